# Optimizing an MI355X kernel written in HIP

```python
import math, functools
import jax, jax.numpy as jnp
from jax import lax
import numpy as np


D_MODEL = 1024
BATCH = 8
SEQ = 4096
DEPTH = 2

GRID_W = 64
CTX_LEN = 256
EPS = 1e-6
ROPE_BASE = 10000.0
N_MOD = 6
F32 = jnp.float32
RET_HEADS = 4
RET_DK = 64
RET_DV = 128
RET_QK = RET_HEADS * RET_DK
RET_WIDTH = RET_HEADS * RET_DV
RET_CHUNK = 128
S5_WIDTH = D_MODEL - RET_WIDTH
S5_GROUP = 16
S5_GROUPS = S5_WIDTH // S5_GROUP
S5_STATE = 64
AB_CUTS = (RET_QK, 2 * RET_QK, 2 * RET_QK + RET_WIDTH, 2 * RET_QK + RET_WIDTH + S5_WIDTH)
AB_IN = 2 * RET_QK + 2 * RET_WIDTH + S5_WIDTH
HG_HEADS = 8
HG_DK = D_MODEL // HG_HEADS
HG_DV = D_MODEL // HG_HEADS
HG_CHUNK = 32
D_FF = 4 * D_MODEL
N_EVEN = (DEPTH + 1) // 2
N_ODD = DEPTH // 2

kernel_name = 'hybrid_retention_s5_hgrn2_prefix_dit'


def _rmsnorm(x, g):
    xf = x.astype(F32)
    y = xf * lax.rsqrt(jnp.mean(jnp.square(xf), axis=-1, keepdims=True) + EPS)
    return (y * g.astype(F32)).astype(x.dtype)


def _head_rms(o):
    return o * lax.rsqrt(jnp.mean(jnp.square(o), axis=-1, keepdims=True) + EPS)


def _modulate(h, shift, scale):
    return h * (1.0 + scale) + shift


def _adaln(cond, w, b, n):
    return jnp.split(jax.nn.silu(cond) @ w + b, n, axis=-1)


def _sqrelu_mlp(h, w1, w2):
    return jnp.square(jax.nn.relu(h @ w1)) @ w2


def _flip(t, rev):
    return t[:, ::-1] if rev else t


def _split_heads(t, d):
    return t.astype(F32).reshape(t.shape[0], t.shape[1], -1, d)


def _grid_rope(n_tok):
    rows = n_tok // GRID_W
    row = jnp.broadcast_to(jnp.arange(rows, dtype=F32)[:, None], (rows, GRID_W)).reshape(-1)
    col = jnp.broadcast_to(jnp.arange(GRID_W, dtype=F32)[None, :], (rows, GRID_W)).reshape(-1)
    n_freq = RET_DK // 4
    inv = ROPE_BASE ** (-jnp.arange(n_freq, dtype=F32) / n_freq)
    ang = jnp.concatenate([row[:, None] * inv, col[:, None] * inv], axis=-1)
    return jnp.cos(ang), jnp.sin(ang)


def _rope(t, cos, sin):
    half = t.shape[-1] // 2
    t1, t2 = t[..., :half], t[..., half:]
    cs, sn = cos[None, :, None, :], sin[None, :, None, :]
    return jnp.concatenate([t1 * cs - t2 * sn, t1 * sn + t2 * cs], axis=-1)


def _retention_chunks(q, k, v, log_gamma, s0):
    b, n, h, _ = q.shape
    dv = v.shape[-1]
    c = min(RET_CHUNK, n)
    nc = n // c
    rs = lambda t: jnp.moveaxis(t.reshape(b, nc, c, h, t.shape[-1]), 1, 0)
    qc, kc, vc = rs(q), rs(k), rs(v)
    pos = jnp.arange(c, dtype=F32)
    diff = pos[:, None] - pos[None, :]
    decay = jnp.where(diff >= 0, jnp.exp(jnp.maximum(diff, 0.0)[None] * log_gamma[:, None, None]), 0.0)
    q_dec = jnp.exp((pos[:, None] + 1.0) * log_gamma[None])
    k_dec = jnp.exp((c - 1.0 - pos)[:, None] * log_gamma[None])
    c_dec = jnp.exp(c * log_gamma)
    att = jnp.einsum('nbihd,nbjhd->nbhij', qc, kc) * decay
    o_intra = jnp.einsum('nbhij,nbjhe->nbihe', att, vc)

    def step(s, inp):
        qn, kn, vn = inp
        o = jnp.einsum('bihd,ih,bhde->bihe', qn, q_dec, s)
        s = c_dec[None, :, None, None] * s + jnp.einsum('bjhd,jh,bjhe->bhde', kn, k_dec, vn)
        return s, o

    s_end, o_inter = lax.scan(step, s0, (qc, kc, vc))
    out = jnp.moveaxis(o_intra + o_inter, 0, 1).reshape(b, n, h, dv)
    return out, s_end


def _retention_state(k, v, log_gamma):
    n = k.shape[1]
    w = jnp.exp((n - 1.0 - jnp.arange(n, dtype=F32))[:, None] * log_gamma[None])
    return jnp.einsum('blhd,lh,blhe->bhde', k, w, v)


def _s5_discretise(a_re, a_im, log_dt, b_re, b_im):
    a_re, a_im = a_re.astype(F32), a_im.astype(F32)
    dt = jnp.exp(log_dt.astype(F32))[:, None]
    mag = jnp.exp(a_re * dt)
    ang = a_im * dt
    ab_re, ab_im = mag * jnp.cos(ang), mag * jnp.sin(ang)
    nr, ni = ab_re - 1.0, ab_im
    den = jnp.square(a_re) + jnp.square(a_im)
    fr = (nr * a_re + ni * a_im) / den
    fi = (ni * a_re - nr * a_im) / den
    b_re, b_im = b_re.astype(F32), b_im.astype(F32)
    bb_re = fr[..., None] * b_re - fi[..., None] * b_im
    bb_im = fr[..., None] * b_im + fi[..., None] * b_re
    return ab_re, ab_im, bb_re, bb_im


def _complex_affine_combine(e1, e2):
    a1r, a1i, b1r, b1i = e1
    a2r, a2i, b2r, b2i = e2
    return (a2r * a1r - a2i * a1i,
            a2r * a1i + a2i * a1r,
            a2r * b1r - a2i * b1i + b2r,
            a2r * b1i + a2i * b1r + b2i)


def _s5_scan(u, ab_re, ab_im, bb_re, bb_im, h0_re, h0_im):
    n = u.shape[1]
    x_re = jnp.einsum('blgm,gpm->blgp', u, bb_re)
    x_im = jnp.einsum('blgm,gpm->blgp', u, bb_im)
    x_re = x_re.at[:, 0].add(ab_re * h0_re - ab_im * h0_im)
    x_im = x_im.at[:, 0].add(ab_re * h0_im + ab_im * h0_re)
    shape = (1, n) + ab_re.shape
    a_re = jnp.broadcast_to(ab_re, shape)
    a_im = jnp.broadcast_to(ab_im, shape)
    _, _, h_re, h_im = lax.associative_scan(_complex_affine_combine, (a_re, a_im, x_re, x_im), axis=1)
    return h_re, h_im


def _s5_readout(h_re, h_im, c_re, c_im):
    return (jnp.einsum('blgp,gmp->blgm', h_re, c_re.astype(F32))
            - jnp.einsum('blgp,gmp->blgm', h_im, c_im.astype(F32)))


def _hgrn_gates(raw, lb):
    log_f = jnp.log(lb + (1.0 - lb) * jax.nn.sigmoid(raw))
    k = (1.0 - lb) * jax.nn.sigmoid(-raw)
    return log_f, k


def _hgrn_chunks(q, k, v, log_f, s0):
    b, n, h, _ = q.shape
    dv = v.shape[-1]
    c = min(HG_CHUNK, n)
    nc = n // c
    rs = lambda t: jnp.moveaxis(t.reshape(b, nc, c, h, t.shape[-1]), 1, 0)
    qc, kc, vc, lf = rs(q), rs(k), rs(v), rs(log_f)
    cum = jnp.cumsum(lf, axis=2)
    tot = cum[:, :, -1:]
    q_in = qc * jnp.exp(cum)
    k_in = kc * jnp.exp(-cum)
    k_out = kc * jnp.exp(tot - cum)
    mask = jnp.tril(jnp.ones((c, c), dtype=bool))
    att = jnp.where(mask, jnp.einsum('nbihd,nbjhd->nbhij', q_in, k_in), 0.0)
    o_intra = jnp.einsum('nbhij,nbjhe->nbihe', att, vc)

    def step(s, inp):
        qn, kn, vn, dn = inp
        o = jnp.einsum('bihd,bhde->bihe', qn, s)
        s = jnp.exp(dn)[:, 0, :, :, None] * s + jnp.einsum('bjhd,bjhe->bhde', kn, vn)
        return s, o

    s_end, o_inter = lax.scan(step, s0, (q_in, k_out, vc, tot))
    out = jnp.moveaxis(o_intra + o_inter, 0, 1).reshape(b, n, h, dv)
    return out, s_end


def _hgrn_state(k, v, log_f):
    cum = jnp.cumsum(log_f, axis=1)
    w = jnp.exp(cum[:, -1:] - cum)
    return jnp.einsum('blhd,blhe->bhde', k * w, v)


def _retention_s5_mixer(xl, xc, cos, sin, w_in, w_out, ret_logit, a_re, a_im, log_dt, b_re, b_im,
                        c_re, c_im, d_skip, w_glu, b_glu, ctx_out):
    b, n, _ = xl.shape
    bc, nc_tok, _ = xc.shape
    k_scale = RET_DK ** -0.5
    ql, kl, vl, ul, gl = jnp.split(xl @ w_in, AB_CUTS, axis=-1)
    if ctx_out:
        qc, kc, vc, uc, gc = jnp.split(xc @ w_in, AB_CUTS, axis=-1)
        qc = _split_heads(qc, RET_DK)
    else:
        kc, vc, uc = jnp.split(xc @ w_in[:, RET_QK:AB_CUTS[3]], [RET_QK, RET_QK + RET_WIDTH], axis=-1)
    ql = _rope(_split_heads(ql, RET_DK), cos, sin)
    kl = _rope(_split_heads(kl, RET_DK), cos, sin) * k_scale
    vl = _split_heads(vl, RET_DV)
    kc = _split_heads(kc, RET_DK) * k_scale
    vc = _split_heads(vc, RET_DV)
    ul_g = ul.astype(F32).reshape(b, n, S5_GROUPS, S5_GROUP)
    uc_g = uc.astype(F32).reshape(bc, nc_tok, S5_GROUPS, S5_GROUP)
    log_gamma = jax.nn.log_sigmoid(ret_logit.astype(F32))
    ret_zero = jnp.zeros((bc, RET_HEADS, RET_DK, RET_DV), F32)
    s5_zero = jnp.zeros((bc, S5_GROUPS, S5_STATE), F32)
    ret_l, ret_c, s5_l, s5_c = [], [], [], []
    for d in range(2):
        f = functools.partial(_flip, rev=(d == 1))
        lg = log_gamma[d]
        if ctx_out:
            o, s_ret = _retention_chunks(f(qc), f(kc), f(vc), lg, ret_zero)
            ret_c.append(f(o))
        else:
            s_ret = _retention_state(f(kc), f(vc), lg)
        o, _ = _retention_chunks(f(ql), f(kl), f(vl), lg, s_ret)
        ret_l.append(f(o))
        disc = _s5_discretise(a_re[d], a_im[d], log_dt[d], b_re[d], b_im[d])
        hc_re, hc_im = _s5_scan(f(uc_g), *disc, s5_zero, s5_zero)
        if ctx_out:
            s5_c.append(f(_s5_readout(hc_re, hc_im, c_re[d], c_im[d])))
        hl_re, hl_im = _s5_scan(f(ul_g), *disc, hc_re[:, -1], hc_im[:, -1])
        s5_l.append(f(_s5_readout(hl_re, hl_im, c_re[d], c_im[d])))

    def merge(ret, s5, g, u):
        bb, nn = u.shape[0], u.shape[1]
        r = _head_rms(ret[0] + ret[1]).reshape(bb, nn, RET_WIDTH) * jax.nn.silu(g.astype(F32))
        y = (s5[0] + s5[1]).reshape(bb, nn, S5_WIDTH) + d_skip.astype(F32) * u.astype(F32)
        y = jax.nn.gelu(y)
        y = y * jax.nn.sigmoid(y @ w_glu + b_glu)
        return jnp.concatenate([r, y], axis=-1) @ w_out

    yl = merge(ret_l, s5_l, gl, ul).astype(xl.dtype)
    yc = merge(ret_c, s5_c, gc, uc).astype(xc.dtype) if ctx_out else None
    return yl, yc


def _hgrn2_mixer(xl, xc, w_in, w_out, lower_bound, norm_g, ctx_out):
    D = D_MODEL
    bc = xc.shape[0]
    ql, ffl, fbl, il, gl = jnp.split(xl @ w_in, 5, axis=-1)
    if ctx_out:
        qc, ffc, fbc, ic, gc = jnp.split(xc @ w_in, 5, axis=-1)
        qc = _split_heads(qc, HG_DK)
    else:
        ffc, fbc, ic = jnp.split(xc @ w_in[:, D:4 * D], 3, axis=-1)
    ql = _split_heads(ql, HG_DK)
    il = _split_heads(il, HG_DV)
    ic = _split_heads(ic, HG_DV)
    raw_l, raw_c = (ffl, fbl), (ffc, fbc)
    zero = jnp.zeros((bc, HG_HEADS, HG_DK, HG_DV), F32)
    out_l, out_c = [], []
    for d in range(2):
        f = functools.partial(_flip, rev=(d == 1))
        lb = lower_bound[d].reshape(HG_HEADS, HG_DK)
        lfl, kl = _hgrn_gates(_split_heads(raw_l[d], HG_DK), lb)
        lfc, kc = _hgrn_gates(_split_heads(raw_c[d], HG_DK), lb)
        if ctx_out:
            o, s = _hgrn_chunks(f(qc), f(kc), f(ic), f(lfc), zero)
            out_c.append(f(o))
        else:
            s = _hgrn_state(f(kc), f(ic), f(lfc))
        o, _ = _hgrn_chunks(f(ql), f(kl), f(il), f(lfl), s)
        out_l.append(f(o))

    def merge(outs, g):
        o = _head_rms(outs[0] + outs[1]) * norm_g.astype(F32)
        o = o.reshape(o.shape[0], o.shape[1], D) * jax.nn.silu(g.astype(F32))
        return o @ w_out

    yl = merge(out_l, gl).astype(xl.dtype)
    yc = merge(out_c, gc).astype(xc.dtype) if ctx_out else None
    return yl, yc


def setup_inputs(seed: int = 0) -> dict:
    key = jax.random.key(seed)
    ks = iter(jax.random.split(key, 32))

    def nrm(shape, scale):
        return scale * jax.random.normal(next(ks), shape, F32)

    D = D_MODEL
    x = nrm((BATCH, SEQ, D), 1.0)
    c = nrm((BATCH, D), 1.0)
    ctx = nrm((BATCH, CTX_LEN, D), 1.0)
    c_ctx = nrm((D,), 1.0)
    w_mod = nrm((DEPTH, D, N_MOD * D), 0.5 * D ** -0.5)
    b_mod = nrm((DEPTH, N_MOD * D), 0.02)
    norm_mix = 1.0 + nrm((DEPTH, D), 0.02)
    norm_mlp = 1.0 + nrm((DEPTH, D), 0.02)
    w_mlp_in = nrm((DEPTH, D, D_FF), D ** -0.5)
    w_mlp_out = nrm((DEPTH, D_FF, D), D_FF ** -0.5)
    ab_w_in = nrm((N_EVEN, D, AB_IN), D ** -0.5)
    ab_w_out = nrm((N_EVEN, D, D), D ** -0.5)
    eps_h = np.exp(np.linspace(math.log(1.0 / 32), math.log(1.0 / 512), RET_HEADS))
    ret_logit = jnp.asarray(np.log((1.0 - eps_h) / eps_h), F32) + nrm((N_EVEN, 2, RET_HEADS), 0.05)
    n_idx = jnp.arange(S5_STATE, dtype=F32)
    s5_a_re = -0.5 + nrm((N_EVEN, 2, S5_GROUPS, S5_STATE), 0.01)
    s5_a_im = math.pi * n_idx + nrm((N_EVEN, 2, S5_GROUPS, S5_STATE), 0.01)
    s5_log_dt = jax.random.uniform(next(ks), (N_EVEN, 2, S5_GROUPS), F32, math.log(1e-3), math.log(1e-1))
    s5_b_re = nrm((N_EVEN, 2, S5_GROUPS, S5_STATE, S5_GROUP), (2 * S5_GROUP) ** -0.5)
    s5_b_im = nrm((N_EVEN, 2, S5_GROUPS, S5_STATE, S5_GROUP), (2 * S5_GROUP) ** -0.5)
    s5_c_re = nrm((N_EVEN, 2, S5_GROUPS, S5_GROUP, S5_STATE), S5_STATE ** -0.5)
    s5_c_im = nrm((N_EVEN, 2, S5_GROUPS, S5_GROUP, S5_STATE), S5_STATE ** -0.5)
    s5_d = nrm((N_EVEN, S5_WIDTH), 1.0)
    s5_w_glu = nrm((N_EVEN, S5_WIDTH, S5_WIDTH), S5_WIDTH ** -0.5)
    s5_b_glu = nrm((N_EVEN, S5_WIDTH), 0.02)
    hg_w_in = nrm((N_ODD, D, 5 * D), D ** -0.5)
    hg_w_out = nrm((N_ODD, D, D), D ** -0.5)
    hg_lb_logits = nrm((2, DEPTH, HG_HEADS * HG_DK), 0.1)
    hg_norm = 1.0 + nrm((N_ODD, HG_DV), 0.02)
    norm_final = 1.0 + nrm((D,), 0.02)
    return {'x': x, 'c': c, 'ctx': ctx, 'c_ctx': c_ctx, 'w_mod': w_mod, 'b_mod': b_mod,
            'norm_mix': norm_mix, 'norm_mlp': norm_mlp, 'w_mlp_in': w_mlp_in, 'w_mlp_out': w_mlp_out,
            'ab_w_in': ab_w_in, 'ab_w_out': ab_w_out, 'ret_logit': ret_logit,
            's5_a_re': s5_a_re, 's5_a_im': s5_a_im, 's5_log_dt': s5_log_dt,
            's5_b_re': s5_b_re, 's5_b_im': s5_b_im, 's5_c_re': s5_c_re, 's5_c_im': s5_c_im,
            's5_d': s5_d, 's5_w_glu': s5_w_glu, 's5_b_glu': s5_b_glu,
            'hg_w_in': hg_w_in, 'hg_w_out': hg_w_out, 'hg_lb_logits': hg_lb_logits, 'hg_norm': hg_norm,
            'norm_final': norm_final}


def reference(x, c, ctx, c_ctx, w_mod, b_mod, norm_mix, norm_mlp, w_mlp_in, w_mlp_out,
              ab_w_in, ab_w_out, ret_logit, s5_a_re, s5_a_im, s5_log_dt, s5_b_re, s5_b_im,
              s5_c_re, s5_c_im, s5_d, s5_w_glu, s5_b_glu, hg_w_in, hg_w_out, hg_lb_logits, hg_norm,
              norm_final):
    cos, sin = _grid_rope(x.shape[1])
    gam = jax.nn.softmax(hg_lb_logits.astype(F32), axis=1)
    lower_bounds = jnp.cumsum(gam, axis=1) - gam[:, :1]
    hl, hc = x, ctx
    for l in range(DEPTH):
        ctx_out = l < DEPTH - 1
        ml = [m[:, None, :] for m in _adaln(c, w_mod[l], b_mod[l], N_MOD)]
        if ctx_out:
            mc = _adaln(c_ctx, w_mod[l], b_mod[l], N_MOD)
        else:
            mc = _adaln(c_ctx, w_mod[l, :, :2 * D_MODEL], b_mod[l, :2 * D_MODEL], 2)
        xl = _modulate(_rmsnorm(hl, norm_mix[l]), ml[0], ml[1])
        xc = _modulate(_rmsnorm(hc, norm_mix[l]), mc[0], mc[1])
        j = l // 2
        if l % 2 == 0:
            yl, yc = _retention_s5_mixer(xl, xc, cos, sin, ab_w_in[j], ab_w_out[j], ret_logit[j],
                                         s5_a_re[j], s5_a_im[j], s5_log_dt[j], s5_b_re[j], s5_b_im[j],
                                         s5_c_re[j], s5_c_im[j], s5_d[j], s5_w_glu[j], s5_b_glu[j], ctx_out)
        else:
            yl, yc = _hgrn2_mixer(xl, xc, hg_w_in[j], hg_w_out[j], lower_bounds[:, l], hg_norm[j], ctx_out)
        hl = hl + ml[2] * yl
        hl = hl + ml[5] * _sqrelu_mlp(_modulate(_rmsnorm(hl, norm_mlp[l]), ml[3], ml[4]), w_mlp_in[l], w_mlp_out[l])
        if ctx_out:
            hc = hc + mc[2] * yc
            hc = hc + mc[5] * _sqrelu_mlp(_modulate(_rmsnorm(hc, norm_mlp[l]), mc[3], mc[4]), w_mlp_in[l], w_mlp_out[l])
    return _rmsnorm(hl, norm_final)
```

```cpp
#include <hip/hip_runtime.h>
#include <cstdio>
#include <cstdint>

namespace pg8 {
#define PG8_LAS __attribute__((address_space(3)))
typedef unsigned short bf16_t;
typedef short bf16x8 __attribute__((ext_vector_type(8)));
typedef float f32x4 __attribute__((ext_vector_type(4)));
typedef unsigned u32x4 __attribute__((ext_vector_type(4)));
constexpr int BM = 256, BK = 64, HALF = 128, HTB = HALF * BK * 2, STAGE_BYTES = 8 * HTB, NXCD = 8, WGM = 8;

__host__ __device__ __forceinline__ int lds_byte(int r, int c) { const int st = (r >> 4) * 2 + (c >> 5), rr = r & 15, cc = c & 31, ob = rr * 64 + cc * 2; return st * 1024 + (ob ^ (((ob >> 9) & 1) << 5)); }
__host__ __device__ __forceinline__ void stage_rc(int b, int& R, int& C) { const int st = b / 1024, sb = b % 1024, swz = sb ^ (((sb >> 9) & 1) << 5); R = (st >> 1) * 16 + swz / 64; C = (st & 1) * 32 + (swz % 64) / 2; }
__host__ __device__ __forceinline__ int perm32(int rho) { const int n = rho >> 4, i = rho & 15; return 8 * (i >> 2) + 4 * n + (i & 3); }

struct Unit { int pm, pn; };
struct Gemm { const bf16_t* A; const bf16_t* Bt; int M, N, K; };

struct StaticOrder {
    int nM, nN, nwg, G, c;
    __host__ __device__ void init(int M, int N, int G_, int c_) { nM = M / BM; nN = N / BM; nwg = nM * nN; G = G_; c = c_; }
    __host__ __device__ bool next(int i, Unit& u) const {
        const long L = (long)i * G + c; if (L >= nwg) return false;
        int wgid = (int)L; { const int q = nwg / NXCD, r = nwg % NXCD, xcd = wgid % NXCD, off = wgid / NXCD; wgid = (xcd < r ? xcd * (q + 1) : r * (q + 1) + (xcd - r) * q) + off; }
        const int nig = WGM * nN, gid = wgid / nig, fm = gid * WGM, gsz = (nM - fm) < WGM ? (nM - fm) : WGM;
        u.pm = fm + ((wgid % nig) % gsz); u.pn = (wgid % nig) / gsz; return true;
    }
    __device__ __forceinline__ void a_ready(const Unit&) const {}
    __device__ __forceinline__ void done(const Unit&) const {}
};

__device__ __forceinline__ unsigned cvt_pk_bf16(float lo, float hi) { unsigned r; asm volatile("v_cvt_pk_bf16_f32 %0, %1, %2" : "=v"(r) : "v"(lo), "v"(hi)); return r; }

template <class Epi, class Sched, bool ALIGN_EPI = false, bool SP2 = false>
__device__ __forceinline__ void gemm_phase(PG8_LAS unsigned char* lds, const Gemm g, const Sched& S, const Epi& E) {
    const int tid = threadIdx.x, wid = __builtin_amdgcn_readfirstlane(tid >> 6), lane = tid & 63, wr = wid >> 2, wc = wid & 3, fr = lane & 15, fq = lane >> 4;
    const int K = g.K, nt = K / BK;
    unsigned voffA[2], voffB[2];
#pragma unroll
    for (int i = 0; i < 2; ++i) { int R, C; stage_rc(tid * 16 + i * 8192, R, C); const int Rb = Epi::PERM ? ((R & ~31) + perm32(R & 31)) : R;
        voffA[i] = (unsigned)(R * K + C) * 2u; voffB[i] = (unsigned)(Rb * K + C) * 2u; }
    const size_t kstep = (size_t)(BK * 2);
    const size_t hstep = (size_t)HALF * K * 2;
    const size_t tstep = 2 * hstep;
    const unsigned ldsw = (unsigned)wid * 1024u;
    const int aoff = lds_byte(wr * 64 + fr, fq * 8), boff = lds_byte(wc * 32 + fr, fq * 8);
#define PG8_SA(b, h) (((b) * 2 + (h)) * HTB)
#define PG8_SB(b, h) ((4 + (b) * 2 + (h)) * HTB)
#define PG8_STAGE(bufoff, gbase, voff) do { _Pragma("unroll") for (int _i = 0; _i < 2; ++_i) \
        __builtin_amdgcn_global_load_lds((const unsigned*)((const char*)(gbase) + (voff)[_i]), (PG8_LAS unsigned*)(lds + (bufoff) + ldsw + _i * 8192), 16, 0, 0); } while (0)
#define PG8_LDA(dst, b, h) do { _Pragma("unroll") for (int m = 0; m < 4; ++m) _Pragma("unroll") for (int k = 0; k < 2; ++k) dst[m][k] = *(const PG8_LAS bf16x8*)(lds + PG8_SA(b, h) + aoff + m * 2048 + k * 1024); } while (0)
#define PG8_LDB(dst, b, h) do { _Pragma("unroll") for (int n = 0; n < 2; ++n) _Pragma("unroll") for (int k = 0; k < 2; ++k) dst[n][k] = *(const PG8_LAS bf16x8*)(lds + PG8_SB(b, h) + boff + n * 2048 + k * 1024); } while (0)
#define PG8_MMA(ai, bj, At, Bt) do { __builtin_amdgcn_s_setprio(1); _Pragma("unroll") for (int m = 0; m < 4; ++m) _Pragma("unroll") for (int n = 0; n < 2; ++n) _Pragma("unroll") for (int k = 0; k < 2; ++k) \
        acc[ai][bj][m][n] = __builtin_amdgcn_mfma_f32_16x16x32_bf16(Bt[n][k], At[m][k], acc[ai][bj][m][n], 0, 0, 0); __builtin_amdgcn_s_setprio(0); } while (0)
#define PG8_WAIT_V(n) asm volatile("s_waitcnt vmcnt(" #n ")" ::: "memory")
#define PG8_WAIT_L(n) asm volatile("s_waitcnt lgkmcnt(" #n ")" ::: "memory")
#define PG8_BAR __builtin_amdgcn_s_barrier()
#define PG8_SCHED __builtin_amdgcn_sched_barrier(0)
    Unit cur, nxt; int ui = 0;
    if (!S.next(0, cur)) return;
    f32x4 acc[2][2][4][2];
#pragma unroll
    for (int a = 0; a < 2; ++a)
#pragma unroll
        for (int b = 0; b < 2; ++b)
#pragma unroll
            for (int m = 0; m < 4; ++m)
#pragma unroll
                for (int n = 0; n < 2; ++n) acc[a][b][m][n] = (f32x4){0.f, 0.f, 0.f, 0.f};
    bf16x8 At[4][2], B0[2][2], B1[2][2];
    const char* cA = (const char*)g.A + (size_t)cur.pm * tstep; const char* cB = (const char*)g.Bt + (size_t)cur.pn * tstep;
    S.a_ready(cur);
    if constexpr (SP2) {
        PG8_STAGE(PG8_SB(0, 0), cB, voffB); PG8_STAGE(PG8_SB(0, 1), cB + hstep, voffB); PG8_STAGE(PG8_SA(0, 0), cA, voffA); PG8_STAGE(PG8_SA(0, 1), cA + hstep, voffA);
        if (wr == 1) PG8_BAR;
        PG8_WAIT_V(2); PG8_BAR;
        PG8_STAGE(PG8_SB(1, 0), cB + kstep, voffB); PG8_STAGE(PG8_SA(1, 0), cA + kstep, voffA); PG8_STAGE(PG8_SB(1, 1), cB + hstep + kstep, voffB);
        PG8_WAIT_V(6); PG8_BAR;
    } else {
        PG8_STAGE(PG8_SB(0, 0), cB, voffB); PG8_STAGE(PG8_SA(0, 0), cA, voffA); PG8_STAGE(PG8_SB(0, 1), cB + hstep, voffB); PG8_STAGE(PG8_SA(0, 1), cA + hstep, voffA);
        if (wr == 1) PG8_BAR;
        PG8_WAIT_V(4); PG8_BAR;
        PG8_STAGE(PG8_SB(1, 0), cB + kstep, voffB); PG8_STAGE(PG8_SA(1, 0), cA + kstep, voffA); PG8_STAGE(PG8_SB(1, 1), cB + hstep + kstep, voffB);
        PG8_WAIT_V(6); PG8_BAR;
    }
    for (;;) {
        const bool has_next = S.next(ui + 1, nxt);
        const char* nA = has_next ? (const char*)g.A + (size_t)nxt.pm * tstep : cA; const char* nB = has_next ? (const char*)g.Bt + (size_t)nxt.pn * tstep : cB;
        for (int t = 0; t < nt; t += 2) {
            const bool last = (t == nt - 2);
            const char* a1 = cA + (size_t)(t + 1) * kstep;
            const char* a2 = last ? nA : cA + (size_t)(t + 2) * kstep; const char* b2 = last ? nB : cB + (size_t)(t + 2) * kstep;
            const char* a3 = a2 + kstep; const char* b3 = b2 + kstep;
            if (last && has_next) S.a_ready(nxt);
            if constexpr (SP2) {
            PG8_LDB(B0, 0, 0); PG8_LDB(B1, 0, 1); PG8_SCHED; PG8_LDA(At, 0, 0); PG8_STAGE(PG8_SA(1, 1), a1 + hstep, voffA);
            PG8_WAIT_V(8); PG8_WAIT_L(0); PG8_BAR; PG8_MMA(0, 0, At, B0); PG8_MMA(0, 1, At, B1); PG8_BAR; PG8_SCHED;
            PG8_LDA(At, 0, 1); PG8_STAGE(PG8_SB(0, 0), b2, voffB); PG8_STAGE(PG8_SB(0, 1), b2 + hstep, voffB); PG8_STAGE(PG8_SA(0, 0), a2, voffA);
            PG8_WAIT_V(8); PG8_WAIT_L(0); PG8_BAR; PG8_MMA(1, 0, At, B0); PG8_MMA(1, 1, At, B1); PG8_BAR; PG8_SCHED;
            PG8_LDB(B0, 1, 0); PG8_LDB(B1, 1, 1); PG8_SCHED; PG8_LDA(At, 1, 0); PG8_STAGE(PG8_SA(0, 1), a2 + hstep, voffA);
            PG8_WAIT_V(8); PG8_WAIT_L(0); PG8_BAR; PG8_MMA(0, 0, At, B0); PG8_MMA(0, 1, At, B1); PG8_BAR; PG8_SCHED;
            PG8_LDA(At, 1, 1); PG8_STAGE(PG8_SB(1, 0), b3, voffB); PG8_STAGE(PG8_SB(1, 1), b3 + hstep, voffB); PG8_STAGE(PG8_SA(1, 0), a3, voffA);
            PG8_WAIT_V(8); PG8_WAIT_L(0); PG8_BAR; PG8_MMA(1, 0, At, B0); PG8_MMA(1, 1, At, B1); PG8_BAR; PG8_SCHED;
            } else {
            PG8_LDB(B0, 0, 0); PG8_SCHED; PG8_LDA(At, 0, 0); PG8_STAGE(PG8_SA(1, 1), a1 + hstep, voffA);
            PG8_WAIT_L(8); PG8_BAR; PG8_WAIT_L(0); PG8_MMA(0, 0, At, B0); PG8_BAR; PG8_SCHED;
            PG8_LDB(B1, 0, 1); PG8_STAGE(PG8_SB(0, 0), b2, voffB);
            PG8_BAR; PG8_WAIT_L(0); PG8_MMA(0, 1, At, B1); PG8_BAR;
            PG8_LDA(At, 0, 1); PG8_STAGE(PG8_SA(0, 0), a2, voffA);
            PG8_BAR; PG8_WAIT_L(0); PG8_MMA(1, 0, At, B0); PG8_BAR; PG8_SCHED;
            PG8_STAGE(PG8_SB(0, 1), b2 + hstep, voffB);
            PG8_WAIT_V(6); PG8_BAR; PG8_MMA(1, 1, At, B1); PG8_BAR;
            PG8_LDB(B0, 1, 0); PG8_SCHED; PG8_LDA(At, 1, 0); PG8_STAGE(PG8_SA(0, 1), a2 + hstep, voffA);
            PG8_WAIT_L(8); PG8_BAR; PG8_WAIT_L(0); PG8_MMA(0, 0, At, B0); PG8_BAR; PG8_SCHED;
            PG8_LDB(B1, 1, 1); PG8_STAGE(PG8_SB(1, 0), b3, voffB);
            PG8_BAR; PG8_WAIT_L(0); PG8_MMA(0, 1, At, B1); PG8_BAR;
            PG8_LDA(At, 1, 1); PG8_STAGE(PG8_SA(1, 0), a3, voffA);
            PG8_BAR; PG8_WAIT_L(0); PG8_MMA(1, 0, At, B0); PG8_BAR; PG8_SCHED;
            PG8_STAGE(PG8_SB(1, 1), b3 + hstep, voffB);
            PG8_WAIT_V(6); PG8_BAR; PG8_MMA(1, 1, At, B1); PG8_BAR;
            }
        }
        if constexpr (ALIGN_EPI) { if (wr == 0) PG8_BAR; }
        if constexpr (!Epi::AFTER_DRAIN) { E(acc, cur, wr, wc, fr, fq); S.done(cur); }
        if (!has_next) break;
#pragma unroll
        for (int a = 0; a < 2; ++a)
#pragma unroll
            for (int b = 0; b < 2; ++b)
#pragma unroll
                for (int m = 0; m < 4; ++m)
#pragma unroll
                    for (int n = 0; n < 2; ++n) acc[a][b][m][n] = (f32x4){0.f, 0.f, 0.f, 0.f};
        cur = nxt; cA = nA; cB = nB; ++ui;
        if constexpr (ALIGN_EPI) { if (wr == 1) PG8_BAR; }
    }
    PG8_WAIT_V(0);
    if constexpr (!ALIGN_EPI) { if (wr == 0) PG8_BAR; }
    PG8_BAR;
#undef PG8_SA
#undef PG8_SB
#undef PG8_STAGE
#undef PG8_LDA
#undef PG8_LDB
#undef PG8_MMA
#undef PG8_WAIT_V
#undef PG8_WAIT_L
#undef PG8_BAR
#undef PG8_SCHED
}
}

#define GAS __attribute__((address_space(1)))
#define LAS __attribute__((address_space(3)))
typedef unsigned short bf16;
typedef unsigned v4u __attribute__((ext_vector_type(4)));
typedef unsigned v2u __attribute__((ext_vector_type(2)));
typedef float f32x4 __attribute__((ext_vector_type(4)));
typedef float f32x2 __attribute__((ext_vector_type(2)));

constexpr int NWAVES = 8;
constexpr int DM = 1024, NBATCH = 8, SEQL = 4096, CTXL = 256, DFF = 4096;
constexpr int ML = NBATCH * SEQL;
constexpr int MC = NBATCH * CTXL;
constexpr int MT = ML + MC;
constexpr int NMOD = 6 * DM;
constexpr float EPSN = 1e-6f;

constexpr size_t MiB = 1u << 20;
constexpr size_t WS_CTL = 0, CTL_ZERO_BYTES = 1 * MiB;
constexpr size_t WS_MOD = 1 * MiB;
constexpr size_t WS_CS = 2 * MiB;
constexpr size_t WS_S5T = 3 * MiB;
constexpr size_t WS_S5T_BB = WS_S5T + 32768, WS_LB = WS_S5T_BB + 524288;
constexpr size_t WS_HC = 4 * MiB;
constexpr size_t WS_WIN0 = 12 * MiB, WS_WOUT0 = 16 * MiB, WS_WGLU = 18 * MiB, WS_W1 = 19 * MiB  , WS_W2 = 35 * MiB  , WS_WHG = 51 * MiB, WS_WHGO = 61 * MiB;
constexpr size_t WS_XN = 64 * MiB;
constexpr size_t WS_BIG = 132 * MiB;
constexpr size_t WS_P0 = WS_BIG;
constexpr size_t WS_RETF = WS_BIG + 136 * MiB;
constexpr size_t WS_RETB = WS_BIG + 204 * MiB;
constexpr size_t WS_S5F = WS_BIG + 272 * MiB;
constexpr size_t WS_S5B = WS_XN;
constexpr size_t WS_H = WS_BIG;
constexpr size_t WS_P1 = WS_BIG;
constexpr size_t WS_Y = 472 * MiB;
constexpr size_t WS_END = 512 * MiB;

constexpr int CW_BAR = 4096;

constexpr int RING_OFF = 0, RING_BYTES = 131072;
constexpr int LDSCTL_OFF = RING_BYTES, MISC_OFF = LDSCTL_OFF + 320;
constexpr int LDS_BYTES = 147456;

typedef GAS unsigned gu32;
#define LDS_WAIT() asm volatile("s_waitcnt lgkmcnt(0)" ::: "memory")
__device__ __forceinline__ unsigned f2bf(float f) { unsigned u = __builtin_bit_cast(unsigned, f); return (u + 0x7fffu + ((u >> 16) & 1u)) >> 16; }
__device__ __forceinline__ unsigned pk2(float lo, float hi) { return f2bf(lo) | (f2bf(hi) << 16); }
__device__ __forceinline__ float bflo(unsigned w) { return __builtin_bit_cast(float, w << 16); }
__device__ __forceinline__ float bfhi(unsigned w) { return __builtin_bit_cast(float, w & 0xffff0000u); }
__device__ __forceinline__ float bf2f(bf16 h) { return __builtin_bit_cast(float, (unsigned)h << 16); }
typedef _Float16 h16x2 __attribute__((ext_vector_type(2)));
__device__ __forceinline__ unsigned pk_f16(float a, float b) { h16x2 v; v.x = (_Float16)a; v.y = (_Float16)b; return __builtin_bit_cast(unsigned, v); }
__device__ __forceinline__ float f16lo(unsigned w) { h16x2 v = __builtin_bit_cast(h16x2, w); return (float)v.x; }
__device__ __forceinline__ float f16hi(unsigned w) { h16x2 v = __builtin_bit_cast(h16x2, w); return (float)v.y; }
__device__ __forceinline__ float sigmoidf_(float x) { return 1.0f / (1.0f + __expf(-x)); }
__device__ __forceinline__ float siluf_(float x) { return x / (1.0f + __expf(-x)); }
__device__ __forceinline__ float gelu_tanh(float x) { const float u = 0.7978845608028654f * (x + 0.044715f * x * x * x); return 0.5f * x * (1.0f + tanhf(u)); }

#define XB_TMO      128
#define XB_XCNT(j)  (256  + 64 * (j))
#define XB_XSUB(j)  (1280 + 64 * (j))
#define XB_XGEN(j)  (2304 + 64 * (j))
#define XB_TOP      3328
#define XB_TOPGEN   3392
#define XCD_BAR_WORDS 3456
#define XB_SPIN_CAP (1u << 22)
__device__ __forceinline__ unsigned xb_ld(unsigned* p)              { return __hip_atomic_load(p, __ATOMIC_RELAXED, __HIP_MEMORY_SCOPE_AGENT); }
__device__ __forceinline__ unsigned xb_add(unsigned* p, unsigned v) { return __hip_atomic_fetch_add(p, v, __ATOMIC_RELAXED, __HIP_MEMORY_SCOPE_AGENT); }
__device__ __forceinline__ unsigned xb_xcc_id() { return (unsigned)__builtin_amdgcn_s_getreg((3 << 11) | 20) & 0xFu; }
#define XB_SPIN(cond, bar) do { unsigned _sp = 0; while (cond) { __builtin_amdgcn_s_sleep(1); \
    if ((++_sp & 255u) == 0u) { if (xb_ld(&(bar)[XB_TMO])) break; if (_sp > XB_SPIN_CAP) { atomicAdd(&(bar)[XB_TMO], 1u); break; } } } } while (0)
struct XcdBarrier { unsigned* bar; unsigned x; volatile LAS unsigned* st; };
__device__ __forceinline__ XcdBarrier xcd_barrier_post(unsigned* bar, volatile LAS unsigned* st) {
    XcdBarrier b; b.bar = bar; b.x = xb_xcc_id(); b.st = st;
    if (threadIdx.x == 0) (void)xb_add(&bar[XB_XCNT(b.x)], 1u);
    return b;
}
__device__ __forceinline__ void xcd_barrier_complete(unsigned* bar, unsigned x, unsigned& nloc, unsigned& nx) {
    const unsigned G = gridDim.x * gridDim.y * gridDim.z;
    unsigned sum, cnt, mine, sp = 0u;
    for (;;) {
        sum = 0u; cnt = 0u; mine = 0u;
#pragma unroll
        for (unsigned j = 0; j < 16; ++j) { const unsigned c = xb_ld(&bar[XB_XCNT(j)]); sum += c; cnt += (c > 0u) ? 1u : 0u; mine = (j == x) ? c : mine; }
        if (sum == G) break;
        __builtin_amdgcn_s_sleep(1);
        if ((++sp & 255u) == 0u) { if (xb_ld(&bar[XB_TMO])) break; if (sp > XB_SPIN_CAP) { atomicAdd(&bar[XB_TMO], 1u); break; } }
    }
    nloc = mine > 0u ? mine : 1u; nx = cnt > 0u ? cnt : 1u;
}
__device__ __forceinline__ void xcd_barrier(const XcdBarrier& b) {
    asm volatile("s_waitcnt vmcnt(0)" ::: "memory");
    __syncthreads();
    if (threadIdx.x == 0) {
        unsigned* bar = b.bar;
        __builtin_amdgcn_s_waitcnt(0);
        unsigned nloc = b.st[0], nx = b.st[1];
        if (nloc == 0u) { xcd_barrier_complete(bar, b.x, nloc, nx); b.st[0] = nloc; b.st[1] = nx; }
        const unsigned old = xb_add(&bar[XB_XSUB(b.x)], 1u);
        const unsigned gen = old / nloc;
        if (old + 1u == (gen + 1u) * nloc) {
            __builtin_amdgcn_fence(__ATOMIC_RELEASE, "agent");
            asm volatile("s_waitcnt vmcnt(0)" ::: "memory");
            const unsigned og = xb_add(&bar[XB_TOP], 1u);
            const unsigned tg = og / nx;
            if (og + 1u == (tg + 1u) * nx) xb_add(&bar[XB_TOPGEN], 1u);
            else XB_SPIN(xb_ld(&bar[XB_TOPGEN]) == tg, bar);
            __builtin_amdgcn_fence(__ATOMIC_ACQUIRE, "agent");
            xb_add(&bar[XB_XGEN(b.x)], 1u);
            asm volatile("s_waitcnt vmcnt(0)" ::: "memory");
        } else {
            XB_SPIN(xb_ld(&bar[XB_XGEN(b.x)]) == gen, bar);
            __builtin_amdgcn_fence(__ATOMIC_ACQUIRE, "agent");
            asm volatile("s_waitcnt vmcnt(0)" ::: "memory");
        }
    }
    __syncthreads();
}

__device__ __forceinline__ float wave_sum(float v) {
#pragma unroll
    for (int o = 1; o < 64; o <<= 1) v += __shfl_xor(v, o);
    return v;
}
__device__ __forceinline__ float sum16(float v) {
#pragma unroll
    for (int o = 1; o < 16; o <<= 1) v += __shfl_xor(v, o);
    return v;
}

__device__ __forceinline__ int rowof(int n, int b, int dir) {
    if (n < CTXL) { const int tc = dir ? (CTXL - 1 - n) : n; return ML + b * CTXL + tc; }
    const int tl = n - CTXL; const int t = dir ? (SEQL - 1 - tl) : tl; return b * SEQL + t;
}

__device__ __forceinline__ int permqk(int n) {
    const int d = n & 63, half = d >> 5, dd = d & 31, i = dd >> 2, j = dd & 3; return (n & ~63) + 8 * i + 4 * half + j;
}
template <bool PERMQK>
__device__ __forceinline__ void p0_transpose_item(const float* W, int K, int N, bf16* WT, LAS float* scr, int item, int lane) {
    const int nblk = N / 32, kb = item / nblk, nb = item % nblk, k0 = 64 * kb, n0 = 32 * nb;
#pragma unroll 8
    for (int i = 0; i < 32; ++i) { const int kk = 2 * i + (lane >> 5); scr[kk * 33 + (lane & 31)] = W[(size_t)(k0 + kk) * N + n0 + (lane & 31)]; }
    LDS_WAIT(); asm volatile("" ::: "memory");
    const int c = lane & 7;
#pragma unroll
    for (int j = 0; j < 4; ++j) { const int n = (lane >> 3) + 8 * j; const LAS float* s = scr + (8 * c) * 33 + n;
        v4u o; o.x = pk2(s[0 * 33], s[1 * 33]); o.y = pk2(s[2 * 33], s[3 * 33]); o.z = pk2(s[4 * 33], s[5 * 33]); o.w = pk2(s[6 * 33], s[7 * 33]);
        int nd = n0 + n; if (PERMQK && nd < 512) nd = permqk(nd);
        *(GAS v4u*)(WT + (size_t)nd * K + k0 + 8 * c) = o; }
    LDS_WAIT(); asm volatile("" ::: "memory");
}

__device__ __forceinline__ void norm_mod_rows(const float* hl, const float* hc, int nrows, const float* g, const float* mod, int shift_off, int scale_off, bf16* XN, int gw, int NGW, int lane) {
    for (int row = gw; row < nrows; row += NGW) {
        const float* xr = row < ML ? hl + (size_t)row * DM : hc + (size_t)(row - ML) * DM;
        const int mr = row < ML ? (row >> 12) : 8;
        const f32x4* x4 = (const f32x4*)xr + lane;
        f32x4 v[4]; float s = 0.f;
#pragma unroll
        for (int j = 0; j < 4; ++j) { v[j] = x4[64 * j]; s += (v[j].x * v[j].x + v[j].y * v[j].y) + (v[j].z * v[j].z + v[j].w * v[j].w); }
        const float rstd = 1.0f / sqrtf(wave_sum(s) * (1.f / DM) + EPSN);
        const f32x4* g4 = (const f32x4*)g + lane; const f32x4* sc4 = (const f32x4*)(mod + (size_t)mr * NMOD + scale_off) + lane; const f32x4* sh4 = (const f32x4*)(mod + (size_t)mr * NMOD + shift_off) + lane;
        unsigned long long* o8 = (unsigned long long*)(XN + (size_t)row * DM) + lane;
#pragma unroll
        for (int j = 0; j < 4; ++j) { const f32x4 gg = g4[64 * j], sc = sc4[64 * j], sh = sh4[64 * j];
            const f32x4 y = (v[j] * rstd) * gg * (sc + 1.0f) + sh;
            o8[64 * j] = (unsigned long long)pk2(y.x, y.y) | ((unsigned long long)pk2(y.z, y.w) << 32); }
    }
}
__device__ __forceinline__ void final_norm_rows(float* h, const float* g, int gw, int NGW, int lane) {
    for (int row = gw; row < ML; row += NGW) {
        f32x4* x4 = (f32x4*)(h + (size_t)row * DM) + lane;
        f32x4 v[4]; float s = 0.f;
#pragma unroll
        for (int j = 0; j < 4; ++j) { v[j] = x4[64 * j]; s += (v[j].x * v[j].x + v[j].y * v[j].y) + (v[j].z * v[j].z + v[j].w * v[j].w); }
        const float rstd = 1.0f / sqrtf(wave_sum(s) * (1.f / DM) + EPSN);
        const f32x4* g4 = (const f32x4*)g + lane;
#pragma unroll
        for (int j = 0; j < 4; ++j) x4[64 * j] = (v[j] * rstd) * g4[64 * j];
    }
}
__device__ __forceinline__ void unpack8(const v4u w, float (&o)[8]) { o[0] = bflo(w.x); o[1] = bfhi(w.x); o[2] = bflo(w.y); o[3] = bfhi(w.y); o[4] = bflo(w.z); o[5] = bfhi(w.z); o[6] = bflo(w.w); o[7] = bfhi(w.w); }
__device__ __forceinline__ v4u pack8(const float (&o)[8]) { v4u w; w.x = pk2(o[0], o[1]); w.y = pk2(o[2], o[3]); w.z = pk2(o[4], o[5]); w.w = pk2(o[6], o[7]); return w; }

__device__ __forceinline__ void merge0_rows(const float* RETF, const float* RETB, const float* S5F, const float* S5B, const bf16* P0, const float* dskip, bf16* RZ, bf16* Y, int gw, int NGW, int lane) {
    const int c0 = lane * 8;
    for (int row = gw; row < MT; row += NGW) {
        const f32x4 a0 = *(const f32x4*)(RETF + (size_t)row * 512 + c0), a1 = *(const f32x4*)(RETF + (size_t)row * 512 + c0 + 4);
        const f32x4 b0 = *(const f32x4*)(RETB + (size_t)row * 512 + c0), b1 = *(const f32x4*)(RETB + (size_t)row * 512 + c0 + 4);
        const f32x4 s0 = *(const f32x4*)(S5F + (size_t)row * 512 + c0), s1 = *(const f32x4*)(S5F + (size_t)row * 512 + c0 + 4);
        const f32x4 t0 = *(const f32x4*)(S5B + (size_t)row * 512 + c0), t1 = *(const f32x4*)(S5B + (size_t)row * 512 + c0 + 4);
        const v4u gw4 = *(const v4u*)(P0 + (size_t)row * 2048 + 1536 + c0), uw4 = *(const v4u*)(P0 + (size_t)row * 2048 + 1024 + c0);
        const f32x4 d0 = *(const f32x4*)(dskip + c0), d1 = *(const f32x4*)(dskip + c0 + 4);
        float o[8] = {a0.x + b0.x, a0.y + b0.y, a0.z + b0.z, a0.w + b0.w, a1.x + b1.x, a1.y + b1.y, a1.z + b1.z, a1.w + b1.w};
        float ss = 0.f;
#pragma unroll
        for (int i = 0; i < 8; ++i) ss += o[i] * o[i];
        const float rs = 1.0f / sqrtf(sum16(ss) * (1.f / 128.f) + EPSN);
        float gg[8], uu[8]; unpack8(gw4, gg); unpack8(uw4, uu);
        float r[8], y[8];
        const float sy[8] = {s0.x + t0.x, s0.y + t0.y, s0.z + t0.z, s0.w + t0.w, s1.x + t1.x, s1.y + t1.y, s1.z + t1.z, s1.w + t1.w};
        const float dd[8] = {d0.x, d0.y, d0.z, d0.w, d1.x, d1.y, d1.z, d1.w};
#pragma unroll
        for (int i = 0; i < 8; ++i) { r[i] = o[i] * rs * siluf_(gg[i]); y[i] = gelu_tanh(sy[i] + dd[i] * uu[i]); }
        *(v4u*)(RZ + (size_t)row * 1024 + c0) = pack8(r);
        *(v4u*)(Y + (size_t)row * 512 + c0) = pack8(y);
    }
}
__device__ __forceinline__ void merge1_rows(bf16* OS, const bf16* P1, const float* hgn, int gw, int NGW, int lane) {
    for (int row = gw; row < ML; row += NGW) {
#pragma unroll
        for (int half = 0; half < 2; ++half) {
            const int c0 = half * 512 + lane * 8;
            const v4u ow = *(const v4u*)(OS + (size_t)row * 1024 + c0), gw4 = *(const v4u*)(P1 + (size_t)row * 5120 + 4096 + c0);
            const f32x4 n0 = *(const f32x4*)(hgn + (c0 & 127)), n1 = *(const f32x4*)(hgn + (c0 & 127) + 4);
            float o[8], gg[8]; unpack8(ow, o); unpack8(gw4, gg);
            float ss = 0.f;
#pragma unroll
            for (int i = 0; i < 8; ++i) ss += o[i] * o[i];
            const float rs = 1.0f / sqrtf(sum16(ss) * (1.f / 128.f) + EPSN);
            const float nn[8] = {n0.x, n0.y, n0.z, n0.w, n1.x, n1.y, n1.z, n1.w};
            float r[8];
#pragma unroll
            for (int i = 0; i < 8; ++i) r[i] = o[i] * rs * nn[i] * siluf_(gg[i]);
            *(v4u*)(OS + (size_t)row * 1024 + c0) = pack8(r);
        }
    }
}

using pg8::Unit; using pg8::HALF; using pg8::BM;
__device__ __forceinline__ v4u pack2x4(const f32x4 v0, const f32x4 v1) { v4u w; w.x = pg8::cvt_pk_bf16(v0[0], v0[1]); w.y = pg8::cvt_pk_bf16(v0[2], v0[3]); w.z = pg8::cvt_pk_bf16(v1[0], v1[1]); w.w = pg8::cvt_pk_bf16(v1[2], v1[3]); return w; }

struct EpiProj0 {
    static constexpr bool PERM = true, AFTER_DRAIN = false;
    bf16* O; const float* CS;
    __device__ __forceinline__ void operator()(const f32x4 (&acc)[2][2][4][2], const Unit& u, int wr, int wc, int fr, int fq) const {
        const int row0 = u.pm * BM + wr * 64 + fr, col0 = u.pn * BM + wc * 32 + 8 * fq;
        const bool rope = (u.pn < 2) && (u.pm < ML / BM); const float sc = (u.pn == 1) ? 0.125f : 1.0f;
        const int i4 = 4 * (4 * (wc & 1) + fq);
#pragma unroll
        for (int ai = 0; ai < 2; ++ai)
#pragma unroll
            for (int m = 0; m < 4; ++m) { const int row = row0 + ai * HALF + m * 16;
                f32x4 ca = (f32x4){1.f, 0.f, 1.f, 0.f}, cb = ca;
                if (rope) { const float* p = CS + ((size_t)(row & (SEQL - 1)) * 32 + i4) * 2; ca = *(const f32x4*)p; cb = *(const f32x4*)(p + 4); }
                bf16* rowp = O + (size_t)row * 2048 + col0;
#pragma unroll
                for (int bj = 0; bj < 2; ++bj) { f32x4 v0 = acc[ai][bj][m][0], v1 = acc[ai][bj][m][1];
                    if (rope) {
                        const f32x4 lo = (f32x4){v0[0] * ca[0] - v1[0] * ca[1], v0[1] * ca[2] - v1[1] * ca[3], v0[2] * cb[0] - v1[2] * cb[1], v0[3] * cb[2] - v1[3] * cb[3]};
                        const f32x4 hi = (f32x4){v0[0] * ca[1] + v1[0] * ca[0], v0[1] * ca[3] + v1[1] * ca[2], v0[2] * cb[1] + v1[2] * cb[0], v0[3] * cb[3] + v1[3] * cb[2]};
                        v0 = lo; v1 = hi; }
                    v0 = v0 * sc; v1 = v1 * sc;
                    *(v4u*)(rowp + bj * HALF) = pack2x4(v0, v1); } }
    }
};
struct EpiGlu {
    static constexpr bool PERM = true, AFTER_DRAIN = false;
    const bf16* Y; const float* b; bf16* Z;
    __device__ __forceinline__ void operator()(const f32x4 (&acc)[2][2][4][2], const Unit& u, int wr, int wc, int fr, int fq) const {
        const int row0 = u.pm * BM + wr * 64 + fr, col0 = u.pn * BM + wc * 32 + 8 * fq;
        f32x4 bv[2][2];
#pragma unroll
        for (int bj = 0; bj < 2; ++bj)
#pragma unroll
            for (int n = 0; n < 2; ++n) bv[bj][n] = *(const f32x4*)(b + col0 + bj * HALF + 4 * n);
#pragma unroll
        for (int ai = 0; ai < 2; ++ai)
#pragma unroll
            for (int m = 0; m < 4; ++m) { const int row = row0 + ai * HALF + m * 16;
#pragma unroll
                for (int bj = 0; bj < 2; ++bj) { const int col = col0 + bj * HALF;
                    const v4u yw = *(const v4u*)(Y + (size_t)row * 512 + col); float yy[8]; unpack8(yw, yy);
                    const f32x4 a0 = acc[ai][bj][m][0] + bv[bj][0], a1 = acc[ai][bj][m][1] + bv[bj][1];
                    const f32x4 z0 = (f32x4){yy[0] * sigmoidf_(a0[0]), yy[1] * sigmoidf_(a0[1]), yy[2] * sigmoidf_(a0[2]), yy[3] * sigmoidf_(a0[3])};
                    const f32x4 z1 = (f32x4){yy[4] * sigmoidf_(a1[0]), yy[5] * sigmoidf_(a1[1]), yy[6] * sigmoidf_(a1[2]), yy[7] * sigmoidf_(a1[3])};
                    *(v4u*)(Z + (size_t)row * 1024 + col) = pack2x4(z0, z1); } }
    }
};
struct EpiResid {
    static constexpr bool PERM = false, AFTER_DRAIN = false;
    const float* baseL; const float* baseC; float* outL; float* outC; const float* gate;
    __device__ __forceinline__ void operator()(const f32x4 (&acc)[2][2][4][2], const Unit& u, int wr, int wc, int fr, int fq) const {
        const bool ctx = u.pm >= ML / BM; const int mr = ctx ? 8 : (u.pm >> 4);
        const int row0 = (ctx ? u.pm - ML / BM : u.pm) * BM + wr * 64 + fr, col0 = u.pn * BM + wc * 32 + 4 * fq;
        const float* B = ctx ? baseC : baseL; float* Oo = ctx ? outC : outL;
        f32x4 gv[2][2];
#pragma unroll
        for (int bj = 0; bj < 2; ++bj)
#pragma unroll
            for (int n = 0; n < 2; ++n) gv[bj][n] = *(const f32x4*)(gate + (size_t)mr * NMOD + col0 + bj * HALF + n * 16);
#pragma unroll
        for (int ai = 0; ai < 2; ++ai)
#pragma unroll
            for (int m = 0; m < 4; ++m) { const size_t off = (size_t)(row0 + ai * HALF + m * 16) * DM + col0;
#pragma unroll
                for (int bj = 0; bj < 2; ++bj)
#pragma unroll
                    for (int n = 0; n < 2; ++n) { const f32x4 bs = *(const f32x4*)(B + off + bj * HALF + n * 16);
                        *(f32x4*)(Oo + off + bj * HALF + n * 16) = bs + gv[bj][n] * acc[ai][bj][m][n]; } }
    }
};
struct EpiSqrelu {
    static constexpr bool PERM = true, AFTER_DRAIN = false;
    bf16* O;
    __device__ __forceinline__ void operator()(const f32x4 (&acc)[2][2][4][2], const Unit& u, int wr, int wc, int fr, int fq) const {
        const int row0 = u.pm * BM + wr * 64 + fr, col0 = u.pn * BM + wc * 32 + 8 * fq;
#pragma unroll
        for (int ai = 0; ai < 2; ++ai)
#pragma unroll
            for (int m = 0; m < 4; ++m) { bf16* rowp = O + (size_t)(row0 + ai * HALF + m * 16) * DFF + col0;
#pragma unroll
                for (int bj = 0; bj < 2; ++bj) { f32x4 v0 = acc[ai][bj][m][0], v1 = acc[ai][bj][m][1];
                    v0 = __builtin_elementwise_max(v0, (f32x4){0.f, 0.f, 0.f, 0.f}); v1 = __builtin_elementwise_max(v1, (f32x4){0.f, 0.f, 0.f, 0.f});
                    *(v4u*)(rowp + bj * HALF) = pack2x4(v0 * v0, v1 * v1); } }
    }
};
struct EpiProj1 {
    static constexpr bool PERM = true, AFTER_DRAIN = false;
    bf16* O; const float* LB;
    __device__ __forceinline__ void operator()(const f32x4 (&acc)[2][2][4][2], const Unit& u, int wr, int wc, int fr, int fq) const {
        const int row0 = u.pm * BM + wr * 64 + fr, col0 = u.pn * BM + wc * 32 + 8 * fq;
        const int kind = u.pn >> 2;
        const bool gatek = (kind == 1) || (kind == 2);
        f32x4 lb[2][2];
#pragma unroll
        for (int bj = 0; bj < 2; ++bj)
#pragma unroll
            for (int n = 0; n < 2; ++n) lb[bj][n] = gatek ? *(const f32x4*)(LB + (size_t)(kind - 1) * 1024 + ((col0 + bj * HALF) & 1023) + 4 * n) : (f32x4){0.f, 0.f, 0.f, 0.f};
#pragma unroll
        for (int ai = 0; ai < 2; ++ai)
#pragma unroll
            for (int m = 0; m < 4; ++m) { bf16* rowp = O + (size_t)(row0 + ai * HALF + m * 16) * 5120 + col0;
#pragma unroll
                for (int bj = 0; bj < 2; ++bj) { const f32x4 v0 = acc[ai][bj][m][0], v1 = acc[ai][bj][m][1];
                    v4u w;
                    if (gatek) {
                        float l0[4], l1[4];
#pragma unroll
                        for (int i = 0; i < 4; ++i) { l0[i] = __logf(lb[bj][0][i] + (1.0f - lb[bj][0][i]) * sigmoidf_(v0[i])); l1[i] = __logf(lb[bj][1][i] + (1.0f - lb[bj][1][i]) * sigmoidf_(v1[i])); }
                        w.x = pk_f16(l0[0], l0[1]); w.y = pk_f16(l0[2], l0[3]); w.z = pk_f16(l1[0], l1[1]); w.w = pk_f16(l1[2], l1[3]);
                    } else w = pack2x4(v0, v1);
                    *(v4u*)(rowp + bj * HALF) = w; } }
    }
};

__device__ __forceinline__ void ret_naive_item(LAS unsigned char* lds, int it, const bf16* P0, const float* ret_logit, float* RETF, float* RETB) {
    const int tid = threadIdx.x, sub = tid >> 7, e = tid & 127;
    LAS float* qs = (LAS float*)(lds + sub * 16384); LAS float* ks = qs + 2048;
    const int seq = it * 4 + sub, b = seq >> 3, h = (seq >> 1) & 3, dir = seq & 1;
    const float gamma = 1.0f / (1.0f + expf(-ret_logit[dir * 4 + h]));
    float* OUT = dir ? RETB : RETF;
    float S[64];
#pragma unroll
    for (int d = 0; d < 64; ++d) S[d] = 0.f;
    for (int n0 = 0; n0 < CTXL + SEQL; n0 += 32) {
        { const int tok = e >> 2, seg = e & 3; const int row = rowof(n0 + tok, b, dir);
          const bf16* qp = P0 + (size_t)row * 2048 + h * 64 + seg * 16;
          const v4u a0 = *(const v4u*)qp, a1 = *(const v4u*)(qp + 8), b0 = *(const v4u*)(qp + 256), b1 = *(const v4u*)(qp + 264);
          float t[8];
          unpack8(a0, t); *(LAS f32x4*)(qs + tok * 64 + seg * 16) = (f32x4){t[0], t[1], t[2], t[3]}; *(LAS f32x4*)(qs + tok * 64 + seg * 16 + 4) = (f32x4){t[4], t[5], t[6], t[7]};
          unpack8(a1, t); *(LAS f32x4*)(qs + tok * 64 + seg * 16 + 8) = (f32x4){t[0], t[1], t[2], t[3]}; *(LAS f32x4*)(qs + tok * 64 + seg * 16 + 12) = (f32x4){t[4], t[5], t[6], t[7]};
          unpack8(b0, t); *(LAS f32x4*)(ks + tok * 64 + seg * 16) = (f32x4){t[0], t[1], t[2], t[3]}; *(LAS f32x4*)(ks + tok * 64 + seg * 16 + 4) = (f32x4){t[4], t[5], t[6], t[7]};
          unpack8(b1, t); *(LAS f32x4*)(ks + tok * 64 + seg * 16 + 8) = (f32x4){t[0], t[1], t[2], t[3]}; *(LAS f32x4*)(ks + tok * 64 + seg * 16 + 12) = (f32x4){t[4], t[5], t[6], t[7]}; }
        __syncthreads();
#pragma unroll 1
        for (int tt = 0; tt < 32; ++tt) {
            const int row = rowof(n0 + tt, b, dir);
            const float v = bf2f(P0[(size_t)row * 2048 + 512 + h * 128 + e]);
            float o = 0.f;
#pragma unroll
            for (int d = 0; d < 64; d += 4) { const f32x4 kq = *(const LAS f32x4*)(ks + tt * 64 + d), qq = *(const LAS f32x4*)(qs + tt * 64 + d);
#pragma unroll
                for (int i = 0; i < 4; ++i) { S[d + i] = gamma * S[d + i] + kq[i] * v; o += qq[i] * S[d + i]; } }
            OUT[(size_t)row * 512 + h * 128 + e] = o;
        }
        __syncthreads();
    }
}
__device__ __forceinline__ void s5_naive_item(int it, const bf16* P0, const f32x2* AB, const f32x2* BB, const float* c_re, const float* c_im, float* S5F, float* S5B) {
    const int tid = threadIdx.x, wave = tid >> 6, lane = tid & 63;
    const int seq = it * 8 + wave, b = seq >> 6, g = (seq >> 1) & 31, dir = seq & 1;
    const int idx = (dir * 32 + g) * 64 + lane;
    const f32x2 ab = AB[idx];
    float bbr[16], bbi[16], cr[16], ci[16];
#pragma unroll
    for (int m = 0; m < 16; ++m) { const f32x2 t = BB[(size_t)idx * 16 + m]; bbr[m] = t.x; bbi[m] = t.y;
        cr[m] = c_re[((size_t)(dir * 32 + g) * 16 + m) * 64 + lane]; ci[m] = c_im[((size_t)(dir * 32 + g) * 16 + m) * 64 + lane]; }
    float hr = 0.f, hi = 0.f;
    float* OUT = dir ? S5B : S5F;
    for (int n0 = 0; n0 < CTXL + SEQL; n0 += 64) {
        const int rowj = rowof(n0 + lane, b, dir);
        const v4u ua = *(const v4u*)(P0 + (size_t)rowj * 2048 + 1024 + g * 16), ub = *(const v4u*)(P0 + (size_t)rowj * 2048 + 1024 + g * 16 + 8);
#pragma unroll 1
        for (int tt = 0; tt < 64; ++tt) {
            v4u wa, wb;
            wa.x = __builtin_amdgcn_readlane(ua.x, tt); wa.y = __builtin_amdgcn_readlane(ua.y, tt); wa.z = __builtin_amdgcn_readlane(ua.z, tt); wa.w = __builtin_amdgcn_readlane(ua.w, tt);
            wb.x = __builtin_amdgcn_readlane(ub.x, tt); wb.y = __builtin_amdgcn_readlane(ub.y, tt); wb.z = __builtin_amdgcn_readlane(ub.z, tt); wb.w = __builtin_amdgcn_readlane(ub.w, tt);
            float uu[16]; { float t[8]; unpack8(wa, t);
#pragma unroll
                for (int i = 0; i < 8; ++i) uu[i] = t[i];
                unpack8(wb, t);
#pragma unroll
                for (int i = 0; i < 8; ++i) uu[8 + i] = t[i]; }
            float xr = 0.f, xi = 0.f;
#pragma unroll
            for (int m = 0; m < 16; ++m) { xr += bbr[m] * uu[m]; xi += bbi[m] * uu[m]; }
            const float nhr = ab.x * hr - ab.y * hi + xr, nhi = ab.x * hi + ab.y * hr + xi; hr = nhr; hi = nhi;
            float mine = 0.f;
#pragma unroll
            for (int m = 0; m < 16; ++m) { const float t = wave_sum(hr * cr[m] - hi * ci[m]); if (lane == m) mine = t; }
            const int row = rowof(n0 + tt, b, dir);
            if (lane < 16) OUT[(size_t)row * 512 + g * 16 + lane] = mine;
        }
    }
}
__device__ __forceinline__ void hgrn_naive_item(LAS unsigned char* lds, int it, const bf16* P1, bf16* OS) {
    const int tid = threadIdx.x, sub = tid >> 7, e = tid & 127;
    LAS float* fs = (LAS float*)(lds + sub * 24576); LAS float* ks = fs + 2048; LAS float* qs = ks + 2048;
    const int seq = it * 4 + sub, b = seq >> 3, h = seq & 7;
    for (int dir = 0; dir < 2; ++dir) {
        float S[128];
#pragma unroll
        for (int d = 0; d < 128; ++d) S[d] = 0.f;
        for (int n0 = 0; n0 < CTXL + SEQL; n0 += 16) {
            { const int tok = e >> 3, seg = e & 7; const int row = rowof(n0 + tok, b, dir);
              const bf16* qp = P1 + (size_t)row * 5120 + h * 128 + seg * 16; const bf16* lp = qp + 1024 + dir * 1024;
              const v4u a0 = *(const v4u*)qp, a1 = *(const v4u*)(qp + 8), l0 = *(const v4u*)lp, l1 = *(const v4u*)(lp + 8);
              float t[8]; const int o = tok * 128 + seg * 16;
              unpack8(a0, t); *(LAS f32x4*)(qs + o) = (f32x4){t[0], t[1], t[2], t[3]}; *(LAS f32x4*)(qs + o + 4) = (f32x4){t[4], t[5], t[6], t[7]};
              unpack8(a1, t); *(LAS f32x4*)(qs + o + 8) = (f32x4){t[0], t[1], t[2], t[3]}; *(LAS f32x4*)(qs + o + 12) = (f32x4){t[4], t[5], t[6], t[7]};
              float f[16]; f[0] = f16lo(l0.x); f[1] = f16hi(l0.x); f[2] = f16lo(l0.y); f[3] = f16hi(l0.y); f[4] = f16lo(l0.z); f[5] = f16hi(l0.z); f[6] = f16lo(l0.w); f[7] = f16hi(l0.w);
              f[8] = f16lo(l1.x); f[9] = f16hi(l1.x); f[10] = f16lo(l1.y); f[11] = f16hi(l1.y); f[12] = f16lo(l1.z); f[13] = f16hi(l1.z); f[14] = f16lo(l1.w); f[15] = f16hi(l1.w);
#pragma unroll
              for (int i = 0; i < 16; ++i) f[i] = expf(f[i]);
#pragma unroll
              for (int i = 0; i < 16; i += 4) { *(LAS f32x4*)(fs + o + i) = (f32x4){f[i], f[i + 1], f[i + 2], f[i + 3]}; *(LAS f32x4*)(ks + o + i) = (f32x4){1.f - f[i], 1.f - f[i + 1], 1.f - f[i + 2], 1.f - f[i + 3]}; } }
            __syncthreads();
#pragma unroll 1
            for (int tt = 0; tt < 16; ++tt) {
                const int n = n0 + tt; const int row = rowof(n, b, dir);
                const float v = bf2f(P1[(size_t)row * 5120 + 3072 + h * 128 + e]);
                float o = 0.f;
#pragma unroll
                for (int d = 0; d < 128; d += 4) { const f32x4 ff = *(const LAS f32x4*)(fs + tt * 128 + d), kk = *(const LAS f32x4*)(ks + tt * 128 + d), qq = *(const LAS f32x4*)(qs + tt * 128 + d);
#pragma unroll
                    for (int i = 0; i < 4; ++i) { S[d + i] = ff[i] * S[d + i] + kk[i] * v; o += qq[i] * S[d + i]; } }
                if (n >= CTXL) { bf16* op = OS + (size_t)row * 1024 + h * 128 + e; if (dir == 0) *op = (bf16)f2bf(o); else *op = (bf16)f2bf(bf2f(*op) + o); }
            }
            __syncthreads();
        }
    }
}

struct Args { const float* in[28]; float* out; unsigned char* ws; };
enum { I_X = 0, I_C, I_CTX, I_CCTX, I_WMOD, I_BMOD, I_NMIX, I_NMLP, I_W1, I_W2, I_ABWIN, I_ABWOUT, I_RETL, I_S5ARE, I_S5AIM, I_S5DT, I_S5BRE, I_S5BIM, I_S5CRE, I_S5CIM, I_S5D, I_S5WGLU, I_S5BGLU, I_HGWIN, I_HGWOUT, I_HGLB, I_HGNORM, I_NFIN };

__global__ void __launch_bounds__(NWAVES * 64, 2) mk_fwd(Args args) {
    extern __shared__ __attribute__((aligned(16))) unsigned char lds_raw[];
    LAS unsigned char* lds = (LAS unsigned char*)lds_raw;
    volatile LAS unsigned* MISC = (volatile LAS unsigned*)(lds + MISC_OFF);
    const int tid = threadIdx.x, lane = tid & 63, wave = __builtin_amdgcn_readfirstlane(tid >> 6);
    const int G = gridDim.x;
    const int vcu = (G % 8 == 0) ? ((int)blockIdx.x % 8) * (G / 8) + (int)blockIdx.x / 8 : (int)blockIdx.x;
    const int gw = vcu * NWAVES + wave, NGW = G * NWAVES;
    unsigned char* ws = args.ws;
    gu32* ctl = (gu32*)(ws + WS_CTL);
    for (int u = tid; u < (LDS_BYTES - LDSCTL_OFF) / 4; u += NWAVES * 64) ((LAS unsigned*)(lds + LDSCTL_OFF))[u] = 0u;
    __syncthreads();
    XcdBarrier bar = xcd_barrier_post((unsigned*)(ctl + CW_BAR), MISC + 8);
#define GRID_BAR() xcd_barrier(bar)

    float* MOD = (float*)(ws + WS_MOD); float* CS = (float*)(ws + WS_CS);
    f32x2* AB = (f32x2*)(ws + WS_S5T); f32x2* BB = (f32x2*)(ws + WS_S5T_BB); float* LB = (float*)(ws + WS_LB);
    float* HC = (float*)(ws + WS_HC);
    bf16* Win0 = (bf16*)(ws + WS_WIN0); bf16* Wout0 = (bf16*)(ws + WS_WOUT0); bf16* Wglu = (bf16*)(ws + WS_WGLU);
    bf16* W1t = (bf16*)(ws + WS_W1); bf16* W2t = (bf16*)(ws + WS_W2); bf16* Whg = (bf16*)(ws + WS_WHG); bf16* Whgo = (bf16*)(ws + WS_WHGO);
    bf16* XN = (bf16*)(ws + WS_XN); bf16* P0b = (bf16*)(ws + WS_P0); bf16* P1b = (bf16*)(ws + WS_P1); bf16* Hb = (bf16*)(ws + WS_H);
    float* RETF = (float*)(ws + WS_RETF); float* RETB = (float*)(ws + WS_RETB); float* S5F = (float*)(ws + WS_S5F); float* S5B = (float*)(ws + WS_S5B);
    bf16* RZ = (bf16*)(ws + WS_RETF); bf16* Yb = (bf16*)(ws + WS_Y); bf16* OS = (bf16*)(ws + WS_XN);
    float* OUT = args.out;

    {
        LAS float* scr = (LAS float*)(lds + RING_OFF + wave * 16384);
        constexpr int I_A = 16 * 64, I_B = 16 * 32, I_G = 8 * 16, I_1 = 16 * 128, I_2 = 64 * 32, I_H = 16 * 160, I_O = 16 * 32;
        constexpr int NITEMS = I_A + I_B + I_G + 2 * I_1 + 2 * I_2 + I_H + I_O;
        for (int it = gw; it < NITEMS; it += NGW) {
            int r = it;
            if (r < I_A) { p0_transpose_item<true>(args.in[I_ABWIN], 1024, 2048, Win0, scr, r, lane); continue; } r -= I_A;
            if (r < I_B) { p0_transpose_item<false>(args.in[I_ABWOUT], 1024, 1024, Wout0, scr, r, lane); continue; } r -= I_B;
            if (r < I_G) { p0_transpose_item<false>(args.in[I_S5WGLU], 512, 512, Wglu, scr, r, lane); continue; } r -= I_G;
            if (r < 2 * I_1) { const int l = r / I_1; p0_transpose_item<false>(args.in[I_W1] + (size_t)l * 1024 * 4096, 1024, 4096, W1t + (size_t)l * 4096 * 1024, scr, r % I_1, lane); continue; } r -= 2 * I_1;
            if (r < 2 * I_2) { const int l = r / I_2; p0_transpose_item<false>(args.in[I_W2] + (size_t)l * 1024 * 4096, 4096, 1024, W2t + (size_t)l * 4096 * 1024, scr, r % I_2, lane); continue; } r -= 2 * I_2;
            if (r < I_H) { p0_transpose_item<false>(args.in[I_HGWIN], 1024, 5120, Whg, scr, r, lane); continue; } r -= I_H;
            p0_transpose_item<false>(args.in[I_HGWOUT], 1024, 1024, Whgo, scr, r, lane);
        }
        __syncthreads();
        if ((int)blockIdx.x < 96) {
            LAS float* Ssil = (LAS float*)lds; LAS float* red = (LAS float*)(lds + 36864);
            for (int i = tid; i < 9 * 1024; i += NWAVES * 64) { const int r = i >> 10, k = i & 1023; const float v = r < 8 ? args.in[I_C][r * 1024 + k] : args.in[I_CCTX][k]; Ssil[i] = v / (1.0f + expf(-v)); }
            __syncthreads();
            for (int it = blockIdx.x; it < 96; it += G) {
                const int l = it / 48, col0 = (it % 48) * 128, cgp = tid & 31, ksl = tid >> 5;
                const float* W = args.in[I_WMOD] + (size_t)l * 1024 * NMOD + col0 + 4 * cgp;
                f32x4 a[9];
#pragma unroll
                for (int r = 0; r < 9; ++r) a[r] = (f32x4){0.f, 0.f, 0.f, 0.f};
                for (int kk = 0; kk < 64; ++kk) { const int k = ksl * 64 + kk; const f32x4 w = *(const f32x4*)(W + (size_t)k * NMOD);
#pragma unroll
                    for (int r = 0; r < 9; ++r) a[r] += w * Ssil[r * 1024 + k]; }
#pragma unroll
                for (int r = 0; r < 9; ++r) *(LAS f32x4*)(red + (ksl * 9 + r) * 128 + 4 * cgp) = a[r];
                __syncthreads();
                for (int o = tid; o < 9 * 128; o += NWAVES * 64) { const int r = o >> 7, cc = o & 127; float s = args.in[I_BMOD][l * NMOD + col0 + cc];
                    for (int q = 0; q < 16; ++q) s += red[(q * 9 + r) * 128 + cc];
                    MOD[(size_t)(l * 9 + r) * NMOD + col0 + cc] = s; }
                __syncthreads();
            }
        }
        const int gt = gw * 64 + lane, NT = NGW * 64;
        for (int i = gt; i < SEQL * 32; i += NT) { const int t = i >> 5, dd = i & 31; const float inv = powf(10000.0f, -(float)(dd & 15) / 16.0f);
            const float a = (dd < 16 ? (float)(t >> 6) : (float)(t & 63)) * inv; CS[2 * i] = cosf(a); CS[2 * i + 1] = sinf(a); }
        for (int i = gt; i < 2 * 32 * 64; i += NT) {
            const float dt = expf(args.in[I_S5DT][i >> 6]); const float are = args.in[I_S5ARE][i], aim = args.in[I_S5AIM][i];
            const float mag = expf(are * dt), ang = aim * dt; const float abr = mag * cosf(ang), abi = mag * sinf(ang);
            const float nr = abr - 1.0f, ni = abi, den = are * are + aim * aim; const float fr = (nr * are + ni * aim) / den, fi = (ni * are - nr * aim) / den;
            AB[i] = (f32x2){abr, abi};
            for (int m = 0; m < 16; ++m) { const float br = args.in[I_S5BRE][(size_t)i * 16 + m], bi = args.in[I_S5BIM][(size_t)i * 16 + m]; BB[(size_t)i * 16 + m] = (f32x2){fr * br - fi * bi, fr * bi + fi * br}; }
        }
        for (int i = gt; i < 2 * 1024; i += NT) { const int d = i >> 10, j = i & 1023; const float x0 = args.in[I_HGLB][(d * 2 + 0) * 1024 + j], x1 = args.in[I_HGLB][(d * 2 + 1) * 1024 + j];
            const float mx = fmaxf(x0, x1), e0 = expf(x0 - mx), e1 = expf(x1 - mx); const float g0 = e0 / (e0 + e1), g1 = e1 / (e0 + e1); LB[i] = (g0 + g1) - g0; }
    }
    GRID_BAR();
    norm_mod_rows(args.in[I_X], args.in[I_CTX], MT, args.in[I_NMIX], MOD, 0, DM, XN, gw, NGW, lane);
    GRID_BAR();
    { pg8::Gemm g{XN, Win0, MT, 2048, 1024}; pg8::StaticOrder S; S.init(MT, 2048, G, (int)blockIdx.x); EpiProj0 E{P0b, CS};
      pg8::gemm_phase<EpiProj0, pg8::StaticOrder, true, true>(lds + RING_OFF, g, S, E); }
    GRID_BAR();
    { const int it = blockIdx.x;
      for (int i = it; i < 80; i += G) { if (i < 16) ret_naive_item(lds, i, P0b, args.in[I_RETL], RETF, RETB); else s5_naive_item(i - 16, P0b, AB, BB, args.in[I_S5CRE], args.in[I_S5CIM], S5F, S5B); } }
    GRID_BAR();
    merge0_rows(RETF, RETB, S5F, S5B, P0b, args.in[I_S5D], RZ, Yb, gw, NGW, lane);
    GRID_BAR();
    { pg8::Gemm g{Yb, Wglu, MT, 512, 512}; pg8::StaticOrder S; S.init(MT, 512, G, (int)blockIdx.x); EpiGlu E{Yb, args.in[I_S5BGLU], RZ + 512};
      pg8::gemm_phase<EpiGlu, pg8::StaticOrder, true, true>(lds + RING_OFF, g, S, E); }
    GRID_BAR();
    { pg8::Gemm g{RZ, Wout0, MT, 1024, 1024}; pg8::StaticOrder S; S.init(MT, 1024, G, (int)blockIdx.x); EpiResid E{args.in[I_X], args.in[I_CTX], OUT, HC, MOD + 2 * DM};
      pg8::gemm_phase<EpiResid, pg8::StaticOrder, true, true>(lds + RING_OFF, g, S, E); }
    GRID_BAR();
    norm_mod_rows(OUT, HC, MT, args.in[I_NMLP], MOD, 3 * DM, 4 * DM, XN, gw, NGW, lane);
    GRID_BAR();
    { pg8::Gemm g{XN, W1t, MT, DFF, 1024}; pg8::StaticOrder S; S.init(MT, DFF, G, (int)blockIdx.x); EpiSqrelu E{Hb};
      pg8::gemm_phase<EpiSqrelu, pg8::StaticOrder, true, true>(lds + RING_OFF, g, S, E); }
    GRID_BAR();
    { pg8::Gemm g{Hb, W2t, MT, 1024, DFF}; pg8::StaticOrder S; S.init(MT, 1024, G, (int)blockIdx.x); EpiResid E{OUT, HC, OUT, HC, MOD + 5 * DM};
      pg8::gemm_phase<EpiResid, pg8::StaticOrder, true, true>(lds + RING_OFF, g, S, E); }
    GRID_BAR();
    const float* MOD1 = MOD + (size_t)9 * NMOD;
    norm_mod_rows(OUT, HC, MT, args.in[I_NMIX] + DM, MOD1, 0, DM, XN, gw, NGW, lane);
    GRID_BAR();
    { pg8::Gemm g{XN, Whg, MT, 5120, 1024}; pg8::StaticOrder S; S.init(MT, 5120, G, (int)blockIdx.x); EpiProj1 E{P1b, LB};
      pg8::gemm_phase<EpiProj1, pg8::StaticOrder, true, true>(lds + RING_OFF, g, S, E); }
    GRID_BAR();
    for (int i = blockIdx.x; i < 16; i += G) hgrn_naive_item(lds, i, P1b, OS);
    GRID_BAR();
    merge1_rows(OS, P1b, args.in[I_HGNORM], gw, NGW, lane);
    GRID_BAR();
    { pg8::Gemm g{OS, Whgo, ML, 1024, 1024}; pg8::StaticOrder S; S.init(ML, 1024, G, (int)blockIdx.x); EpiResid E{OUT, HC, OUT, HC, MOD1 + 2 * DM};
      pg8::gemm_phase<EpiResid, pg8::StaticOrder, true, true>(lds + RING_OFF, g, S, E); }
    GRID_BAR();
    norm_mod_rows(OUT, HC, ML, args.in[I_NMLP] + DM, MOD1, 3 * DM, 4 * DM, XN, gw, NGW, lane);
    GRID_BAR();
    { pg8::Gemm g{XN, W1t + (size_t)DFF * 1024, ML, DFF, 1024}; pg8::StaticOrder S; S.init(ML, DFF, G, (int)blockIdx.x); EpiSqrelu E{Hb};
      pg8::gemm_phase<EpiSqrelu, pg8::StaticOrder, true, true>(lds + RING_OFF, g, S, E); }
    GRID_BAR();
    { pg8::Gemm g{Hb, W2t + (size_t)DFF * 1024, ML, 1024, DFF}; pg8::StaticOrder S; S.init(ML, 1024, G, (int)blockIdx.x); EpiResid E{OUT, HC, OUT, HC, MOD1 + 5 * DM};
      pg8::gemm_phase<EpiResid, pg8::StaticOrder, true, true>(lds + RING_OFF, g, S, E); }
    GRID_BAR();
    final_norm_rows(OUT, args.in[I_NFIN], gw, NGW, lane);
}

extern "C" void kernel_launch(void* const* d_in, const int* in_sizes, int n_in, void* d_out, int out_size, void* d_ws, size_t ws_size, hipStream_t stream) {
    static int grid = 0;
    if (grid == 0) {
        if (n_in != 28 || in_sizes[0] != ML * DM || out_size != ML * DM || ws_size < WS_END) { fprintf(stderr, "kernel_launch: unexpected shapes (n_in %d, in0 %d, out %d, ws %zu)\n", n_in, n_in > 0 ? in_sizes[0] : -1, out_size, ws_size); grid = -1; return; }
        int dev = 0, cus = 0, per_cu = 0;
        if (hipGetDevice(&dev) != hipSuccess || hipDeviceGetAttribute(&cus, hipDeviceAttributeMultiprocessorCount, dev) != hipSuccess) { grid = -1; return; }
        if (hipFuncSetAttribute((const void*)mk_fwd, hipFuncAttributeMaxDynamicSharedMemorySize, LDS_BYTES) != hipSuccess) { fprintf(stderr, "kernel_launch: hipFuncSetAttribute failed\n"); grid = -1; return; }
        if (hipOccupancyMaxActiveBlocksPerMultiprocessor(&per_cu, (const void*)mk_fwd, NWAVES * 64, LDS_BYTES) != hipSuccess || per_cu < 1) { fprintf(stderr, "kernel_launch: occupancy query says %d blocks per CU\n", per_cu); }
        (void)hipGetLastError();
        grid = cus;
    }
    if (grid < 0) return;
    if (hipMemsetAsync((char*)d_ws + WS_CTL, 0, CTL_ZERO_BYTES, stream) != hipSuccess) return;
    Args a{};
    for (int i = 0; i < 28; ++i) a.in[i] = (const float*)d_in[i];
    a.out = (float*)d_out; a.ws = (unsigned char*)d_ws;
    hipLaunchKernelGGL(mk_fwd, dim3(grid), dim3(NWAVES * 64), LDS_BYTES, stream, a);
}
```

```cpp
#include <hip/hip_runtime.h>
#include <cstdio>
#include <cstdint>

namespace pg8 {
#define PG8_LAS __attribute__((address_space(3)))
typedef unsigned short bf16_t;
typedef short bf16x8 __attribute__((ext_vector_type(8)));
typedef float f32x4 __attribute__((ext_vector_type(4)));
typedef unsigned u32x4 __attribute__((ext_vector_type(4)));
constexpr int BM = 256, BK = 64, HALF = 128, HTB = HALF * BK * 2, STAGE_BYTES = 8 * HTB, NXCD = 8, WGM = 8;

__host__ __device__ __forceinline__ int lds_byte(int r, int c) { const int st = (r >> 4) * 2 + (c >> 5), rr = r & 15, cc = c & 31, ob = rr * 64 + cc * 2; return st * 1024 + (ob ^ (((ob >> 9) & 1) << 5)); }
__host__ __device__ __forceinline__ void stage_rc(int b, int& R, int& C) { const int st = b / 1024, sb = b % 1024, swz = sb ^ (((sb >> 9) & 1) << 5); R = (st >> 1) * 16 + swz / 64; C = (st & 1) * 32 + (swz % 64) / 2; }
__host__ __device__ __forceinline__ int perm32(int rho) { const int n = rho >> 4, i = rho & 15; return 8 * (i >> 2) + 4 * n + (i & 3); }

struct Unit { int pm, pn; };
struct Gemm { const bf16_t* A; const bf16_t* Bt; int M, N, K, lda, ldb; };

struct StaticOrder {
    int nM, nN, nwg, G, c;
    __host__ __device__ void init(int M, int N, int G_, int c_) { nM = M / BM; nN = N / BM; nwg = nM * nN; G = G_; c = c_; }
    __host__ __device__ bool next(int i, Unit& u) const {
        const long L = (long)i * G + c; if (L >= nwg) return false;
        int wgid = (int)L; { const int q = nwg / NXCD, r = nwg % NXCD, xcd = wgid % NXCD, off = wgid / NXCD; wgid = (xcd < r ? xcd * (q + 1) : r * (q + 1) + (xcd - r) * q) + off; }
        const int nig = WGM * nN, gid = wgid / nig, fm = gid * WGM, gsz = (nM - fm) < WGM ? (nM - fm) : WGM;
        u.pm = fm + ((wgid % nig) % gsz); u.pn = (wgid % nig) / gsz; return true;
    }
    __device__ __forceinline__ void a_ready(const Unit&) const {}
    __device__ __forceinline__ void done(const Unit&) const {}
};

struct BatchOrder {
    int nb, tm, tn, G, c;
    __host__ __device__ void init(int nb_, int tm_, int tn_, int G_, int c_) { nb = nb_; tm = tm_; tn = tn_; G = G_; c = c_; }
    __host__ __device__ bool next(int i, Unit& u) const {
        const long L = (long)i * G + c; if (c < 0 || L >= (long)nb * tm * tn) return false;
        const int per = tm * tn, g = (int)L / per, rem = (int)L % per;
        u.pm = g * tm + rem % tm; u.pn = g * tn + rem / tm; return true;
    }
    __device__ __forceinline__ void a_ready(const Unit&) const {}
    __device__ __forceinline__ void done(const Unit&) const {}
};

__device__ __forceinline__ unsigned cvt_pk_bf16(float lo, float hi) { unsigned r; asm volatile("v_cvt_pk_bf16_f32 %0, %1, %2" : "=v"(r) : "v"(lo), "v"(hi)); return r; }

template <class Epi, class Sched, bool ALIGN_EPI = false, bool SP2 = false>
__device__ __forceinline__ void gemm_phase(PG8_LAS unsigned char* lds, const Gemm g, const Sched& S, const Epi& E) {
    int tid_ = threadIdx.x; asm volatile("" : "+v"(tid_));
    const int tid = tid_, wid = __builtin_amdgcn_readfirstlane(tid >> 6), lane = tid & 63, wr = wid >> 2, wc = wid & 3, fr = lane & 15, fq = lane >> 4;
    const int K = g.K, nt = K / BK;
    unsigned voffA[2], voffB[2];
#pragma unroll
    for (int i = 0; i < 2; ++i) { int R, C; stage_rc(tid * 16 + i * 8192, R, C); const int Rb = Epi::PERM ? ((R & ~31) + perm32(R & 31)) : R;
        voffA[i] = (unsigned)(R * g.lda + C) * 2u; voffB[i] = (unsigned)(Rb * g.ldb + C) * 2u; }
    const size_t kstep = (size_t)(BK * 2);
    const size_t hstepA = (size_t)HALF * g.lda * 2, hstepB = (size_t)HALF * g.ldb * 2;
    const size_t tstepA = 2 * hstepA, tstepB = 2 * hstepB;
    const unsigned ldsw = (unsigned)wid * 1024u;
    const int aoff = lds_byte(wr * 64 + fr, fq * 8), boff = lds_byte(wc * 32 + fr, fq * 8);
#define PG8_SA(b, h) (((b) * 2 + (h)) * HTB)
#define PG8_SB(b, h) ((4 + (b) * 2 + (h)) * HTB)
#define PG8_STAGE(bufoff, gbase, voff) do { _Pragma("unroll") for (int _i = 0; _i < 2; ++_i) \
        __builtin_amdgcn_global_load_lds((const unsigned*)((const char*)(gbase) + (voff)[_i]), (PG8_LAS unsigned*)(lds + (bufoff) + ldsw + _i * 8192), 16, 0, 0); } while (0)
#define PG8_LDA(dst, b, h) do { _Pragma("unroll") for (int m = 0; m < 4; ++m) _Pragma("unroll") for (int k = 0; k < 2; ++k) dst[m][k] = *(const PG8_LAS bf16x8*)(lds + PG8_SA(b, h) + aoff + m * 2048 + k * 1024); } while (0)
#define PG8_LDB(dst, b, h) do { _Pragma("unroll") for (int n = 0; n < 2; ++n) _Pragma("unroll") for (int k = 0; k < 2; ++k) dst[n][k] = *(const PG8_LAS bf16x8*)(lds + PG8_SB(b, h) + boff + n * 2048 + k * 1024); } while (0)
#define PG8_MMA(ai, bj, At, Bt) do { __builtin_amdgcn_s_setprio(1); _Pragma("unroll") for (int m = 0; m < 4; ++m) _Pragma("unroll") for (int n = 0; n < 2; ++n) _Pragma("unroll") for (int k = 0; k < 2; ++k) \
        acc[ai][bj][m][n] = __builtin_amdgcn_mfma_f32_16x16x32_bf16(Bt[n][k], At[m][k], acc[ai][bj][m][n], 0, 0, 0); __builtin_amdgcn_s_setprio(0); } while (0)
#define PG8_WAIT_V(n) asm volatile("s_waitcnt vmcnt(" #n ")" ::: "memory")
#define PG8_WAIT_L(n) asm volatile("s_waitcnt lgkmcnt(" #n ")" ::: "memory")
#define PG8_BAR __builtin_amdgcn_s_barrier()
#define PG8_SCHED __builtin_amdgcn_sched_barrier(0)
    Unit cur, nxt; int ui = 0;
    if (!S.next(0, cur)) return;
    f32x4 acc[2][2][4][2];
#pragma unroll
    for (int a = 0; a < 2; ++a)
#pragma unroll
        for (int b = 0; b < 2; ++b)
#pragma unroll
            for (int m = 0; m < 4; ++m)
#pragma unroll
                for (int n = 0; n < 2; ++n) acc[a][b][m][n] = (f32x4){0.f, 0.f, 0.f, 0.f};
    bf16x8 At[4][2], B0[2][2], B1[2][2];
    const char* cA = (const char*)g.A + (size_t)cur.pm * tstepA; const char* cB = (const char*)g.Bt + (size_t)cur.pn * tstepB;
    S.a_ready(cur);
    if constexpr (SP2) {
        PG8_STAGE(PG8_SB(0, 0), cB, voffB); PG8_STAGE(PG8_SB(0, 1), cB + hstepB, voffB); PG8_STAGE(PG8_SA(0, 0), cA, voffA); PG8_STAGE(PG8_SA(0, 1), cA + hstepA, voffA);
        if (wr == 1) PG8_BAR;
        PG8_WAIT_V(2); PG8_BAR;
        PG8_STAGE(PG8_SB(1, 0), cB + kstep, voffB); PG8_STAGE(PG8_SA(1, 0), cA + kstep, voffA); PG8_STAGE(PG8_SB(1, 1), cB + hstepB + kstep, voffB);
        PG8_WAIT_V(6); PG8_BAR;
    } else {
        PG8_STAGE(PG8_SB(0, 0), cB, voffB); PG8_STAGE(PG8_SA(0, 0), cA, voffA); PG8_STAGE(PG8_SB(0, 1), cB + hstepB, voffB); PG8_STAGE(PG8_SA(0, 1), cA + hstepA, voffA);
        if (wr == 1) PG8_BAR;
        PG8_WAIT_V(4); PG8_BAR;
        PG8_STAGE(PG8_SB(1, 0), cB + kstep, voffB); PG8_STAGE(PG8_SA(1, 0), cA + kstep, voffA); PG8_STAGE(PG8_SB(1, 1), cB + hstepB + kstep, voffB);
        PG8_WAIT_V(6); PG8_BAR;
    }
    for (;;) {
        const bool has_next = S.next(ui + 1, nxt);
        const char* nA = has_next ? (const char*)g.A + (size_t)nxt.pm * tstepA : cA; const char* nB = has_next ? (const char*)g.Bt + (size_t)nxt.pn * tstepB : cB;
        for (int t = 0; t < nt; t += 2) {
            const bool last = (t == nt - 2);
            const char* a1 = cA + (size_t)(t + 1) * kstep;
            const char* a2 = last ? nA : cA + (size_t)(t + 2) * kstep; const char* b2 = last ? nB : cB + (size_t)(t + 2) * kstep;
            const char* a3 = a2 + kstep; const char* b3 = b2 + kstep;
            if (last && has_next) S.a_ready(nxt);
            if constexpr (SP2) {
            PG8_LDB(B0, 0, 0); PG8_LDB(B1, 0, 1); PG8_SCHED; PG8_LDA(At, 0, 0); PG8_STAGE(PG8_SA(1, 1), a1 + hstepA, voffA);
            PG8_WAIT_V(8); PG8_WAIT_L(0); PG8_BAR; PG8_MMA(0, 0, At, B0); PG8_MMA(0, 1, At, B1); PG8_BAR; PG8_SCHED;
            PG8_LDA(At, 0, 1); PG8_STAGE(PG8_SB(0, 0), b2, voffB); PG8_STAGE(PG8_SB(0, 1), b2 + hstepB, voffB); PG8_STAGE(PG8_SA(0, 0), a2, voffA);
            PG8_WAIT_V(8); PG8_WAIT_L(0); PG8_BAR; PG8_MMA(1, 0, At, B0); PG8_MMA(1, 1, At, B1); PG8_BAR; PG8_SCHED;
            PG8_LDB(B0, 1, 0); PG8_LDB(B1, 1, 1); PG8_SCHED; PG8_LDA(At, 1, 0); PG8_STAGE(PG8_SA(0, 1), a2 + hstepA, voffA);
            PG8_WAIT_V(8); PG8_WAIT_L(0); PG8_BAR; PG8_MMA(0, 0, At, B0); PG8_MMA(0, 1, At, B1); PG8_BAR; PG8_SCHED;
            PG8_LDA(At, 1, 1); PG8_STAGE(PG8_SB(1, 0), b3, voffB); PG8_STAGE(PG8_SB(1, 1), b3 + hstepB, voffB); PG8_STAGE(PG8_SA(1, 0), a3, voffA);
            PG8_WAIT_V(8); PG8_WAIT_L(0); PG8_BAR; PG8_MMA(1, 0, At, B0); PG8_MMA(1, 1, At, B1); PG8_BAR; PG8_SCHED;
            } else {
            PG8_LDB(B0, 0, 0); PG8_SCHED; PG8_LDA(At, 0, 0); PG8_STAGE(PG8_SA(1, 1), a1 + hstepA, voffA);
            PG8_WAIT_L(8); PG8_BAR; PG8_WAIT_L(0); PG8_MMA(0, 0, At, B0); PG8_BAR; PG8_SCHED;
            PG8_LDB(B1, 0, 1); PG8_STAGE(PG8_SB(0, 0), b2, voffB);
            PG8_BAR; PG8_WAIT_L(0); PG8_MMA(0, 1, At, B1); PG8_BAR;
            PG8_LDA(At, 0, 1); PG8_STAGE(PG8_SA(0, 0), a2, voffA);
            PG8_BAR; PG8_WAIT_L(0); PG8_MMA(1, 0, At, B0); PG8_BAR; PG8_SCHED;
            PG8_STAGE(PG8_SB(0, 1), b2 + hstepB, voffB);
            PG8_WAIT_V(6); PG8_BAR; PG8_MMA(1, 1, At, B1); PG8_BAR;
            PG8_LDB(B0, 1, 0); PG8_SCHED; PG8_LDA(At, 1, 0); PG8_STAGE(PG8_SA(0, 1), a2 + hstepA, voffA);
            PG8_WAIT_L(8); PG8_BAR; PG8_WAIT_L(0); PG8_MMA(0, 0, At, B0); PG8_BAR; PG8_SCHED;
            PG8_LDB(B1, 1, 1); PG8_STAGE(PG8_SB(1, 0), b3, voffB);
            PG8_BAR; PG8_WAIT_L(0); PG8_MMA(0, 1, At, B1); PG8_BAR;
            PG8_LDA(At, 1, 1); PG8_STAGE(PG8_SA(1, 0), a3, voffA);
            PG8_BAR; PG8_WAIT_L(0); PG8_MMA(1, 0, At, B0); PG8_BAR; PG8_SCHED;
            PG8_STAGE(PG8_SB(1, 1), b3 + hstepB, voffB);
            PG8_WAIT_V(6); PG8_BAR; PG8_MMA(1, 1, At, B1); PG8_BAR;
            }
        }
        if constexpr (ALIGN_EPI) { if (wr == 0) PG8_BAR; }
        if constexpr (!Epi::AFTER_DRAIN) { E(acc, cur, wr, wc, fr, fq); S.done(cur); }
        if (!has_next) break;
#pragma unroll
        for (int a = 0; a < 2; ++a)
#pragma unroll
            for (int b = 0; b < 2; ++b)
#pragma unroll
                for (int m = 0; m < 4; ++m)
#pragma unroll
                    for (int n = 0; n < 2; ++n) acc[a][b][m][n] = (f32x4){0.f, 0.f, 0.f, 0.f};
        cur = nxt; cA = nA; cB = nB; ++ui;
        if constexpr (ALIGN_EPI) { if (wr == 1) PG8_BAR; }
    }
    PG8_WAIT_V(0);
    if constexpr (!ALIGN_EPI) { if (wr == 0) PG8_BAR; }
    PG8_BAR;
#undef PG8_SA
#undef PG8_SB
#undef PG8_STAGE
#undef PG8_LDA
#undef PG8_LDB
#undef PG8_MMA
#undef PG8_WAIT_V
#undef PG8_WAIT_L
#undef PG8_BAR
#undef PG8_SCHED
}
}

#define GAS __attribute__((address_space(1)))
#define LAS __attribute__((address_space(3)))
typedef unsigned short bf16;
typedef unsigned v4u __attribute__((ext_vector_type(4)));
typedef unsigned v2u __attribute__((ext_vector_type(2)));
typedef float f32x4 __attribute__((ext_vector_type(4)));
typedef float f32x2 __attribute__((ext_vector_type(2)));

constexpr int NWAVES = 8;
constexpr int DM = 1024, NBATCH = 8, SEQL = 4096, CTXL = 256, DFF = 4096;
constexpr int ML = NBATCH * SEQL;
constexpr int MC = NBATCH * CTXL;
constexpr int MT = ML + MC;
constexpr int NMOD = 6 * DM;
constexpr float EPSN = 1e-6f;

constexpr size_t MiB = 1u << 20;
constexpr size_t WS_CTL = 0, CTL_ZERO_BYTES = 1 * MiB;
constexpr size_t WS_MOD = 1 * MiB;
constexpr size_t WS_CS = 2 * MiB;
constexpr size_t WS_S5T = 3 * MiB;
constexpr size_t WS_S5T_BB = WS_S5T + 32768, WS_LB = WS_S5T_BB + 524288;
constexpr size_t WS_HC = 4 * MiB;
constexpr size_t WS_WIN0 = 12 * MiB, WS_WOUT0 = 16 * MiB, WS_WGLU = 18 * MiB, WS_W1 = 19 * MiB  , WS_W2 = 35 * MiB  , WS_WHG = 51 * MiB, WS_WHGO = 61 * MiB;
constexpr size_t WS_XN = 64 * MiB;
constexpr size_t WS_BIG = 132 * MiB;
constexpr int P0LD = 1536;
constexpr size_t WS_P0 = WS_BIG;
constexpr int S5R = 1088, S5RP = 1280, S5K = 768;
constexpr size_t WS_UA = WS_BIG + 102 * MiB;
constexpr size_t WS_BC = WS_BIG + 162 * MiB;
constexpr size_t WS_WS5 = WS_BIG + 186 * MiB;
constexpr size_t WS_ULOC = WS_BIG + 194 * MiB;
constexpr size_t WS_SIN = WS_BIG + 228 * MiB;
constexpr size_t WS_RZ = WS_BIG + 262 * MiB;
constexpr size_t WS_HLOC = WS_XN;
constexpr size_t WS_H = WS_BIG;
constexpr size_t WS_P1 = WS_BIG;
constexpr size_t WS_Y = 472 * MiB;
constexpr size_t WS_END = 512 * MiB;

constexpr int CW_BAR = 4096;

constexpr int RING_OFF = 0, RING_BYTES = 131072;
constexpr int LDSCTL_OFF = 143360, MISC_OFF = LDSCTL_OFF + 320;
constexpr int LDS_BYTES = 147456;

typedef GAS unsigned gu32;
#define LDS_WAIT() asm volatile("s_waitcnt lgkmcnt(0)" ::: "memory")
__device__ __forceinline__ unsigned f2bf(float f) { unsigned u = __builtin_bit_cast(unsigned, f); return (u + 0x7fffu + ((u >> 16) & 1u)) >> 16; }
__device__ __forceinline__ unsigned pk2(float lo, float hi) { return f2bf(lo) | (f2bf(hi) << 16); }
__device__ __forceinline__ float bflo(unsigned w) { return __builtin_bit_cast(float, w << 16); }
__device__ __forceinline__ float bfhi(unsigned w) { return __builtin_bit_cast(float, w & 0xffff0000u); }
__device__ __forceinline__ float bf2f(bf16 h) { return __builtin_bit_cast(float, (unsigned)h << 16); }
typedef _Float16 h16x2 __attribute__((ext_vector_type(2)));
__device__ __forceinline__ unsigned pk_f16(float a, float b) { h16x2 v; v.x = (_Float16)a; v.y = (_Float16)b; return __builtin_bit_cast(unsigned, v); }
__device__ __forceinline__ float f16lo(unsigned w) { h16x2 v = __builtin_bit_cast(h16x2, w); return (float)v.x; }
__device__ __forceinline__ float f16hi(unsigned w) { h16x2 v = __builtin_bit_cast(h16x2, w); return (float)v.y; }
__device__ __forceinline__ float sigmoidf_(float x) { return 1.0f / (1.0f + __expf(-x)); }
__device__ __forceinline__ float siluf_(float x) { return x / (1.0f + __expf(-x)); }
__device__ __forceinline__ float gelu_tanh(float x) { const float u = 0.7978845608028654f * (x + 0.044715f * x * x * x); return 0.5f * x * (1.0f + tanhf(u)); }

#define XB_TMO      128
#define XB_XCNT(j)  (256  + 64 * (j))
#define XB_XSUB(j)  (1280 + 64 * (j))
#define XB_XGEN(j)  (2304 + 64 * (j))
#define XB_TOP      3328
#define XB_TOPGEN   3392
#define XCD_BAR_WORDS 3456
#define XB_SPIN_CAP (1u << 22)
__device__ __forceinline__ unsigned xb_ld(unsigned* p)              { return __hip_atomic_load(p, __ATOMIC_RELAXED, __HIP_MEMORY_SCOPE_AGENT); }
__device__ __forceinline__ unsigned xb_add(unsigned* p, unsigned v) { return __hip_atomic_fetch_add(p, v, __ATOMIC_RELAXED, __HIP_MEMORY_SCOPE_AGENT); }
__device__ __forceinline__ unsigned xb_xcc_id() { return (unsigned)__builtin_amdgcn_s_getreg((3 << 11) | 20) & 0xFu; }
#define XB_SPIN(cond, bar) do { unsigned _sp = 0; while (cond) { __builtin_amdgcn_s_sleep(1); \
    if ((++_sp & 255u) == 0u) { if (xb_ld(&(bar)[XB_TMO])) break; if (_sp > XB_SPIN_CAP) { atomicAdd(&(bar)[XB_TMO], 1u); break; } } } } while (0)
struct XcdBarrier { unsigned* bar; unsigned x; volatile LAS unsigned* st; };
__device__ __forceinline__ XcdBarrier xcd_barrier_post(unsigned* bar, volatile LAS unsigned* st) {
    XcdBarrier b; b.bar = bar; b.x = xb_xcc_id(); b.st = st;
    if (threadIdx.x == 0) (void)xb_add(&bar[XB_XCNT(b.x)], 1u);
    return b;
}
__device__ __forceinline__ void xcd_barrier_complete(unsigned* bar, unsigned x, unsigned& nloc, unsigned& nx) {
    const unsigned G = gridDim.x * gridDim.y * gridDim.z;
    unsigned sum, cnt, mine, sp = 0u;
    for (;;) {
        sum = 0u; cnt = 0u; mine = 0u;
#pragma unroll
        for (unsigned j = 0; j < 16; ++j) { const unsigned c = xb_ld(&bar[XB_XCNT(j)]); sum += c; cnt += (c > 0u) ? 1u : 0u; mine = (j == x) ? c : mine; }
        if (sum == G) break;
        __builtin_amdgcn_s_sleep(1);
        if ((++sp & 255u) == 0u) { if (xb_ld(&bar[XB_TMO])) break; if (sp > XB_SPIN_CAP) { atomicAdd(&bar[XB_TMO], 1u); break; } }
    }
    nloc = mine > 0u ? mine : 1u; nx = cnt > 0u ? cnt : 1u;
}
__device__ __forceinline__ void xcd_barrier(const XcdBarrier& b) {
    asm volatile("s_waitcnt vmcnt(0)" ::: "memory");
    __syncthreads();
    if (threadIdx.x == 0) {
        unsigned* bar = b.bar;
        __builtin_amdgcn_s_waitcnt(0);
        unsigned nloc = b.st[0], nx = b.st[1];
        if (nloc == 0u) { xcd_barrier_complete(bar, b.x, nloc, nx); b.st[0] = nloc; b.st[1] = nx; }
        const unsigned old = xb_add(&bar[XB_XSUB(b.x)], 1u);
        const unsigned gen = old / nloc;
        if (old + 1u == (gen + 1u) * nloc) {
            __builtin_amdgcn_fence(__ATOMIC_RELEASE, "agent");
            asm volatile("s_waitcnt vmcnt(0)" ::: "memory");
            const unsigned og = xb_add(&bar[XB_TOP], 1u);
            const unsigned tg = og / nx;
            if (og + 1u == (tg + 1u) * nx) xb_add(&bar[XB_TOPGEN], 1u);
            else XB_SPIN(xb_ld(&bar[XB_TOPGEN]) == tg, bar);
            __builtin_amdgcn_fence(__ATOMIC_ACQUIRE, "agent");
            xb_add(&bar[XB_XGEN(b.x)], 1u);
            asm volatile("s_waitcnt vmcnt(0)" ::: "memory");
        } else {
            XB_SPIN(xb_ld(&bar[XB_XGEN(b.x)]) == gen, bar);
            __builtin_amdgcn_fence(__ATOMIC_ACQUIRE, "agent");
            asm volatile("s_waitcnt vmcnt(0)" ::: "memory");
        }
    }
    __syncthreads();
}

__device__ __forceinline__ float wave_sum(float v) {
#pragma unroll
    for (int o = 1; o < 64; o <<= 1) v += __shfl_xor(v, o);
    return v;
}
__device__ __forceinline__ float sum16(float v) {
#pragma unroll
    for (int o = 1; o < 16; o <<= 1) v += __shfl_xor(v, o);
    return v;
}

__device__ __forceinline__ int rowof(int n, int b, int dir) {
    if (n < CTXL) { const int tc = dir ? (CTXL - 1 - n) : n; return ML + b * CTXL + tc; }
    const int tl = n - CTXL; const int t = dir ? (SEQL - 1 - tl) : tl; return b * SEQL + t;
}

__device__ __forceinline__ int permqk(int n) {
    const int d = n & 63, half = d >> 5, dd = d & 31, i = dd >> 2, j = dd & 3; return (n & ~63) + 8 * i + 4 * half + j;
}
template <bool PERMQK>
__device__ __forceinline__ void p0_transpose_item(const float* W, int K, int N, bf16* WT, LAS float* scr, int item, int lane) {
    const int nblk = N / 32, kb = item / nblk, nb = item % nblk, k0 = 64 * kb, n0 = 32 * nb;
#pragma unroll 8
    for (int i = 0; i < 32; ++i) { const int kk = 2 * i + (lane >> 5); scr[kk * 33 + (lane & 31)] = W[(size_t)(k0 + kk) * N + n0 + (lane & 31)]; }
    LDS_WAIT(); asm volatile("" ::: "memory");
    const int c = lane & 7;
#pragma unroll
    for (int j = 0; j < 4; ++j) { const int n = (lane >> 3) + 8 * j; const LAS float* s = scr + (8 * c) * 33 + n;
        v4u o; o.x = pk2(s[0 * 33], s[1 * 33]); o.y = pk2(s[2 * 33], s[3 * 33]); o.z = pk2(s[4 * 33], s[5 * 33]); o.w = pk2(s[6 * 33], s[7 * 33]);
        int nd = n0 + n; if (PERMQK && nd < 512) nd = permqk(nd);
        *(GAS v4u*)(WT + (size_t)nd * K + k0 + 8 * c) = o; }
    LDS_WAIT(); asm volatile("" ::: "memory");
}

__device__ __forceinline__ void norm_mod_rows(const float* hl, const float* hc, int nrows, const float* g, const float* mod, int shift_off, int scale_off, bf16* XN, int gw, int NGW, int lane) {
    for (int row = gw; row < nrows; row += NGW) {
        const float* xr = row < ML ? hl + (size_t)row * DM : hc + (size_t)(row - ML) * DM;
        const int mr = row < ML ? (row >> 12) : 8;
        const f32x4* x4 = (const f32x4*)xr + lane;
        f32x4 v[4]; float s = 0.f;
#pragma unroll
        for (int j = 0; j < 4; ++j) { v[j] = x4[64 * j]; s += (v[j].x * v[j].x + v[j].y * v[j].y) + (v[j].z * v[j].z + v[j].w * v[j].w); }
        const float rstd = 1.0f / sqrtf(wave_sum(s) * (1.f / DM) + EPSN);
        const f32x4* g4 = (const f32x4*)g + lane; const f32x4* sc4 = (const f32x4*)(mod + (size_t)mr * NMOD + scale_off) + lane; const f32x4* sh4 = (const f32x4*)(mod + (size_t)mr * NMOD + shift_off) + lane;
        unsigned long long* o8 = (unsigned long long*)(XN + (size_t)row * DM) + lane;
#pragma unroll
        for (int j = 0; j < 4; ++j) { const f32x4 gg = g4[64 * j], sc = sc4[64 * j], sh = sh4[64 * j];
            const f32x4 y = (v[j] * rstd) * gg * (sc + 1.0f) + sh;
            o8[64 * j] = (unsigned long long)pk2(y.x, y.y) | ((unsigned long long)pk2(y.z, y.w) << 32); }
    }
}
__device__ __forceinline__ void final_norm_rows(float* h, const float* g, int gw, int NGW, int lane) {
    for (int row = gw; row < ML; row += NGW) {
        f32x4* x4 = (f32x4*)(h + (size_t)row * DM) + lane;
        f32x4 v[4]; float s = 0.f;
#pragma unroll
        for (int j = 0; j < 4; ++j) { v[j] = x4[64 * j]; s += (v[j].x * v[j].x + v[j].y * v[j].y) + (v[j].z * v[j].z + v[j].w * v[j].w); }
        const float rstd = 1.0f / sqrtf(wave_sum(s) * (1.f / DM) + EPSN);
        const f32x4* g4 = (const f32x4*)g + lane;
#pragma unroll
        for (int j = 0; j < 4; ++j) x4[64 * j] = (v[j] * rstd) * g4[64 * j];
    }
}
__device__ __forceinline__ void unpack8(const v4u w, float (&o)[8]) { o[0] = bflo(w.x); o[1] = bfhi(w.x); o[2] = bflo(w.y); o[3] = bfhi(w.y); o[4] = bflo(w.z); o[5] = bfhi(w.z); o[6] = bflo(w.w); o[7] = bfhi(w.w); }
__device__ __forceinline__ v4u pack8(const float (&o)[8]) { v4u w; w.x = pk2(o[0], o[1]); w.y = pk2(o[2], o[3]); w.z = pk2(o[4], o[5]); w.w = pk2(o[6], o[7]); return w; }

__device__ __forceinline__ void merge1_rows(bf16* OS, const bf16* P1, const float* hgn, int gw, int NGW, int lane) {
    for (int row = gw; row < ML; row += NGW) {
#pragma unroll
        for (int half = 0; half < 2; ++half) {
            const int c0 = half * 512 + lane * 8;
            const v4u ow = *(const v4u*)(OS + (size_t)row * 1024 + c0), gw4 = *(const v4u*)(P1 + (size_t)row * 5120 + 4096 + c0);
            const f32x4 n0 = *(const f32x4*)(hgn + (c0 & 127)), n1 = *(const f32x4*)(hgn + (c0 & 127) + 4);
            float o[8], gg[8]; unpack8(ow, o); unpack8(gw4, gg);
            float ss = 0.f;
#pragma unroll
            for (int i = 0; i < 8; ++i) ss += o[i] * o[i];
            const float rs = 1.0f / sqrtf(sum16(ss) * (1.f / 128.f) + EPSN);
            const float nn[8] = {n0.x, n0.y, n0.z, n0.w, n1.x, n1.y, n1.z, n1.w};
            float r[8];
#pragma unroll
            for (int i = 0; i < 8; ++i) r[i] = o[i] * rs * nn[i] * siluf_(gg[i]);
            *(v4u*)(OS + (size_t)row * 1024 + c0) = pack8(r);
        }
    }
}

using pg8::Unit; using pg8::HALF; using pg8::BM;
__device__ __forceinline__ v4u pack2x4(const f32x4 v0, const f32x4 v1) { v4u w; w.x = pg8::cvt_pk_bf16(v0[0], v0[1]); w.y = pg8::cvt_pk_bf16(v0[2], v0[3]); w.z = pg8::cvt_pk_bf16(v1[0], v1[1]); w.w = pg8::cvt_pk_bf16(v1[2], v1[3]); return w; }

struct EpiProj0 {
    static constexpr bool PERM = true, AFTER_DRAIN = false;
    bf16* O; const float* CS; bf16* UA;
    __device__ __forceinline__ void operator()(const f32x4 (&acc)[2][2][4][2], const Unit& u, int wr, int wc, int fr, int fq) const {
        const int row0 = u.pm * BM + wr * 64 + fr, col0 = u.pn * BM + wc * 32 + 8 * fq;
        const bool lat = u.pm < ML / BM;
        const bool rope = (u.pn < 2) && lat; const float sc = (u.pn == 1) ? 0.125f : 1.0f;
        const bool isu = (u.pn == 4) || (u.pn == 5);
        const int ocol0 = (u.pn >= 6) ? col0 - 512 : col0;
        const int i4 = 4 * (4 * (wc & 1) + fq);
#pragma unroll
        for (int ai = 0; ai < 2; ++ai)
#pragma unroll
            for (int m = 0; m < 4; ++m) { const int row = row0 + ai * HALF + m * 16;
                f32x4 ca = (f32x4){1.f, 0.f, 1.f, 0.f}, cb = ca;
                if (rope) { const float* p = CS + ((size_t)(row & (SEQL - 1)) * 32 + i4) * 2; ca = *(const f32x4*)p; cb = *(const f32x4*)(p + 4); }
                bf16* rowp = O + (size_t)row * P0LD + ocol0;
                int r5, i5;
                if (lat) { const int t = row & (SEQL - 1); r5 = (row >> 12) * 136 + 8 + (t >> 5); i5 = t & 31; }
                else { const int rc = row - ML, t = rc & (CTXL - 1); r5 = (rc >> 8) * 136 + (t >> 5); i5 = t & 31; }
#pragma unroll
                for (int bj = 0; bj < 2; ++bj) { f32x4 v0 = acc[ai][bj][m][0], v1 = acc[ai][bj][m][1];
                    if (rope) {
                        const f32x4 lo = (f32x4){v0[0] * ca[0] - v1[0] * ca[1], v0[1] * ca[2] - v1[1] * ca[3], v0[2] * cb[0] - v1[2] * cb[1], v0[3] * cb[2] - v1[3] * cb[3]};
                        const f32x4 hi = (f32x4){v0[0] * ca[1] + v1[0] * ca[0], v0[1] * ca[3] + v1[1] * ca[2], v0[2] * cb[1] + v1[2] * cb[0], v0[3] * cb[3] + v1[3] * cb[2]};
                        v0 = lo; v1 = hi; }
                    v0 = v0 * sc; v1 = v1 * sc;
                    const v4u w = pack2x4(v0, v1);
                    if (isu) { const int c = col0 + bj * HALF - 1024, g5 = c >> 4, m0 = c & 15;
                        *(v4u*)(UA + ((size_t)(g5 * S5RP + r5) * S5K + i5 * 16 + m0)) = w; }
                    else *(v4u*)(rowp + bj * HALF) = w; } }
    }
};
struct EpiGlu {
    static constexpr bool PERM = true, AFTER_DRAIN = false;
    const bf16* Y; const float* b; bf16* Z;
    __device__ __forceinline__ void operator()(const f32x4 (&acc)[2][2][4][2], const Unit& u, int wr, int wc, int fr, int fq) const {
        const int row0 = u.pm * BM + wr * 64 + fr, col0 = u.pn * BM + wc * 32 + 8 * fq;
        f32x4 bv[2][2];
#pragma unroll
        for (int bj = 0; bj < 2; ++bj)
#pragma unroll
            for (int n = 0; n < 2; ++n) bv[bj][n] = *(const f32x4*)(b + col0 + bj * HALF + 4 * n);
#pragma unroll
        for (int ai = 0; ai < 2; ++ai)
#pragma unroll
            for (int m = 0; m < 4; ++m) { const int row = row0 + ai * HALF + m * 16;
#pragma unroll
                for (int bj = 0; bj < 2; ++bj) { const int col = col0 + bj * HALF;
                    const v4u yw = *(const v4u*)(Y + (size_t)row * 512 + col); float yy[8]; unpack8(yw, yy);
                    const f32x4 a0 = acc[ai][bj][m][0] + bv[bj][0], a1 = acc[ai][bj][m][1] + bv[bj][1];
                    const f32x4 z0 = (f32x4){yy[0] * sigmoidf_(a0[0]), yy[1] * sigmoidf_(a0[1]), yy[2] * sigmoidf_(a0[2]), yy[3] * sigmoidf_(a0[3])};
                    const f32x4 z1 = (f32x4){yy[4] * sigmoidf_(a1[0]), yy[5] * sigmoidf_(a1[1]), yy[6] * sigmoidf_(a1[2]), yy[7] * sigmoidf_(a1[3])};
                    *(v4u*)(Z + (size_t)row * 1024 + col) = pack2x4(z0, z1); } }
    }
};
struct EpiResid {
    static constexpr bool PERM = false, AFTER_DRAIN = false;
    const float* baseL; const float* baseC; float* outL; float* outC; const float* gate;
    __device__ __forceinline__ void operator()(const f32x4 (&acc)[2][2][4][2], const Unit& u, int wr, int wc, int fr, int fq) const {
        const bool ctx = u.pm >= ML / BM; const int mr = ctx ? 8 : (u.pm >> 4);
        const int row0 = (ctx ? u.pm - ML / BM : u.pm) * BM + wr * 64 + fr, col0 = u.pn * BM + wc * 32 + 4 * fq;
        const float* B = ctx ? baseC : baseL; float* Oo = ctx ? outC : outL;
        f32x4 gv[2][2];
#pragma unroll
        for (int bj = 0; bj < 2; ++bj)
#pragma unroll
            for (int n = 0; n < 2; ++n) gv[bj][n] = *(const f32x4*)(gate + (size_t)mr * NMOD + col0 + bj * HALF + n * 16);
#pragma unroll
        for (int ai = 0; ai < 2; ++ai)
#pragma unroll
            for (int m = 0; m < 4; ++m) { const size_t off = (size_t)(row0 + ai * HALF + m * 16) * DM + col0;
#pragma unroll
                for (int bj = 0; bj < 2; ++bj)
#pragma unroll
                    for (int n = 0; n < 2; ++n) { const f32x4 bs = *(const f32x4*)(B + off + bj * HALF + n * 16);
                        *(f32x4*)(Oo + off + bj * HALF + n * 16) = bs + gv[bj][n] * acc[ai][bj][m][n]; } }
    }
};
struct EpiSqrelu {
    static constexpr bool PERM = true, AFTER_DRAIN = false;
    bf16* O;
    __device__ __forceinline__ void operator()(const f32x4 (&acc)[2][2][4][2], const Unit& u, int wr, int wc, int fr, int fq) const {
        const int row0 = u.pm * BM + wr * 64 + fr, col0 = u.pn * BM + wc * 32 + 8 * fq;
#pragma unroll
        for (int ai = 0; ai < 2; ++ai)
#pragma unroll
            for (int m = 0; m < 4; ++m) { bf16* rowp = O + (size_t)(row0 + ai * HALF + m * 16) * DFF + col0;
#pragma unroll
                for (int bj = 0; bj < 2; ++bj) { f32x4 v0 = acc[ai][bj][m][0], v1 = acc[ai][bj][m][1];
                    v0 = __builtin_elementwise_max(v0, (f32x4){0.f, 0.f, 0.f, 0.f}); v1 = __builtin_elementwise_max(v1, (f32x4){0.f, 0.f, 0.f, 0.f});
                    *(v4u*)(rowp + bj * HALF) = pack2x4(v0 * v0, v1 * v1); } }
    }
};
struct EpiProj1 {
    static constexpr bool PERM = true, AFTER_DRAIN = false;
    bf16* O; const float* LB;
    __device__ __forceinline__ void operator()(const f32x4 (&acc)[2][2][4][2], const Unit& u, int wr, int wc, int fr, int fq) const {
        const int row0 = u.pm * BM + wr * 64 + fr, col0 = u.pn * BM + wc * 32 + 8 * fq;
        const int kind = u.pn >> 2;
        const bool gatek = (kind == 1) || (kind == 2);
        f32x4 lb[2][2];
#pragma unroll
        for (int bj = 0; bj < 2; ++bj)
#pragma unroll
            for (int n = 0; n < 2; ++n) lb[bj][n] = gatek ? *(const f32x4*)(LB + (size_t)(kind - 1) * 1024 + ((col0 + bj * HALF) & 1023) + 4 * n) : (f32x4){0.f, 0.f, 0.f, 0.f};
#pragma unroll
        for (int ai = 0; ai < 2; ++ai)
#pragma unroll
            for (int m = 0; m < 4; ++m) { bf16* rowp = O + (size_t)(row0 + ai * HALF + m * 16) * 5120 + col0;
#pragma unroll
                for (int bj = 0; bj < 2; ++bj) { const f32x4 v0 = acc[ai][bj][m][0], v1 = acc[ai][bj][m][1];
                    v4u w;
                    if (gatek) {
                        float l0[4], l1[4];
#pragma unroll
                        for (int i = 0; i < 4; ++i) { l0[i] = __logf(lb[bj][0][i] + (1.0f - lb[bj][0][i]) * sigmoidf_(v0[i])); l1[i] = __logf(lb[bj][1][i] + (1.0f - lb[bj][1][i]) * sigmoidf_(v1[i])); }
                        w.x = pk_f16(l0[0], l0[1]); w.y = pk_f16(l0[2], l0[3]); w.z = pk_f16(l1[0], l1[1]); w.w = pk_f16(l1[2], l1[3]);
                    } else w = pack2x4(v0, v1);
                    *(v4u*)(rowp + bj * HALF) = w; } }
    }
};

struct EpiHloc {
    static constexpr bool PERM = false, AFTER_DRAIN = false;
    float* C;
    __device__ __forceinline__ void operator()(const f32x4 (&acc)[2][2][4][2], const Unit& u, int wr, int wc, int fr, int fq) const {
        const int row0 = u.pm * BM + wr * 64 + fr, col0 = wc * 32 + 4 * fq;
#pragma unroll
        for (int ai = 0; ai < 2; ++ai)
#pragma unroll
            for (int m = 0; m < 4; ++m) { float* rowp = C + (size_t)(row0 + ai * HALF + m * 16) * 256 + col0;
#pragma unroll
                for (int bj = 0; bj < 2; ++bj)
#pragma unroll
                    for (int n = 0; n < 2; ++n) *(f32x4*)(rowp + bj * HALF + n * 16) = acc[ai][bj][m][n]; }
    }
};
struct EpiS5Out {
    static constexpr bool PERM = true, AFTER_DRAIN = false;
    const bf16* UA; const float* dskip; bf16* Y;
    __device__ __forceinline__ void operator()(const f32x4 (&acc)[2][2][4][2], const Unit& u, int wr, int wc, int fr, int fq) const {
        const int g5 = u.pm / 5, pml = u.pm - 5 * g5, pnl = u.pn - 2 * g5;
        const int r0 = pml * BM + wr * 64 + fr, col0 = pnl * BM + wc * 32 + 8 * fq;
#pragma unroll
        for (int ai = 0; ai < 2; ++ai)
#pragma unroll
            for (int m = 0; m < 4; ++m) { const int r = r0 + ai * HALF + m * 16;
                if (r < S5R) {
                    const int b = r / 136, ch = r - b * 136;
#pragma unroll
                    for (int bj = 0; bj < 2; ++bj) { const int col = col0 + bj * HALF, i5 = col >> 4, m0 = col & 15;
                        const int trow = ch < 8 ? ML + b * CTXL + ch * 32 + i5 : b * SEQL + (ch - 8) * 32 + i5;
                        const v4u uw = *(const v4u*)(UA + ((size_t)(g5 * S5RP + r) * S5K + col)); float uu[8]; unpack8(uw, uu);
                        const f32x4 d0 = *(const f32x4*)(dskip + g5 * 16 + m0), d1 = *(const f32x4*)(dskip + g5 * 16 + m0 + 4);
                        const f32x4 a0 = acc[ai][bj][m][0], a1 = acc[ai][bj][m][1];
                        const f32x4 y0 = (f32x4){gelu_tanh(a0[0] + d0[0] * uu[0]), gelu_tanh(a0[1] + d0[1] * uu[1]), gelu_tanh(a0[2] + d0[2] * uu[2]), gelu_tanh(a0[3] + d0[3] * uu[3])};
                        const f32x4 y1 = (f32x4){gelu_tanh(a1[0] + d1[0] * uu[4]), gelu_tanh(a1[1] + d1[1] * uu[5]), gelu_tanh(a1[2] + d1[2] * uu[6]), gelu_tanh(a1[3] + d1[3] * uu[7])};
                        *(v4u*)(Y + (size_t)trow * 512 + g5 * 16 + m0) = pack2x4(y0, y1); } } }
    }
};

__device__ __forceinline__ f32x2 cmul(f32x2 a, f32x2 b) { return (f32x2){a.x * b.x - a.y * b.y, a.x * b.y + a.y * b.x}; }
__device__ __forceinline__ void s5_tables_item(LAS unsigned char* lds, int g, const float* a_re, const float* a_im, const float* log_dt, const float* b_re, const float* b_im,
                                               const float* c_re, const float* c_im, bf16* Bc, bf16* Ws5) {
    const int tid = threadIdx.x;
    LAS f32x2* POW = (LAS f32x2*)lds;
    LAS f32x2* BBl = (LAS f32x2*)(lds + 33792);
    LAS f32x2* CCl = (LAS f32x2*)(lds + 50176);
    LAS float* KRN = (LAS float*)(lds + 66560);
    if (tid < 128) {
        const int d = tid >> 6, p = tid & 63, i = (d * 32 + g) * 64 + p;
        const float dt = expf(log_dt[d * 32 + g]); const float are = a_re[i], aim = a_im[i];
        const float mag = expf(are * dt), ang = aim * dt; const f32x2 ab = (f32x2){mag * cosf(ang), mag * sinf(ang)};
        const float nr = ab.x - 1.0f, ni = ab.y, den = are * are + aim * aim; const float fr = (nr * are + ni * aim) / den, fi = (ni * are - nr * aim) / den;
        f32x2 pw = (f32x2){1.f, 0.f};
        for (int e = 0; e <= 32; ++e) { POW[(d * 64 + p) * 33 + e] = pw; pw = cmul(pw, ab); }
        for (int n = 0; n < 16; ++n) { const float br = b_re[(size_t)i * 16 + n], bi = b_im[(size_t)i * 16 + n]; BBl[(d * 64 + p) * 16 + n] = (f32x2){fr * br - fi * bi, fr * bi + fi * br}; }
    }
    for (int o = tid; o < 2048; o += NWAVES * 64) { const int d = o >> 10, m = (o >> 6) & 15, p = o & 63; const size_t ci = ((size_t)(d * 32 + g) * 16 + m) * 64 + p; CCl[o] = (f32x2){c_re[ci], c_im[ci]}; }
    __syncthreads();
    for (int k = 0; k < 8; ++k) { const int o4 = tid + 512 * k, d = o4 >> 11, tau = (o4 >> 6) & 31, m = (o4 >> 2) & 15, nq = o4 & 3;
        float a0 = 0.f, a1 = 0.f, a2 = 0.f, a3 = 0.f;
        for (int p = 0; p < 64; ++p) { const f32x2 cp = cmul(CCl[(d * 16 + m) * 64 + p], POW[(d * 64 + p) * 33 + tau]); const LAS f32x2* bb = BBl + (d * 64 + p) * 16 + nq * 4;
            a0 += cp.x * bb[0].x - cp.y * bb[0].y; a1 += cp.x * bb[1].x - cp.y * bb[1].y; a2 += cp.x * bb[2].x - cp.y * bb[2].y; a3 += cp.x * bb[3].x - cp.y * bb[3].y; }
        *(LAS f32x4*)(KRN + ((d * 32 + tau) * 16 + m) * 16 + nq * 4) = (f32x4){a0, a1, a2, a3}; }
    __syncthreads();
    for (int k = 0; k < 96; ++k) { const int ch = tid + 512 * k, row = ch / 96, kc = ch - row * 96, k0 = kc * 8, i = row >> 4, m = row & 15;
        float v[8];
        if (k0 < 512) { const int j = k0 >> 4, n0 = k0 & 15;
            if (i > j) { const LAS float* s = KRN + ((0 * 32 + (i - j)) * 16 + m) * 16 + n0;
#pragma unroll
                for (int t = 0; t < 8; ++t) v[t] = s[t]; }
            else if (i < j) { const LAS float* s = KRN + ((1 * 32 + (j - i)) * 16 + m) * 16 + n0;
#pragma unroll
                for (int t = 0; t < 8; ++t) v[t] = s[t]; }
            else { const LAS float* s0 = KRN + ((0 * 32 + 0) * 16 + m) * 16 + n0; const LAS float* s1 = KRN + ((1 * 32 + 0) * 16 + m) * 16 + n0;
#pragma unroll
                for (int t = 0; t < 8; ++t) v[t] = s0[t] + s1[t]; }
        } else { const int q0 = k0 - 512, d = q0 >> 7, p0 = (q0 & 127) >> 1, e = d == 0 ? i + 1 : 32 - i;
#pragma unroll
            for (int t = 0; t < 4; ++t) { const f32x2 ca = cmul(CCl[(d * 16 + m) * 64 + p0 + t], POW[(d * 64 + p0 + t) * 33 + e]); v[2 * t] = ca.x; v[2 * t + 1] = -ca.y; } }
        *(v4u*)(Bc + ((size_t)(g * 512 + row) * S5K + k0)) = pack8(v); }
    for (int k = 0; k < 32; ++k) { const int ch = tid + 512 * k, q = ch >> 6, kc = ch & 63, k0 = kc * 8, j = k0 >> 4, n0 = k0 & 15;
        const int d = q >> 7, p = (q & 127) >> 1, ri = q & 1, ef = d == 0 ? 31 - j : j;
        const f32x2 pw = POW[(d * 64 + p) * 33 + ef]; float v[8];
#pragma unroll
        for (int t = 0; t < 8; ++t) { const f32x2 w = cmul(pw, BBl[(d * 64 + p) * 16 + n0 + t]); v[t] = ri ? w.y : w.x; }
        *(v4u*)(Ws5 + ((size_t)(g * 256 + q) * 512 + k0)) = pack8(v); }
    __syncthreads();
}
__device__ __forceinline__ void s5_scan(const float* HL, bf16* UA, const f32x2* AB, int gw, int NGW, int lane) {
    for (int w = gw; w < 512; w += NGW) {
        const int b = w >> 6, g = (w >> 1) & 31, d = w & 1;
        f32x2 a32 = AB[(d * 32 + g) * 64 + lane];
#pragma unroll
        for (int i = 0; i < 5; ++i) a32 = cmul(a32, a32);
        f32x2 h = (f32x2){0.f, 0.f};
        const size_t rbase = (size_t)g * S5RP + b * 136;
#pragma unroll 1
        for (int s0 = 0; s0 < 136; s0 += 34) {
            f32x2 hl[34];
#pragma unroll
            for (int k = 0; k < 34; ++k) { const int s = s0 + k, c = d == 0 ? s : (s < 8 ? 7 - s : 143 - s); hl[k] = *(const f32x2*)(HL + (rbase + c) * 256 + d * 128 + lane * 2); }
#pragma unroll
            for (int k = 0; k < 34; ++k) { const int s = s0 + k, c = d == 0 ? s : (s < 8 ? 7 - s : 143 - s);
                *(unsigned*)(UA + (rbase + c) * S5K + 512 + d * 128 + lane * 2) = pk2(h.x, h.y);
                h = cmul(a32, h) + hl[k]; }
        }
    }
}

typedef short bf16x8_t __attribute__((ext_vector_type(8)));
__device__ __forceinline__ bf16x8_t frag_rm(const LAS unsigned char* T, int RS, int r0, int k0, int lane) { return *(const LAS bf16x8_t*)(T + (r0 + (lane & 15)) * RS + (k0 + 8 * (lane >> 4)) * 2); }
#define MFMA16(a, b, c) __builtin_amdgcn_mfma_f32_16x16x32_bf16((a), (b), (c), 0, 0, 0)
__device__ __forceinline__ bf16x8_t scale_frag(bf16x8_t f, float sc) {
    const v4u w = __builtin_bit_cast(v4u, f); float t[8]; unpack8(w, t);
    v4u o; o.x = pk2(t[0] * sc, t[1] * sc); o.y = pk2(t[2] * sc, t[3] * sc); o.z = pk2(t[4] * sc, t[5] * sc); o.w = pk2(t[6] * sc, t[7] * sc);
    return __builtin_bit_cast(bf16x8_t, o);
}
constexpr int RCH = 34;
__device__ __forceinline__ int ret_row0(int b, int s) { return s < 2 ? ML + b * CTXL + s * 128 : b * SEQL + (s - 2) * 128; }
__device__ __forceinline__ void stage_vt(LAS unsigned char* Vt, const bf16* P0, int row0, int h, int tid) {
#pragma unroll
    for (int k = 0; k < 4; ++k) { const int c = tid + 512 * k, j = c & 127, e0 = (c >> 7) * 8;
        const v4u w = *(const v4u*)(P0 + (size_t)(row0 + j) * P0LD + 512 + h * 128 + e0);
        LAS unsigned short* p = (LAS unsigned short*)(Vt + e0 * 272 + j * 2);
        p[0 * 136] = (unsigned short)(w.x & 0xffffu); p[1 * 136] = (unsigned short)(w.x >> 16); p[2 * 136] = (unsigned short)(w.y & 0xffffu); p[3 * 136] = (unsigned short)(w.y >> 16);
        p[4 * 136] = (unsigned short)(w.z & 0xffffu); p[5 * 136] = (unsigned short)(w.z >> 16); p[6 * 136] = (unsigned short)(w.w & 0xffffu); p[7 * 136] = (unsigned short)(w.w >> 16); }
}
__device__ __forceinline__ void ret_passA_item(LAS unsigned char* lds, int it, const bf16* P0, const float* ret_logit, bf16* ULOC) {
    int tid_ = threadIdx.x; asm volatile("" : "+v"(tid_)); const int tid = tid_, lane = tid & 63, w = tid >> 6, g4 = lane >> 4;
    const int bh = it / RCH, s = it - bh * RCH, b = bh >> 2, h = bh & 3, row0 = ret_row0(b, s);
    const float lgf = log2f(1.0f / (1.0f + expf(-ret_logit[h]))), lgb = log2f(1.0f / (1.0f + expf(-ret_logit[4 + h])));
    LAS unsigned char* KtF = lds; LAS unsigned char* KtB = lds + 17408; LAS unsigned char* Vt = lds + 34816;
#pragma unroll
    for (int k = 0; k < 2; ++k) { const int c = tid + 512 * k, j = c & 127, d0 = (c >> 7) * 8;
        const v4u wv = *(const v4u*)(P0 + (size_t)(row0 + j) * P0LD + 256 + h * 64 + d0); float t[8]; unpack8(wv, t);
        const float sf = exp2f((float)(127 - j) * lgf), sb = exp2f((float)j * lgb);
        LAS unsigned short* pf = (LAS unsigned short*)(KtF + d0 * 272 + j * 2); LAS unsigned short* pb = (LAS unsigned short*)(KtB + d0 * 272 + j * 2);
#pragma unroll
        for (int i = 0; i < 8; ++i) { pf[i * 136] = (unsigned short)f2bf(t[i] * sf); pb[i * 136] = (unsigned short)f2bf(t[i] * sb); } }
    stage_vt(Vt, P0, row0, h, tid);
    __syncthreads();
    f32x4 acc[2][4];
#pragma unroll
    for (int d = 0; d < 2; ++d)
#pragma unroll
        for (int dt = 0; dt < 4; ++dt) acc[d][dt] = (f32x4){0.f, 0.f, 0.f, 0.f};
#pragma unroll
    for (int ks = 0; ks < 4; ++ks) { const bf16x8_t vb = frag_rm(Vt, 272, 16 * w, 32 * ks, lane);
#pragma unroll
        for (int dt = 0; dt < 4; ++dt) { acc[0][dt] = MFMA16(frag_rm(KtF, 272, 16 * dt, 32 * ks, lane), vb, acc[0][dt]); acc[1][dt] = MFMA16(frag_rm(KtB, 272, 16 * dt, 32 * ks, lane), vb, acc[1][dt]); } }
    const int e = 16 * w + (lane & 15);
#pragma unroll
    for (int d = 0; d < 2; ++d)
#pragma unroll
        for (int dt = 0; dt < 4; ++dt) { v2u o; o.x = pk2(acc[d][dt][0], acc[d][dt][1]); o.y = pk2(acc[d][dt][2], acc[d][dt][3]);
            *(v2u*)(ULOC + ((size_t)((bh * 2 + d) * RCH + s) * 128 + e) * 64 + 16 * dt + 4 * g4) = o; }
    __syncthreads();
}
__device__ __forceinline__ void ret_scan(const bf16* ULOC, bf16* SIN, const float* ret_logit, int gt, int NT) {
    for (int idx = gt; idx < 64 * 2048; idx += NT) {
        const int bhd = idx >> 11, off = (idx & 2047) * 4, dir = bhd & 1, h = (bhd >> 1) & 3;
        const float g128 = exp2f(128.0f * log2f(1.0f / (1.0f + expf(-ret_logit[dir * 4 + h]))));
        const size_t base = (size_t)bhd * RCH * 8192 + off;
        v2u u[RCH];
#pragma unroll
        for (int k = 0; k < RCH; ++k) { const int s = dir == 0 ? k : (k < 2 ? 1 - k : 35 - k); u[k] = *(const v2u*)(ULOC + base + (size_t)s * 8192); }
        float st[4] = {0.f, 0.f, 0.f, 0.f};
#pragma unroll
        for (int k = 0; k < RCH; ++k) { const int s = dir == 0 ? k : (k < 2 ? 1 - k : 35 - k);
            v2u o; o.x = pg8::cvt_pk_bf16(st[0], st[1]); o.y = pg8::cvt_pk_bf16(st[2], st[3]); *(v2u*)(SIN + base + (size_t)s * 8192) = o;
            st[0] = g128 * st[0] + bflo(u[k].x); st[1] = g128 * st[1] + bfhi(u[k].x); st[2] = g128 * st[2] + bflo(u[k].y); st[3] = g128 * st[3] + bfhi(u[k].y); }
    }
}
__device__ __forceinline__ void ret_passC_item(LAS unsigned char* lds, int it, const bf16* P0, const float* ret_logit, const bf16* SIN, bf16* RZ) {
    int tid_ = threadIdx.x; asm volatile("" : "+v"(tid_)); const int tid = tid_, lane = tid & 63, w = tid >> 6, g4 = lane >> 4, l15 = lane & 15;
    const int bh = it / RCH, s = it - bh * RCH, b = bh >> 2, h = bh & 3, row0 = ret_row0(b, s);
    const float lgf = log2f(1.0f / (1.0f + expf(-ret_logit[h]))), lgb = log2f(1.0f / (1.0f + expf(-ret_logit[4 + h])));
    LAS unsigned char* Qs = lds; LAS unsigned char* Ks = lds + 18432; LAS unsigned char* SfT = lds + 36864; LAS unsigned char* SbT = lds + 55296; LAS unsigned char* Vt = lds + 73728;
    LAS unsigned char* Pm = lds + 108544;
#pragma unroll
    for (int k = 0; k < 2; ++k) { const int c = tid + 512 * k, j = c >> 3, ch = c & 7;
        *(LAS v4u*)(Qs + j * 144 + ch * 16) = *(const v4u*)(P0 + (size_t)(row0 + j) * P0LD + h * 64 + ch * 8);
        *(LAS v4u*)(Ks + j * 144 + ch * 16) = *(const v4u*)(P0 + (size_t)(row0 + j) * P0LD + 256 + h * 64 + ch * 8);
        *(LAS v4u*)(SfT + j * 144 + ch * 16) = *(const v4u*)(SIN + ((size_t)((bh * 2 + 0) * RCH + s) * 128 + j) * 64 + ch * 8);
        *(LAS v4u*)(SbT + j * 144 + ch * 16) = *(const v4u*)(SIN + ((size_t)((bh * 2 + 1) * RCH + s) * 128 + j) * 64 + ch * 8); }
    stage_vt(Vt, P0, row0, h, tid);
    __syncthreads();
    f32x4 accO[8], accA[8];
#pragma unroll
    for (int t = 0; t < 8; ++t) { accO[t] = (f32x4){0.f, 0.f, 0.f, 0.f}; accA[t] = (f32x4){0.f, 0.f, 0.f, 0.f}; }
    { const int il = 16 * w + l15;
      const float af = exp2f((float)(il + 1) * lgf), ab = exp2f((float)(128 - il) * lgb);
#pragma unroll
      for (int ks = 0; ks < 2; ++ks) { const bf16x8_t q = frag_rm(Qs, 144, 16 * w, 32 * ks, lane); const bf16x8_t qf = scale_frag(q, af), qb = scale_frag(q, ab);
#pragma unroll
          for (int t = 0; t < 8; ++t) { accA[t] = MFMA16(q, frag_rm(Ks, 144, 16 * t, 32 * ks, lane), accA[t]);
              accO[t] = MFMA16(qf, frag_rm(SfT, 144, 16 * t, 32 * ks, lane), accO[t]); accO[t] = MFMA16(qb, frag_rm(SbT, 144, 16 * t, 32 * ks, lane), accO[t]); } } }
    __syncthreads();
#pragma unroll
    for (int t = 0; t < 8; ++t)
#pragma unroll
        for (int r = 0; r < 4; ++r) { const int i = 16 * w + 4 * g4 + r, j = 16 * t + l15;
            const float dm = i > j ? exp2f((float)(i - j) * lgf) : (i < j ? exp2f((float)(j - i) * lgb) : 2.0f);
            *(LAS unsigned short*)(Pm + i * 272 + j * 2) = (unsigned short)f2bf(accA[t][r] * dm); }
    __syncthreads();
#pragma unroll
    for (int ks = 0; ks < 4; ++ks) { const bf16x8_t p = frag_rm(Pm, 272, 16 * w, 32 * ks, lane);
#pragma unroll
        for (int t = 0; t < 8; ++t) accO[t] = MFMA16(p, frag_rm(Vt, 272, 16 * t, 32 * ks, lane), accO[t]); }
#pragma unroll
    for (int r = 0; r < 4; ++r) { float ss = 0.f;
#pragma unroll
        for (int t = 0; t < 8; ++t) ss += accO[t][r] * accO[t][r];
        const float rs = 1.0f / sqrtf(sum16(ss) * (1.f / 128.f) + EPSN);
        const size_t row = (size_t)(row0 + 16 * w + 4 * g4 + r);
#pragma unroll
        for (int t = 0; t < 8; ++t) { const int e = 16 * t + l15; const float gt = bf2f(P0[row * P0LD + 1024 + h * 128 + e]);
            RZ[row * 1024 + h * 128 + e] = (bf16)f2bf(accO[t][r] * rs * siluf_(gt)); } }
    __syncthreads();
}
__device__ __forceinline__ int hg_row0(int b, int dir, int st) {
    if (st < 8) { const int c = dir ? 7 - st : st; return ML + b * CTXL + c * 32; }
    const int c = dir ? 135 - st : st - 8; return b * SEQL + c * 32;
}
#define HG_ISSUE(st_) do { const int r0_ = hg_row0(b, dir, (st_)); \
        const unsigned short* lp_ = P1 + (size_t)r0_ * 5120 + 1024 + dir * 1024 + h * 128 + d; const unsigned short* qp_ = P1 + (size_t)(r0_ + tq * 16) * 5120 + h * 128 + d; \
        _Pragma("unroll") for (int i_ = 0; i_ < 16; ++i_) { lfm[i_] = lp_[(size_t)(tq * 16 + i_) * 5120]; lfo[i_] = lp_[(size_t)((1 - tq) * 16 + i_) * 5120]; qr[i_] = qp_[(size_t)i_ * 5120]; } \
        vr = *(const v4u*)(P1 + (size_t)(r0_ + tv) * 5120 + 3072 + h * 128 + eh * 64 + eseg); } while (0)
__device__ __forceinline__ float f16bits(unsigned short hbits) { return (float)__builtin_bit_cast(_Float16, hbits); }
__device__ __forceinline__ void hgrn_item(LAS unsigned char* lds, int it, const bf16* P1, bf16* OS) {
    int tid_ = threadIdx.x; asm volatile("" : "+v"(tid_)); const int tid = tid_;
    const int lane = tid & 63, w = tid >> 6, g4 = lane >> 4, l15 = lane & 15;
    const int dir = w >> 2, et = w & 3, td = tid & 255, d = td & 127, tq = td >> 7, tv = td >> 3, eseg = (td & 7) * 8;
    const int b = it >> 4, h = (it >> 1) & 7, eh = it & 1;
    LAS unsigned char* base = lds + dir * 36864;
    LAS unsigned char* QI = base; LAS unsigned char* KI = base + 8704; LAS unsigned char* KT = base + 17408; LAS unsigned char* VT = base + 27648; LAS unsigned char* PM = base + 32768;
    LAS float* DEC = (LAS float*)(base + 35328);
    f32x4 S[8];
#pragma unroll
    for (int t = 0; t < 8; ++t) S[t] = (f32x4){0.f, 0.f, 0.f, 0.f};
    unsigned short lfm[16], lfo[16], qr[16]; v4u vr;
    HG_ISSUE(0);
#pragma unroll 1
    for (int st = 0; st < 136; ++st) {
        const int row0 = hg_row0(b, dir, st);
        asm volatile("s_waitcnt vmcnt(0)" ::: "memory");
        __syncthreads();
        {
            float lf[16], osum = 0.f, msum = 0.f;
#pragma unroll
            for (int i = 0; i < 16; ++i) { lf[i] = f16bits(lfm[i]); msum += lf[i]; osum += f16bits(lfo[i]); }
            const float tot = msum + osum;
            float run = dir == 0 ? (tq ? osum : 0.f) : (tq ? 0.f : osum);
            float cum[16];
            if (dir == 0) {
#pragma unroll
                for (int i = 0; i < 16; ++i) { run += lf[i]; cum[i] = run; }
            } else {
#pragma unroll
                for (int i = 15; i >= 0; --i) { run += lf[i]; cum[i] = run; }
            }
            unsigned short ko[16];
#pragma unroll
            for (int i = 0; i < 16; ++i) {
                const float c = cum[i], eq = __expf(c), kk = 1.0f - __expf(lf[i]);
                const float qin = bf2f(qr[i]) * eq, kin = kk * __expf(-c), kout = kk * __expf(tot - c);
                const int tok = tq * 16 + i;
                *(LAS unsigned short*)(QI + tok * 272 + d * 2) = (unsigned short)f2bf(qin);
                *(LAS unsigned short*)(KI + tok * 272 + d * 2) = (unsigned short)f2bf(kin);
                ko[i] = (unsigned short)f2bf(kout);
            }
            v4u k0, k1;
            k0.x = ko[0] | ((unsigned)ko[1] << 16); k0.y = ko[2] | ((unsigned)ko[3] << 16); k0.z = ko[4] | ((unsigned)ko[5] << 16); k0.w = ko[6] | ((unsigned)ko[7] << 16);
            k1.x = ko[8] | ((unsigned)ko[9] << 16); k1.y = ko[10] | ((unsigned)ko[11] << 16); k1.z = ko[12] | ((unsigned)ko[13] << 16); k1.w = ko[14] | ((unsigned)ko[15] << 16);
            *(LAS v4u*)(KT + d * 80 + tq * 32) = k0; *(LAS v4u*)(KT + d * 80 + tq * 32 + 16) = k1;
            if (tq == 0) DEC[d] = __expf(tot);
            LAS unsigned short* vp = (LAS unsigned short*)(VT + eseg * 80 + tv * 2);
            vp[0 * 40] = (unsigned short)(vr.x & 0xffffu); vp[1 * 40] = (unsigned short)(vr.x >> 16); vp[2 * 40] = (unsigned short)(vr.y & 0xffffu); vp[3 * 40] = (unsigned short)(vr.y >> 16);
            vp[4 * 40] = (unsigned short)(vr.z & 0xffffu); vp[5 * 40] = (unsigned short)(vr.z >> 16); vp[6 * 40] = (unsigned short)(vr.w & 0xffffu); vp[7 * 40] = (unsigned short)(vr.w >> 16);
        }
        if (st + 1 < 136) HG_ISSUE(st + 1);
        __syncthreads();
        {
            const int it1 = et >> 1, jt1 = et & 1;
            f32x4 ap = (f32x4){0.f, 0.f, 0.f, 0.f};
#pragma unroll
            for (int ks = 0; ks < 4; ++ks) ap = MFMA16(frag_rm(QI, 272, 16 * it1, 32 * ks, lane), frag_rm(KI, 272, 16 * jt1, 32 * ks, lane), ap);
#pragma unroll
            for (int r = 0; r < 4; ++r) { const int i = 16 * it1 + 4 * g4 + r, j = 16 * jt1 + l15; const bool keep = dir == 0 ? (j <= i) : (j >= i);
                *(LAS unsigned short*)(PM + i * 80 + j * 2) = keep ? (unsigned short)f2bf(ap[r]) : (unsigned short)0; }
        }
        __syncthreads();
        {
            bf16x8_t sb[4];
#pragma unroll
            for (int ks = 0; ks < 4; ++ks) { v4u t; t.x = pk2(S[2 * ks][0], S[2 * ks][1]); t.y = pk2(S[2 * ks][2], S[2 * ks][3]); t.z = pk2(S[2 * ks + 1][0], S[2 * ks + 1][1]); t.w = pk2(S[2 * ks + 1][2], S[2 * ks + 1][3]);
                sb[ks] = __builtin_bit_cast(bf16x8_t, t); }
            const bf16x8_t vfrag = frag_rm(VT, 80, 16 * et, 0, lane);
            f32x4 o[2];
#pragma unroll
            for (int t2 = 0; t2 < 2; ++t2) {
                o[t2] = MFMA16(vfrag, frag_rm(PM, 80, 16 * t2, 0, lane), ((f32x4){0.f, 0.f, 0.f, 0.f}));
#pragma unroll
                for (int ks = 0; ks < 4; ++ks) { const LAS unsigned char* qrow = QI + (16 * t2 + l15) * 272 + (32 * ks + 4 * g4) * 2;
                    const v2u qa = *(const LAS v2u*)qrow, qb = *(const LAS v2u*)(qrow + 32);
                    v4u qq; qq.x = qa.x; qq.y = qa.y; qq.z = qb.x; qq.w = qb.y;
                    o[t2] = MFMA16(sb[ks], __builtin_bit_cast(bf16x8_t, qq), o[t2]); }
            }
#pragma unroll
            for (int dt = 0; dt < 8; ++dt) { const f32x4 dv = *(const LAS f32x4*)(DEC + 16 * dt + 4 * g4);
                S[dt] = MFMA16(frag_rm(KT, 80, 16 * dt, 0, lane), vfrag, S[dt] * dv); }
            if (st >= 8) {
#pragma unroll
                for (int t2 = 0; t2 < 2; ++t2) { bf16* op = OS + (size_t)(row0 + 16 * t2 + l15) * 1024 + h * 128 + eh * 64 + 16 * et + 4 * g4;
                    f32x4 v = o[t2];
                    if (st >= 72) { const unsigned long long old = __hip_atomic_load((unsigned long long*)op, __ATOMIC_RELAXED, __HIP_MEMORY_SCOPE_AGENT); const unsigned lo = (unsigned)old, hi = (unsigned)(old >> 32);
                        v[0] += bflo(lo); v[1] += bfhi(lo); v[2] += bflo(hi); v[3] += bfhi(hi); }
                    v2u pk; pk.x = pk2(v[0], v[1]); pk.y = pk2(v[2], v[3]); *(v2u*)op = pk; }
            }
        }
    }
    __syncthreads();
}

struct Args { const float* in[28]; float* out; unsigned char* ws; };
enum { I_X = 0, I_C, I_CTX, I_CCTX, I_WMOD, I_BMOD, I_NMIX, I_NMLP, I_W1, I_W2, I_ABWIN, I_ABWOUT, I_RETL, I_S5ARE, I_S5AIM, I_S5DT, I_S5BRE, I_S5BIM, I_S5CRE, I_S5CIM, I_S5D, I_S5WGLU, I_S5BGLU, I_HGWIN, I_HGWOUT, I_HGLB, I_HGNORM, I_NFIN };

__global__ void __launch_bounds__(NWAVES * 64, 2) mk_fwd(Args args) {
    extern __shared__ __attribute__((aligned(16))) unsigned char lds_raw[];
    LAS unsigned char* lds = (LAS unsigned char*)lds_raw;
    volatile LAS unsigned* MISC = (volatile LAS unsigned*)(lds + MISC_OFF);
    const int tid = threadIdx.x, lane = tid & 63, wave = __builtin_amdgcn_readfirstlane(tid >> 6);
    const int G = gridDim.x;
    const int vcu = (G % 8 == 0) ? ((int)blockIdx.x % 8) * (G / 8) + (int)blockIdx.x / 8 : (int)blockIdx.x;
    const int gw = vcu * NWAVES + wave, NGW = G * NWAVES;
    unsigned char* ws = args.ws;
    gu32* ctl = (gu32*)(ws + WS_CTL);
    for (int u = tid; u < (LDS_BYTES - LDSCTL_OFF) / 4; u += NWAVES * 64) ((LAS unsigned*)(lds + LDSCTL_OFF))[u] = 0u;
    __syncthreads();
    XcdBarrier bar = xcd_barrier_post((unsigned*)(ctl + CW_BAR), MISC + 8);
#define GRID_BAR() xcd_barrier(bar)

    float* MOD = (float*)(ws + WS_MOD); float* CS = (float*)(ws + WS_CS);
    f32x2* AB = (f32x2*)(ws + WS_S5T); float* LB = (float*)(ws + WS_LB);
    float* HC = (float*)(ws + WS_HC);
    bf16* Win0 = (bf16*)(ws + WS_WIN0); bf16* Wout0 = (bf16*)(ws + WS_WOUT0); bf16* Wglu = (bf16*)(ws + WS_WGLU);
    bf16* W1t = (bf16*)(ws + WS_W1); bf16* W2t = (bf16*)(ws + WS_W2); bf16* Whg = (bf16*)(ws + WS_WHG); bf16* Whgo = (bf16*)(ws + WS_WHGO);
    bf16* XN = (bf16*)(ws + WS_XN); bf16* P0b = (bf16*)(ws + WS_P0); bf16* P1b = (bf16*)(ws + WS_P1); bf16* Hb = (bf16*)(ws + WS_H);
    bf16* ULOC = (bf16*)(ws + WS_ULOC); bf16* SIN = (bf16*)(ws + WS_SIN);
    bf16* UA = (bf16*)(ws + WS_UA); bf16* Bc = (bf16*)(ws + WS_BC); bf16* Ws5 = (bf16*)(ws + WS_WS5); float* HLOC = (float*)(ws + WS_HLOC);
    bf16* RZ = (bf16*)(ws + WS_RZ); bf16* Yb = (bf16*)(ws + WS_Y); bf16* OS = (bf16*)(ws + WS_XN);
    float* OUT = args.out;

    {
        LAS float* scr = (LAS float*)(lds + RING_OFF + wave * 16384);
        constexpr int I_A = 16 * 64, I_B = 16 * 32, I_G = 8 * 16, I_1 = 16 * 128, I_2 = 64 * 32, I_H = 16 * 160, I_O = 16 * 32;
        constexpr int NITEMS = I_A + I_B + I_G + 2 * I_1 + 2 * I_2 + I_H + I_O;
        for (int it = gw; it < NITEMS; it += NGW) {
            int r = it;
            if (r < I_A) { p0_transpose_item<true>(args.in[I_ABWIN], 1024, 2048, Win0, scr, r, lane); continue; } r -= I_A;
            if (r < I_B) { p0_transpose_item<false>(args.in[I_ABWOUT], 1024, 1024, Wout0, scr, r, lane); continue; } r -= I_B;
            if (r < I_G) { p0_transpose_item<false>(args.in[I_S5WGLU], 512, 512, Wglu, scr, r, lane); continue; } r -= I_G;
            if (r < 2 * I_1) { const int l = r / I_1; p0_transpose_item<false>(args.in[I_W1] + (size_t)l * 1024 * 4096, 1024, 4096, W1t + (size_t)l * 4096 * 1024, scr, r % I_1, lane); continue; } r -= 2 * I_1;
            if (r < 2 * I_2) { const int l = r / I_2; p0_transpose_item<false>(args.in[I_W2] + (size_t)l * 1024 * 4096, 4096, 1024, W2t + (size_t)l * 4096 * 1024, scr, r % I_2, lane); continue; } r -= 2 * I_2;
            if (r < I_H) { p0_transpose_item<false>(args.in[I_HGWIN], 1024, 5120, Whg, scr, r, lane); continue; } r -= I_H;
            p0_transpose_item<false>(args.in[I_HGWOUT], 1024, 1024, Whgo, scr, r, lane);
        }
        __syncthreads();
        if ((int)blockIdx.x < 96) {
            LAS float* Ssil = (LAS float*)lds; LAS float* red = (LAS float*)(lds + 36864);
            for (int i = tid; i < 9 * 1024; i += NWAVES * 64) { const int r = i >> 10, k = i & 1023; const float v = r < 8 ? args.in[I_C][r * 1024 + k] : args.in[I_CCTX][k]; Ssil[i] = v / (1.0f + expf(-v)); }
            __syncthreads();
            for (int it = blockIdx.x; it < 96; it += G) {
                const int l = it / 48, col0 = (it % 48) * 128, cgp = tid & 31, ksl = tid >> 5;
                const float* W = args.in[I_WMOD] + (size_t)l * 1024 * NMOD + col0 + 4 * cgp;
                f32x4 a[9];
#pragma unroll
                for (int r = 0; r < 9; ++r) a[r] = (f32x4){0.f, 0.f, 0.f, 0.f};
                for (int kk = 0; kk < 64; ++kk) { const int k = ksl * 64 + kk; const f32x4 w = *(const f32x4*)(W + (size_t)k * NMOD);
#pragma unroll
                    for (int r = 0; r < 9; ++r) a[r] += w * Ssil[r * 1024 + k]; }
#pragma unroll
                for (int r = 0; r < 9; ++r) *(LAS f32x4*)(red + (ksl * 9 + r) * 128 + 4 * cgp) = a[r];
                __syncthreads();
                for (int o = tid; o < 9 * 128; o += NWAVES * 64) { const int r = o >> 7, cc = o & 127; float s = args.in[I_BMOD][l * NMOD + col0 + cc];
                    for (int q = 0; q < 16; ++q) s += red[(q * 9 + r) * 128 + cc];
                    MOD[(size_t)(l * 9 + r) * NMOD + col0 + cc] = s; }
                __syncthreads();
            }
        }
        { const int first = G >= 128 ? 96 : 0, nb_ = G >= 128 ? 32 : G;
          if ((int)blockIdx.x >= first && (int)blockIdx.x < first + nb_) { __syncthreads();
            for (int g5 = (int)blockIdx.x - first; g5 < 32; g5 += nb_)
                s5_tables_item(lds, g5, args.in[I_S5ARE], args.in[I_S5AIM], args.in[I_S5DT], args.in[I_S5BRE], args.in[I_S5BIM], args.in[I_S5CRE], args.in[I_S5CIM], Bc, Ws5); } }
        const int gt = gw * 64 + lane, NT = NGW * 64;
        for (int i = gt; i < SEQL * 32; i += NT) { const int t = i >> 5, dd = i & 31; const float inv = powf(10000.0f, -(float)(dd & 15) / 16.0f);
            const float a = (dd < 16 ? (float)(t >> 6) : (float)(t & 63)) * inv; CS[2 * i] = cosf(a); CS[2 * i + 1] = sinf(a); }
        for (int i = gt; i < 2 * 32 * 64; i += NT) {
            const float dt = expf(args.in[I_S5DT][i >> 6]); const float are = args.in[I_S5ARE][i], aim = args.in[I_S5AIM][i];
            const float mag = expf(are * dt), ang = aim * dt; const float abr = mag * cosf(ang), abi = mag * sinf(ang);
            const float nr = abr - 1.0f, ni = abi, den = are * are + aim * aim; const float fr = (nr * are + ni * aim) / den, fi = (ni * are - nr * aim) / den;
            AB[i] = (f32x2){abr, abi}; (void)fr; (void)fi;
        }
        for (int i = gt; i < 2 * 1024; i += NT) { const int d = i >> 10, j = i & 1023; const float x0 = args.in[I_HGLB][(d * 2 + 0) * 1024 + j], x1 = args.in[I_HGLB][(d * 2 + 1) * 1024 + j];
            const float mx = fmaxf(x0, x1), e0 = expf(x0 - mx), e1 = expf(x1 - mx); const float g0 = e0 / (e0 + e1), g1 = e1 / (e0 + e1); LB[i] = (g0 + g1) - g0; }
    }
    GRID_BAR();
    norm_mod_rows(args.in[I_X], args.in[I_CTX], MT, args.in[I_NMIX], MOD, 0, DM, XN, gw, NGW, lane);
    GRID_BAR();
    { pg8::Gemm g{XN, Win0, MT, 2048, 1024, 1024, 1024}; pg8::StaticOrder S; S.init(MT, 2048, G, (int)blockIdx.x); EpiProj0 E{P0b, CS, UA};
      pg8::gemm_phase<EpiProj0, pg8::StaticOrder, true, true>(lds + RING_OFF, g, S, E); }
    GRID_BAR();
    { pg8::Gemm g{UA, Ws5, 32 * S5RP, 32 * 256, 512, S5K, 512}; pg8::BatchOrder S; S.init(32, 5, 1, G, (int)blockIdx.x); EpiHloc E{HLOC};
      pg8::gemm_phase<EpiHloc, pg8::BatchOrder, true, true>(lds + RING_OFF, g, S, E);
      __syncthreads();
      for (int it = (int)blockIdx.x; it < 32 * RCH; it += G) ret_passA_item(lds, it, P0b, args.in[I_RETL], ULOC); }
    GRID_BAR();
    s5_scan(HLOC, UA, AB, gw, NGW, lane);
    ret_scan(ULOC, SIN, args.in[I_RETL], gw * 64 + lane, NGW * 64);
    GRID_BAR();
    { pg8::Gemm g{UA, Bc, 32 * S5RP, 32 * 512, S5K, S5K, S5K}; pg8::BatchOrder S; S.init(32, 5, 2, G, (int)blockIdx.x); EpiS5Out E{UA, args.in[I_S5D], Yb};
      pg8::gemm_phase<EpiS5Out, pg8::BatchOrder, true, true>(lds + RING_OFF, g, S, E);
      __syncthreads();
      for (int it = (int)blockIdx.x; it < 32 * RCH; it += G) ret_passC_item(lds, it, P0b, args.in[I_RETL], SIN, RZ); }
    GRID_BAR();
    { pg8::Gemm g{Yb, Wglu, MT, 512, 512, 512, 512}; pg8::StaticOrder S; S.init(MT, 512, G, (int)blockIdx.x); EpiGlu E{Yb, args.in[I_S5BGLU], RZ + 512};
      pg8::gemm_phase<EpiGlu, pg8::StaticOrder, true, true>(lds + RING_OFF, g, S, E); }
    GRID_BAR();
    { pg8::Gemm g{RZ, Wout0, MT, 1024, 1024, 1024, 1024}; pg8::StaticOrder S; S.init(MT, 1024, G, (int)blockIdx.x); EpiResid E{args.in[I_X], args.in[I_CTX], OUT, HC, MOD + 2 * DM};
      pg8::gemm_phase<EpiResid, pg8::StaticOrder, true, true>(lds + RING_OFF, g, S, E); }
    GRID_BAR();
    norm_mod_rows(OUT, HC, MT, args.in[I_NMLP], MOD, 3 * DM, 4 * DM, XN, gw, NGW, lane);
    GRID_BAR();
    { pg8::Gemm g{XN, W1t, MT, DFF, 1024, 1024, 1024}; pg8::StaticOrder S; S.init(MT, DFF, G, (int)blockIdx.x); EpiSqrelu E{Hb};
      pg8::gemm_phase<EpiSqrelu, pg8::StaticOrder, true, true>(lds + RING_OFF, g, S, E); }
    GRID_BAR();
    { pg8::Gemm g{Hb, W2t, MT, 1024, DFF, DFF, DFF}; pg8::StaticOrder S; S.init(MT, 1024, G, (int)blockIdx.x); EpiResid E{OUT, HC, OUT, HC, MOD + 5 * DM};
      pg8::gemm_phase<EpiResid, pg8::StaticOrder, true, true>(lds + RING_OFF, g, S, E); }
    GRID_BAR();
    const float* MOD1 = MOD + (size_t)9 * NMOD;
    norm_mod_rows(OUT, HC, MT, args.in[I_NMIX] + DM, MOD1, 0, DM, XN, gw, NGW, lane);
    GRID_BAR();
    { pg8::Gemm g{XN, Whg, MT, 5120, 1024, 1024, 1024}; pg8::StaticOrder S; S.init(MT, 5120, G, (int)blockIdx.x); EpiProj1 E{P1b, LB};
      pg8::gemm_phase<EpiProj1, pg8::StaticOrder, true, true>(lds + RING_OFF, g, S, E); }
    GRID_BAR();
    for (int i = blockIdx.x; i < 128; i += G) hgrn_item(lds, i, P1b, OS);
    GRID_BAR();
    merge1_rows(OS, P1b, args.in[I_HGNORM], gw, NGW, lane);
    GRID_BAR();
    { pg8::Gemm g{OS, Whgo, ML, 1024, 1024, 1024, 1024}; pg8::StaticOrder S; S.init(ML, 1024, G, (int)blockIdx.x); EpiResid E{OUT, HC, OUT, HC, MOD1 + 2 * DM};
      pg8::gemm_phase<EpiResid, pg8::StaticOrder, true, true>(lds + RING_OFF, g, S, E); }
    GRID_BAR();
    norm_mod_rows(OUT, HC, ML, args.in[I_NMLP] + DM, MOD1, 3 * DM, 4 * DM, XN, gw, NGW, lane);
    GRID_BAR();
    { pg8::Gemm g{XN, W1t + (size_t)DFF * 1024, ML, DFF, 1024, 1024, 1024}; pg8::StaticOrder S; S.init(ML, DFF, G, (int)blockIdx.x); EpiSqrelu E{Hb};
      pg8::gemm_phase<EpiSqrelu, pg8::StaticOrder, true, true>(lds + RING_OFF, g, S, E); }
    GRID_BAR();
    { pg8::Gemm g{Hb, W2t + (size_t)DFF * 1024, ML, 1024, DFF, DFF, DFF}; pg8::StaticOrder S; S.init(ML, 1024, G, (int)blockIdx.x); EpiResid E{OUT, HC, OUT, HC, MOD1 + 5 * DM};
      pg8::gemm_phase<EpiResid, pg8::StaticOrder, true, true>(lds + RING_OFF, g, S, E); }
    GRID_BAR();
    final_norm_rows(OUT, args.in[I_NFIN], gw, NGW, lane);
}

extern "C" void kernel_launch(void* const* d_in, const int* in_sizes, int n_in, void* d_out, int out_size, void* d_ws, size_t ws_size, hipStream_t stream) {
    static int grid = 0;
    if (grid == 0) {
        if (n_in != 28 || in_sizes[0] != ML * DM || out_size != ML * DM || ws_size < WS_END) { fprintf(stderr, "kernel_launch: unexpected shapes (n_in %d, in0 %d, out %d, ws %zu)\n", n_in, n_in > 0 ? in_sizes[0] : -1, out_size, ws_size); grid = -1; return; }
        int dev = 0, cus = 0, per_cu = 0;
        if (hipGetDevice(&dev) != hipSuccess || hipDeviceGetAttribute(&cus, hipDeviceAttributeMultiprocessorCount, dev) != hipSuccess) { grid = -1; return; }
        if (hipFuncSetAttribute((const void*)mk_fwd, hipFuncAttributeMaxDynamicSharedMemorySize, LDS_BYTES) != hipSuccess) { fprintf(stderr, "kernel_launch: hipFuncSetAttribute failed\n"); grid = -1; return; }
        if (hipOccupancyMaxActiveBlocksPerMultiprocessor(&per_cu, (const void*)mk_fwd, NWAVES * 64, LDS_BYTES) != hipSuccess || per_cu < 1) { fprintf(stderr, "kernel_launch: occupancy query says %d blocks per CU\n", per_cu); }
        (void)hipGetLastError();
        grid = cus;
    }
    if (grid < 0) return;
    if (hipMemsetAsync((char*)d_ws + WS_CTL, 0, CTL_ZERO_BYTES, stream) != hipSuccess) return;
    Args a{};
    for (int i = 0; i < 28; ++i) a.in[i] = (const float*)d_in[i];
    a.out = (float*)d_out; a.ws = (unsigned char*)d_ws;
    hipLaunchKernelGGL(mk_fwd, dim3(grid), dim3(NWAVES * 64), LDS_BYTES, stream, a);
}
```

```cpp
#include <hip/hip_runtime.h>
#include <cstdio>
#include <cstdint>

namespace pg8 {
#define PG8_LAS __attribute__((address_space(3)))
typedef unsigned short bf16_t;
typedef short bf16x8 __attribute__((ext_vector_type(8)));
typedef float f32x4 __attribute__((ext_vector_type(4)));
typedef unsigned u32x4 __attribute__((ext_vector_type(4)));
constexpr int BM = 256, BK = 64, HALF = 128, HTB = HALF * BK * 2, STAGE_BYTES = 8 * HTB, NXCD = 8, WGM = 8;

__host__ __device__ __forceinline__ int lds_byte(int r, int c) { const int st = (r >> 4) * 2 + (c >> 5), rr = r & 15, cc = c & 31, ob = rr * 64 + cc * 2; return st * 1024 + (ob ^ (((ob >> 9) & 1) << 5)); }
__host__ __device__ __forceinline__ void stage_rc(int b, int& R, int& C) { const int st = b / 1024, sb = b % 1024, swz = sb ^ (((sb >> 9) & 1) << 5); R = (st >> 1) * 16 + swz / 64; C = (st & 1) * 32 + (swz % 64) / 2; }
__host__ __device__ __forceinline__ int perm32(int rho) { const int n = rho >> 4, i = rho & 15; return 8 * (i >> 2) + 4 * n + (i & 3); }

struct Unit { int pm, pn; };
struct Gemm { const bf16_t* A; const bf16_t* Bt; int M, N, K, lda, ldb; };

struct StaticOrder {
    int nM, nN, nwg, G, c;
    __host__ __device__ void init(int M, int N, int G_, int c_) { nM = M / BM; nN = N / BM; nwg = nM * nN; G = G_; c = c_; }
    __host__ __device__ bool next(int i, Unit& u) const {
        const long L = (long)i * G + c; if (L >= nwg) return false;
        int wgid = (int)L; { const int q = nwg / NXCD, r = nwg % NXCD, xcd = wgid % NXCD, off = wgid / NXCD; wgid = (xcd < r ? xcd * (q + 1) : r * (q + 1) + (xcd - r) * q) + off; }
        const int nig = WGM * nN, gid = wgid / nig, fm = gid * WGM, gsz = (nM - fm) < WGM ? (nM - fm) : WGM;
        u.pm = fm + ((wgid % nig) % gsz); u.pn = (wgid % nig) / gsz; return true;
    }
    __device__ __forceinline__ void a_ready(const Unit&) const {}
    __device__ __forceinline__ void done(const Unit&) const {}
};

struct BatchOrder {
    int nb, tm, tn, G, c;
    __host__ __device__ void init(int nb_, int tm_, int tn_, int G_, int c_) { nb = nb_; tm = tm_; tn = tn_; G = G_; c = c_; }
    __host__ __device__ bool next(int i, Unit& u) const {
        const long L = (long)i * G + c; if (c < 0 || L >= (long)nb * tm * tn) return false;
        const int per = tm * tn, g = (int)L / per, rem = (int)L % per;
        u.pm = g * tm + rem % tm; u.pn = g * tn + rem / tm; return true;
    }
    __device__ __forceinline__ void a_ready(const Unit&) const {}
    __device__ __forceinline__ void done(const Unit&) const {}
};

__device__ __forceinline__ unsigned cvt_pk_bf16(float lo, float hi) { unsigned r; asm volatile("v_cvt_pk_bf16_f32 %0, %1, %2" : "=v"(r) : "v"(lo), "v"(hi)); return r; }

template <class Epi, class Sched, bool ALIGN_EPI = false, bool SP2 = false>
__device__ __forceinline__ void gemm_phase(PG8_LAS unsigned char* lds, const Gemm g, const Sched& S, const Epi& E) {
    int tid_ = threadIdx.x; asm volatile("" : "+v"(tid_));
    const int tid = tid_, wid = __builtin_amdgcn_readfirstlane(tid >> 6), lane = tid & 63, wr = wid >> 2, wc = wid & 3, fr = lane & 15, fq = lane >> 4;
    const int K = g.K, nt = K / BK;
    unsigned voffA[2], voffB[2];
#pragma unroll
    for (int i = 0; i < 2; ++i) { int R, C; stage_rc(tid * 16 + i * 8192, R, C); const int Rb = Epi::PERM ? ((R & ~31) + perm32(R & 31)) : R;
        voffA[i] = (unsigned)(R * g.lda + C) * 2u; voffB[i] = (unsigned)(Rb * g.ldb + C) * 2u; }
    const size_t kstep = (size_t)(BK * 2);
    const size_t hstepA = (size_t)HALF * g.lda * 2, hstepB = (size_t)HALF * g.ldb * 2;
    const size_t tstepA = 2 * hstepA, tstepB = 2 * hstepB;
    const unsigned ldsw = (unsigned)wid * 1024u;
    const int aoff = lds_byte(wr * 64 + fr, fq * 8), boff = lds_byte(wc * 32 + fr, fq * 8);
#define PG8_SA(b, h) (((b) * 2 + (h)) * HTB)
#define PG8_SB(b, h) ((4 + (b) * 2 + (h)) * HTB)
#define PG8_STAGE(bufoff, gbase, voff) do { _Pragma("unroll") for (int _i = 0; _i < 2; ++_i) \
        __builtin_amdgcn_global_load_lds((const unsigned*)((const char*)(gbase) + (voff)[_i]), (PG8_LAS unsigned*)(lds + (bufoff) + ldsw + _i * 8192), 16, 0, 0); } while (0)
#define PG8_LDA(dst, b, h) do { _Pragma("unroll") for (int m = 0; m < 4; ++m) _Pragma("unroll") for (int k = 0; k < 2; ++k) dst[m][k] = *(const PG8_LAS bf16x8*)(lds + PG8_SA(b, h) + aoff + m * 2048 + k * 1024); } while (0)
#define PG8_LDB(dst, b, h) do { _Pragma("unroll") for (int n = 0; n < 2; ++n) _Pragma("unroll") for (int k = 0; k < 2; ++k) dst[n][k] = *(const PG8_LAS bf16x8*)(lds + PG8_SB(b, h) + boff + n * 2048 + k * 1024); } while (0)
#define PG8_MMA(ai, bj, At, Bt) do { __builtin_amdgcn_s_setprio(1); _Pragma("unroll") for (int m = 0; m < 4; ++m) _Pragma("unroll") for (int n = 0; n < 2; ++n) _Pragma("unroll") for (int k = 0; k < 2; ++k) \
        acc[ai][bj][m][n] = __builtin_amdgcn_mfma_f32_16x16x32_bf16(Bt[n][k], At[m][k], acc[ai][bj][m][n], 0, 0, 0); __builtin_amdgcn_s_setprio(0); } while (0)
#define PG8_WAIT_V(n) asm volatile("s_waitcnt vmcnt(" #n ")" ::: "memory")
#define PG8_WAIT_L(n) asm volatile("s_waitcnt lgkmcnt(" #n ")" ::: "memory")
#define PG8_BAR __builtin_amdgcn_s_barrier()
#define PG8_SCHED __builtin_amdgcn_sched_barrier(0)
    Unit cur, nxt; int ui = 0;
    if (!S.next(0, cur)) return;
    f32x4 acc[2][2][4][2];
#pragma unroll
    for (int a = 0; a < 2; ++a)
#pragma unroll
        for (int b = 0; b < 2; ++b)
#pragma unroll
            for (int m = 0; m < 4; ++m)
#pragma unroll
                for (int n = 0; n < 2; ++n) acc[a][b][m][n] = (f32x4){0.f, 0.f, 0.f, 0.f};
    bf16x8 At[4][2], B0[2][2], B1[2][2];
    const char* cA = (const char*)g.A + (size_t)cur.pm * tstepA; const char* cB = (const char*)g.Bt + (size_t)cur.pn * tstepB;
    S.a_ready(cur);
    if constexpr (SP2) {
        PG8_STAGE(PG8_SB(0, 0), cB, voffB); PG8_STAGE(PG8_SB(0, 1), cB + hstepB, voffB); PG8_STAGE(PG8_SA(0, 0), cA, voffA); PG8_STAGE(PG8_SA(0, 1), cA + hstepA, voffA);
        if (wr == 1) PG8_BAR;
        PG8_WAIT_V(2); PG8_BAR;
        PG8_STAGE(PG8_SB(1, 0), cB + kstep, voffB); PG8_STAGE(PG8_SA(1, 0), cA + kstep, voffA); PG8_STAGE(PG8_SB(1, 1), cB + hstepB + kstep, voffB);
        PG8_WAIT_V(6); PG8_BAR;
    } else {
        PG8_STAGE(PG8_SB(0, 0), cB, voffB); PG8_STAGE(PG8_SA(0, 0), cA, voffA); PG8_STAGE(PG8_SB(0, 1), cB + hstepB, voffB); PG8_STAGE(PG8_SA(0, 1), cA + hstepA, voffA);
        if (wr == 1) PG8_BAR;
        PG8_WAIT_V(4); PG8_BAR;
        PG8_STAGE(PG8_SB(1, 0), cB + kstep, voffB); PG8_STAGE(PG8_SA(1, 0), cA + kstep, voffA); PG8_STAGE(PG8_SB(1, 1), cB + hstepB + kstep, voffB);
        PG8_WAIT_V(6); PG8_BAR;
    }
    for (;;) {
        const bool has_next = S.next(ui + 1, nxt);
        const char* nA = has_next ? (const char*)g.A + (size_t)nxt.pm * tstepA : cA; const char* nB = has_next ? (const char*)g.Bt + (size_t)nxt.pn * tstepB : cB;
        for (int t = 0; t < nt; t += 2) {
            const bool last = (t == nt - 2);
            const char* a1 = cA + (size_t)(t + 1) * kstep;
            const char* a2 = last ? nA : cA + (size_t)(t + 2) * kstep; const char* b2 = last ? nB : cB + (size_t)(t + 2) * kstep;
            const char* a3 = a2 + kstep; const char* b3 = b2 + kstep;
            if (last && has_next) S.a_ready(nxt);
            if constexpr (SP2) {
            PG8_LDB(B0, 0, 0); PG8_LDB(B1, 0, 1); PG8_SCHED; PG8_LDA(At, 0, 0); PG8_STAGE(PG8_SA(1, 1), a1 + hstepA, voffA);
            PG8_WAIT_V(8); PG8_WAIT_L(0); PG8_BAR; PG8_MMA(0, 0, At, B0); PG8_MMA(0, 1, At, B1); PG8_BAR; PG8_SCHED;
            PG8_LDA(At, 0, 1); PG8_STAGE(PG8_SB(0, 0), b2, voffB); PG8_STAGE(PG8_SB(0, 1), b2 + hstepB, voffB); PG8_STAGE(PG8_SA(0, 0), a2, voffA);
            PG8_WAIT_V(8); PG8_WAIT_L(0); PG8_BAR; PG8_MMA(1, 0, At, B0); PG8_MMA(1, 1, At, B1); PG8_BAR; PG8_SCHED;
            PG8_LDB(B0, 1, 0); PG8_LDB(B1, 1, 1); PG8_SCHED; PG8_LDA(At, 1, 0); PG8_STAGE(PG8_SA(0, 1), a2 + hstepA, voffA);
            PG8_WAIT_V(8); PG8_WAIT_L(0); PG8_BAR; PG8_MMA(0, 0, At, B0); PG8_MMA(0, 1, At, B1); PG8_BAR; PG8_SCHED;
            PG8_LDA(At, 1, 1); PG8_STAGE(PG8_SB(1, 0), b3, voffB); PG8_STAGE(PG8_SB(1, 1), b3 + hstepB, voffB); PG8_STAGE(PG8_SA(1, 0), a3, voffA);
            PG8_WAIT_V(8); PG8_WAIT_L(0); PG8_BAR; PG8_MMA(1, 0, At, B0); PG8_MMA(1, 1, At, B1); PG8_BAR; PG8_SCHED;
            } else {
            PG8_LDB(B0, 0, 0); PG8_SCHED; PG8_LDA(At, 0, 0); PG8_STAGE(PG8_SA(1, 1), a1 + hstepA, voffA);
            PG8_WAIT_L(8); PG8_BAR; PG8_WAIT_L(0); PG8_MMA(0, 0, At, B0); PG8_BAR; PG8_SCHED;
            PG8_LDB(B1, 0, 1); PG8_STAGE(PG8_SB(0, 0), b2, voffB);
            PG8_BAR; PG8_WAIT_L(0); PG8_MMA(0, 1, At, B1); PG8_BAR;
            PG8_LDA(At, 0, 1); PG8_STAGE(PG8_SA(0, 0), a2, voffA);
            PG8_BAR; PG8_WAIT_L(0); PG8_MMA(1, 0, At, B0); PG8_BAR; PG8_SCHED;
            PG8_STAGE(PG8_SB(0, 1), b2 + hstepB, voffB);
            PG8_WAIT_V(6); PG8_BAR; PG8_MMA(1, 1, At, B1); PG8_BAR;
            PG8_LDB(B0, 1, 0); PG8_SCHED; PG8_LDA(At, 1, 0); PG8_STAGE(PG8_SA(0, 1), a2 + hstepA, voffA);
            PG8_WAIT_L(8); PG8_BAR; PG8_WAIT_L(0); PG8_MMA(0, 0, At, B0); PG8_BAR; PG8_SCHED;
            PG8_LDB(B1, 1, 1); PG8_STAGE(PG8_SB(1, 0), b3, voffB);
            PG8_BAR; PG8_WAIT_L(0); PG8_MMA(0, 1, At, B1); PG8_BAR;
            PG8_LDA(At, 1, 1); PG8_STAGE(PG8_SA(1, 0), a3, voffA);
            PG8_BAR; PG8_WAIT_L(0); PG8_MMA(1, 0, At, B0); PG8_BAR; PG8_SCHED;
            PG8_STAGE(PG8_SB(1, 1), b3 + hstepB, voffB);
            PG8_WAIT_V(6); PG8_BAR; PG8_MMA(1, 1, At, B1); PG8_BAR;
            }
        }
        if constexpr (ALIGN_EPI) { if (wr == 0) PG8_BAR; }
        if constexpr (!Epi::AFTER_DRAIN) { E(acc, cur, wr, wc, fr, fq); S.done(cur); }
        if (!has_next) break;
#pragma unroll
        for (int a = 0; a < 2; ++a)
#pragma unroll
            for (int b = 0; b < 2; ++b)
#pragma unroll
                for (int m = 0; m < 4; ++m)
#pragma unroll
                    for (int n = 0; n < 2; ++n) acc[a][b][m][n] = (f32x4){0.f, 0.f, 0.f, 0.f};
        cur = nxt; cA = nA; cB = nB; ++ui;
        if constexpr (ALIGN_EPI) { if (wr == 1) PG8_BAR; }
    }
    PG8_WAIT_V(0);
    if constexpr (!ALIGN_EPI) { if (wr == 0) PG8_BAR; }
    PG8_BAR;
#undef PG8_SA
#undef PG8_SB
#undef PG8_STAGE
#undef PG8_LDA
#undef PG8_LDB
#undef PG8_MMA
#undef PG8_WAIT_V
#undef PG8_WAIT_L
#undef PG8_BAR
#undef PG8_SCHED
}
}

#define GAS __attribute__((address_space(1)))
#define LAS __attribute__((address_space(3)))
typedef unsigned short bf16;
typedef unsigned v4u __attribute__((ext_vector_type(4)));
typedef unsigned v2u __attribute__((ext_vector_type(2)));
typedef float f32x4 __attribute__((ext_vector_type(4)));
typedef float f32x2 __attribute__((ext_vector_type(2)));

constexpr int NWAVES = 8;
constexpr int DM = 1024, NBATCH = 8, SEQL = 4096, CTXL = 256, DFF = 4096;
constexpr int ML = NBATCH * SEQL;
constexpr int MC = NBATCH * CTXL;
constexpr int MT = ML + MC;
constexpr int NMOD = 6 * DM;
constexpr float EPSN = 1e-6f;

constexpr size_t MiB = 1u << 20;
constexpr size_t WS_CTL = 0, CTL_ZERO_BYTES = 1 * MiB;
constexpr size_t WS_MOD = 1 * MiB;
constexpr size_t WS_CS = 2 * MiB;
constexpr size_t WS_S5T = 3 * MiB;
constexpr size_t WS_S5T_BB = WS_S5T + 32768, WS_LB = WS_S5T_BB + 524288;
constexpr size_t WS_HC = 4 * MiB;
constexpr size_t WS_WIN0 = 12 * MiB, WS_WOUT0 = 16 * MiB, WS_WGLU = 18 * MiB, WS_W1_0 = 19 * MiB, WS_W2_0 = 27 * MiB, WS_W1_1 = 35 * MiB, WS_W2_1 = 43 * MiB, WS_WHG = 51 * MiB, WS_WHGO = 61 * MiB;
__host__ __device__ __forceinline__ size_t ws_ob(int b) { return b < 5 ? 472 * MiB + (size_t)b * 8 * MiB : (b < 7 ? 12 * MiB + (size_t)(b - 5) * 8 * MiB : 4 * MiB); }
constexpr size_t WS_XN = 64 * MiB;
constexpr size_t WS_BIG = 132 * MiB;
constexpr int P0LD = 1536;
constexpr size_t WS_P0 = WS_BIG;
constexpr int S5R = 1088, S5RP = 1280, S5K = 768;
constexpr size_t WS_UA = WS_BIG + 102 * MiB;
constexpr size_t WS_BC = WS_BIG + 162 * MiB;
constexpr size_t WS_WS5 = WS_BIG + 186 * MiB;
constexpr size_t WS_ULOC = WS_BIG + 194 * MiB;
constexpr size_t WS_SIN = WS_BIG + 228 * MiB;
constexpr size_t WS_RZ = WS_BIG + 262 * MiB;
constexpr size_t WS_HLOC = WS_XN;
constexpr size_t WS_H = WS_BIG;
constexpr size_t WS_P1 = WS_BIG;
constexpr size_t WS_Y = 472 * MiB;
constexpr size_t WS_END = 512 * MiB;

constexpr int CW_BAR = 4096;

constexpr int RING_OFF = 0, RING_BYTES = 131072;
constexpr int LDSCTL_OFF = 143360, MISC_OFF = LDSCTL_OFF + 320;
constexpr int LDS_BYTES = 147456;

typedef GAS unsigned gu32;
#define LDS_WAIT() asm volatile("s_waitcnt lgkmcnt(0)" ::: "memory")
typedef __bf16 hwbf2 __attribute__((ext_vector_type(2)));
__device__ __forceinline__ unsigned pk2(float lo, float hi) { hwbf2 v; v.x = (__bf16)lo; v.y = (__bf16)hi; return __builtin_bit_cast(unsigned, v); }
__device__ __forceinline__ unsigned f2bf(float f) { return (unsigned)__builtin_bit_cast(unsigned short, (__bf16)f); }
__device__ __forceinline__ float bflo(unsigned w) { return __builtin_bit_cast(float, w << 16); }
__device__ __forceinline__ float bfhi(unsigned w) { return __builtin_bit_cast(float, w & 0xffff0000u); }
__device__ __forceinline__ float bf2f(bf16 h) { return __builtin_bit_cast(float, (unsigned)h << 16); }
typedef _Float16 h16x2 __attribute__((ext_vector_type(2)));
__device__ __forceinline__ unsigned pk_f16(float a, float b) { h16x2 v; v.x = (_Float16)a; v.y = (_Float16)b; return __builtin_bit_cast(unsigned, v); }
__device__ __forceinline__ float f16lo(unsigned w) { h16x2 v = __builtin_bit_cast(h16x2, w); return (float)v.x; }
__device__ __forceinline__ float f16hi(unsigned w) { h16x2 v = __builtin_bit_cast(h16x2, w); return (float)v.y; }
__device__ __forceinline__ float sigmoidf_(float x) { return 1.0f / (1.0f + __expf(-x)); }
__device__ __forceinline__ float siluf_(float x) { return x / (1.0f + __expf(-x)); }
__device__ __forceinline__ float gelu_tanh(float x) { const float u = 0.7978845608028654f * (x + 0.044715f * x * x * x); return 0.5f * x * (1.0f + tanhf(u)); }

#define XB_TMO      128
#define XB_XCNT(j)  (256  + 64 * (j))
#define XB_XSUB(j)  (1280 + 64 * (j))
#define XB_XGEN(j)  (2304 + 64 * (j))
#define XB_TOP      3328
#define XB_TOPGEN   3392
#define XCD_BAR_WORDS 3456
#define XB_SPIN_CAP (1u << 22)
__device__ __forceinline__ unsigned xb_ld(unsigned* p)              { return __hip_atomic_load(p, __ATOMIC_RELAXED, __HIP_MEMORY_SCOPE_AGENT); }
__device__ __forceinline__ unsigned xb_add(unsigned* p, unsigned v) { return __hip_atomic_fetch_add(p, v, __ATOMIC_RELAXED, __HIP_MEMORY_SCOPE_AGENT); }
__device__ __forceinline__ unsigned xb_xcc_id() { return (unsigned)__builtin_amdgcn_s_getreg((3 << 11) | 20) & 0xFu; }
#define XB_SPIN(cond, bar) do { unsigned _sp = 0; while (cond) { __builtin_amdgcn_s_sleep(1); \
    if ((++_sp & 255u) == 0u) { if (xb_ld(&(bar)[XB_TMO])) break; if (_sp > XB_SPIN_CAP) { atomicAdd(&(bar)[XB_TMO], 1u); break; } } } } while (0)
struct XcdBarrier { unsigned* bar; unsigned x; volatile LAS unsigned* st; };
__device__ __forceinline__ XcdBarrier xcd_barrier_post(unsigned* bar, volatile LAS unsigned* st) {
    XcdBarrier b; b.bar = bar; b.x = xb_xcc_id(); b.st = st;
    if (threadIdx.x == 0) (void)xb_add(&bar[XB_XCNT(b.x)], 1u);
    return b;
}
__device__ __forceinline__ void xcd_barrier_complete(unsigned* bar, unsigned x, unsigned& nloc, unsigned& nx) {
    const unsigned G = gridDim.x * gridDim.y * gridDim.z;
    unsigned sum, cnt, mine, sp = 0u;
    for (;;) {
        sum = 0u; cnt = 0u; mine = 0u;
#pragma unroll
        for (unsigned j = 0; j < 16; ++j) { const unsigned c = xb_ld(&bar[XB_XCNT(j)]); sum += c; cnt += (c > 0u) ? 1u : 0u; mine = (j == x) ? c : mine; }
        if (sum == G) break;
        __builtin_amdgcn_s_sleep(1);
        if ((++sp & 255u) == 0u) { if (xb_ld(&bar[XB_TMO])) break; if (sp > XB_SPIN_CAP) { atomicAdd(&bar[XB_TMO], 1u); break; } }
    }
    nloc = mine > 0u ? mine : 1u; nx = cnt > 0u ? cnt : 1u;
}
__device__ __forceinline__ void xcd_barrier(const XcdBarrier& b) {
    asm volatile("s_waitcnt vmcnt(0)" ::: "memory");
    __syncthreads();
    if (threadIdx.x == 0) {
        unsigned* bar = b.bar;
        __builtin_amdgcn_s_waitcnt(0);
        unsigned nloc = b.st[0], nx = b.st[1];
        if (nloc == 0u) { xcd_barrier_complete(bar, b.x, nloc, nx); b.st[0] = nloc; b.st[1] = nx; }
        const unsigned old = xb_add(&bar[XB_XSUB(b.x)], 1u);
        const unsigned gen = old / nloc;
        if (old + 1u == (gen + 1u) * nloc) {
            __builtin_amdgcn_fence(__ATOMIC_RELEASE, "agent");
            asm volatile("s_waitcnt vmcnt(0)" ::: "memory");
            const unsigned og = xb_add(&bar[XB_TOP], 1u);
            const unsigned tg = og / nx;
            if (og + 1u == (tg + 1u) * nx) xb_add(&bar[XB_TOPGEN], 1u);
            else XB_SPIN(xb_ld(&bar[XB_TOPGEN]) == tg, bar);
            __builtin_amdgcn_fence(__ATOMIC_ACQUIRE, "agent");
            xb_add(&bar[XB_XGEN(b.x)], 1u);
            asm volatile("s_waitcnt vmcnt(0)" ::: "memory");
        } else {
            XB_SPIN(xb_ld(&bar[XB_XGEN(b.x)]) == gen, bar);
            __builtin_amdgcn_fence(__ATOMIC_ACQUIRE, "agent");
            asm volatile("s_waitcnt vmcnt(0)" ::: "memory");
        }
    }
    __syncthreads();
}

__device__ __forceinline__ float wave_sum(float v) {
#pragma unroll
    for (int o = 1; o < 64; o <<= 1) v += __shfl_xor(v, o);
    return v;
}
__device__ __forceinline__ float sum16(float v) {
#pragma unroll
    for (int o = 1; o < 16; o <<= 1) v += __shfl_xor(v, o);
    return v;
}

__device__ __forceinline__ int rowof(int n, int b, int dir) {
    if (n < CTXL) { const int tc = dir ? (CTXL - 1 - n) : n; return ML + b * CTXL + tc; }
    const int tl = n - CTXL; const int t = dir ? (SEQL - 1 - tl) : tl; return b * SEQL + t;
}

__device__ __forceinline__ int permqk(int n) {
    const int d = n & 63, half = d >> 5, dd = d & 31, i = dd >> 2, j = dd & 3; return (n & ~63) + 8 * i + 4 * half + j;
}
template <bool PERMQK>
__device__ __forceinline__ void p0_transpose_item(const float* W, int K, int N, bf16* WT, LAS float* scr, int item, int lane) {
    const int nblk = N / 32, kb = item / nblk, nb = item % nblk, k0 = 64 * kb, n0 = 32 * nb;
#pragma unroll 8
    for (int i = 0; i < 32; ++i) { const int kk = 2 * i + (lane >> 5); scr[kk * 33 + (lane & 31)] = W[(size_t)(k0 + kk) * N + n0 + (lane & 31)]; }
    LDS_WAIT(); asm volatile("" ::: "memory");
    const int c = lane & 7;
#pragma unroll
    for (int j = 0; j < 4; ++j) { const int n = (lane >> 3) + 8 * j; const LAS float* s = scr + (8 * c) * 33 + n;
        v4u o; o.x = pk2(s[0 * 33], s[1 * 33]); o.y = pk2(s[2 * 33], s[3 * 33]); o.z = pk2(s[4 * 33], s[5 * 33]); o.w = pk2(s[6 * 33], s[7 * 33]);
        int nd = n0 + n; if (PERMQK && nd < 512) nd = permqk(nd);
        *(GAS v4u*)(WT + (size_t)nd * K + k0 + 8 * c) = o; }
    LDS_WAIT(); asm volatile("" ::: "memory");
}

__device__ __forceinline__ void norm_mod_rows(const float* hl, const float* hc, int nrows, const float* g, const float* mod, int shift_off, int scale_off, bf16* XN, int gw, int NGW, int lane) {
    for (int row = gw; row < nrows; row += NGW) {
        const float* xr = row < ML ? hl + (size_t)row * DM : hc + (size_t)(row - ML) * DM;
        const int mr = row < ML ? (row >> 12) : 8;
        const f32x4* x4 = (const f32x4*)xr + lane;
        f32x4 v[4]; float s = 0.f;
#pragma unroll
        for (int j = 0; j < 4; ++j) { v[j] = x4[64 * j]; s += (v[j].x * v[j].x + v[j].y * v[j].y) + (v[j].z * v[j].z + v[j].w * v[j].w); }
        const float rstd = 1.0f / sqrtf(wave_sum(s) * (1.f / DM) + EPSN);
        const f32x4* g4 = (const f32x4*)g + lane; const f32x4* sc4 = (const f32x4*)(mod + (size_t)mr * NMOD + scale_off) + lane; const f32x4* sh4 = (const f32x4*)(mod + (size_t)mr * NMOD + shift_off) + lane;
        unsigned long long* o8 = (unsigned long long*)(XN + (size_t)row * DM) + lane;
#pragma unroll
        for (int j = 0; j < 4; ++j) { const f32x4 gg = g4[64 * j], sc = sc4[64 * j], sh = sh4[64 * j];
            const f32x4 y = (v[j] * rstd) * gg * (sc + 1.0f) + sh;
            o8[64 * j] = (unsigned long long)pk2(y.x, y.y) | ((unsigned long long)pk2(y.z, y.w) << 32); }
    }
}
__device__ __forceinline__ void final_norm_rows(float* h, const float* g, int gw, int NGW, int lane) {
    for (int row = gw; row < ML; row += NGW) {
        f32x4* x4 = (f32x4*)(h + (size_t)row * DM) + lane;
        f32x4 v[4]; float s = 0.f;
#pragma unroll
        for (int j = 0; j < 4; ++j) { v[j] = x4[64 * j]; s += (v[j].x * v[j].x + v[j].y * v[j].y) + (v[j].z * v[j].z + v[j].w * v[j].w); }
        const float rstd = 1.0f / sqrtf(wave_sum(s) * (1.f / DM) + EPSN);
        const f32x4* g4 = (const f32x4*)g + lane;
#pragma unroll
        for (int j = 0; j < 4; ++j) x4[64 * j] = (v[j] * rstd) * g4[64 * j];
    }
}
__device__ __forceinline__ void unpack8(const v4u w, float (&o)[8]) { o[0] = bflo(w.x); o[1] = bfhi(w.x); o[2] = bflo(w.y); o[3] = bfhi(w.y); o[4] = bflo(w.z); o[5] = bfhi(w.z); o[6] = bflo(w.w); o[7] = bfhi(w.w); }
__device__ __forceinline__ v4u pack8(const float (&o)[8]) { v4u w; w.x = pk2(o[0], o[1]); w.y = pk2(o[2], o[3]); w.z = pk2(o[4], o[5]); w.w = pk2(o[6], o[7]); return w; }

__device__ __forceinline__ void merge1_rows(bf16* OS, const unsigned char* ws, const bf16* P1, const float* hgn, int gw, int NGW, int lane) {
    for (int row = gw; row < ML; row += NGW) {
#pragma unroll
        for (int half = 0; half < 2; ++half) {
            const int c0 = half * 512 + lane * 8;
            const v4u ow = *(const v4u*)(OS + (size_t)row * 1024 + c0), gw4 = *(const v4u*)(P1 + (size_t)row * 5120 + 4096 + c0);
            const v4u ob = *(const v4u*)((const bf16*)(ws + ws_ob(row >> 12)) + (size_t)(row & (SEQL - 1)) * 1024 + c0);
            const f32x4 n0 = *(const f32x4*)(hgn + (c0 & 127)), n1 = *(const f32x4*)(hgn + (c0 & 127) + 4);
            float o[8], gg[8], o2[8]; unpack8(ow, o); unpack8(gw4, gg); unpack8(ob, o2);
            float ss = 0.f;
#pragma unroll
            for (int i = 0; i < 8; ++i) o[i] += o2[i];
#pragma unroll
            for (int i = 0; i < 8; ++i) ss += o[i] * o[i];
            const float rs = 1.0f / sqrtf(sum16(ss) * (1.f / 128.f) + EPSN);
            const float nn[8] = {n0.x, n0.y, n0.z, n0.w, n1.x, n1.y, n1.z, n1.w};
            float r[8];
#pragma unroll
            for (int i = 0; i < 8; ++i) r[i] = o[i] * rs * nn[i] * siluf_(gg[i]);
            *(v4u*)(OS + (size_t)row * 1024 + c0) = pack8(r);
        }
    }
}

using pg8::Unit; using pg8::HALF; using pg8::BM;
__device__ __forceinline__ v4u pack2x4(const f32x4 v0, const f32x4 v1) { v4u w; w.x = pg8::cvt_pk_bf16(v0[0], v0[1]); w.y = pg8::cvt_pk_bf16(v0[2], v0[3]); w.z = pg8::cvt_pk_bf16(v1[0], v1[1]); w.w = pg8::cvt_pk_bf16(v1[2], v1[3]); return w; }

struct EpiProj0 {
    static constexpr bool PERM = true, AFTER_DRAIN = false;
    bf16* O; const float* CS; bf16* UA;
    __device__ __forceinline__ void operator()(const f32x4 (&acc)[2][2][4][2], const Unit& u, int wr, int wc, int fr, int fq) const {
        const int row0 = u.pm * BM + wr * 64 + fr, col0 = u.pn * BM + wc * 32 + 8 * fq;
        const bool lat = u.pm < ML / BM;
        const bool rope = (u.pn < 2) && lat; const float sc = (u.pn == 1) ? 0.125f : 1.0f;
        const bool isu = (u.pn == 4) || (u.pn == 5);
        const int ocol0 = (u.pn >= 6) ? col0 - 512 : col0;
        const int i4 = 4 * (4 * (wc & 1) + fq);
#pragma unroll
        for (int ai = 0; ai < 2; ++ai)
#pragma unroll
            for (int m = 0; m < 4; ++m) { const int row = row0 + ai * HALF + m * 16;
                f32x4 ca = (f32x4){1.f, 0.f, 1.f, 0.f}, cb = ca;
                if (rope) { const float* p = CS + ((size_t)(row & (SEQL - 1)) * 32 + i4) * 2; ca = *(const f32x4*)p; cb = *(const f32x4*)(p + 4); }
                bf16* rowp = O + (size_t)row * P0LD + ocol0;
                int r5, i5;
                if (lat) { const int t = row & (SEQL - 1); r5 = (row >> 12) * 136 + 8 + (t >> 5); i5 = t & 31; }
                else { const int rc = row - ML, t = rc & (CTXL - 1); r5 = (rc >> 8) * 136 + (t >> 5); i5 = t & 31; }
#pragma unroll
                for (int bj = 0; bj < 2; ++bj) { f32x4 v0 = acc[ai][bj][m][0], v1 = acc[ai][bj][m][1];
                    if (rope) {
                        const f32x4 lo = (f32x4){v0[0] * ca[0] - v1[0] * ca[1], v0[1] * ca[2] - v1[1] * ca[3], v0[2] * cb[0] - v1[2] * cb[1], v0[3] * cb[2] - v1[3] * cb[3]};
                        const f32x4 hi = (f32x4){v0[0] * ca[1] + v1[0] * ca[0], v0[1] * ca[3] + v1[1] * ca[2], v0[2] * cb[1] + v1[2] * cb[0], v0[3] * cb[3] + v1[3] * cb[2]};
                        v0 = lo; v1 = hi; }
                    v0 = v0 * sc; v1 = v1 * sc;
                    const v4u w = pack2x4(v0, v1);
                    if (isu) { const int c = col0 + bj * HALF - 1024, g5 = c >> 4, m0 = c & 15;
                        *(v4u*)(UA + ((size_t)(g5 * S5RP + r5) * S5K + i5 * 16 + m0)) = w; }
                    else *(v4u*)(rowp + bj * HALF) = w; } }
    }
};
struct EpiGlu {
    static constexpr bool PERM = true, AFTER_DRAIN = false;
    const bf16* Y; const float* b; bf16* Z;
    __device__ __forceinline__ void operator()(const f32x4 (&acc)[2][2][4][2], const Unit& u, int wr, int wc, int fr, int fq) const {
        const int row0 = u.pm * BM + wr * 64 + fr, col0 = u.pn * BM + wc * 32 + 8 * fq;
        f32x4 bv[2][2];
#pragma unroll
        for (int bj = 0; bj < 2; ++bj)
#pragma unroll
            for (int n = 0; n < 2; ++n) bv[bj][n] = *(const f32x4*)(b + col0 + bj * HALF + 4 * n);
#pragma unroll
        for (int ai = 0; ai < 2; ++ai)
#pragma unroll
            for (int m = 0; m < 4; ++m) { const int row = row0 + ai * HALF + m * 16;
#pragma unroll
                for (int bj = 0; bj < 2; ++bj) { const int col = col0 + bj * HALF;
                    const v4u yw = *(const v4u*)(Y + (size_t)row * 512 + col); float yy[8]; unpack8(yw, yy);
                    const f32x4 a0 = acc[ai][bj][m][0] + bv[bj][0], a1 = acc[ai][bj][m][1] + bv[bj][1];
                    const f32x4 z0 = (f32x4){yy[0] * sigmoidf_(a0[0]), yy[1] * sigmoidf_(a0[1]), yy[2] * sigmoidf_(a0[2]), yy[3] * sigmoidf_(a0[3])};
                    const f32x4 z1 = (f32x4){yy[4] * sigmoidf_(a1[0]), yy[5] * sigmoidf_(a1[1]), yy[6] * sigmoidf_(a1[2]), yy[7] * sigmoidf_(a1[3])};
                    *(v4u*)(Z + (size_t)row * 1024 + col) = pack2x4(z0, z1); } }
    }
};
struct EpiResid {
    static constexpr bool PERM = false, AFTER_DRAIN = false;
    const float* baseL; const float* baseC; float* outL; float* outC; const float* gate;
    __device__ __forceinline__ void operator()(const f32x4 (&acc)[2][2][4][2], const Unit& u, int wr, int wc, int fr, int fq) const {
        const bool ctx = u.pm >= ML / BM; const int mr = ctx ? 8 : (u.pm >> 4);
        const int row0 = (ctx ? u.pm - ML / BM : u.pm) * BM + wr * 64 + fr, col0 = u.pn * BM + wc * 32 + 4 * fq;
        const float* B = ctx ? baseC : baseL; float* Oo = ctx ? outC : outL;
        f32x4 gv[2][2];
#pragma unroll
        for (int bj = 0; bj < 2; ++bj)
#pragma unroll
            for (int n = 0; n < 2; ++n) gv[bj][n] = *(const f32x4*)(gate + (size_t)mr * NMOD + col0 + bj * HALF + n * 16);
#pragma unroll
        for (int ai = 0; ai < 2; ++ai)
#pragma unroll
            for (int m = 0; m < 4; ++m) { const size_t off = (size_t)(row0 + ai * HALF + m * 16) * DM + col0;
#pragma unroll
                for (int bj = 0; bj < 2; ++bj)
#pragma unroll
                    for (int n = 0; n < 2; ++n) { const f32x4 bs = *(const f32x4*)(B + off + bj * HALF + n * 16);
                        *(f32x4*)(Oo + off + bj * HALF + n * 16) = bs + gv[bj][n] * acc[ai][bj][m][n]; } }
    }
};
struct EpiSqrelu {
    static constexpr bool PERM = true, AFTER_DRAIN = false;
    bf16* O;
    __device__ __forceinline__ void operator()(const f32x4 (&acc)[2][2][4][2], const Unit& u, int wr, int wc, int fr, int fq) const {
        const int row0 = u.pm * BM + wr * 64 + fr, col0 = u.pn * BM + wc * 32 + 8 * fq;
#pragma unroll
        for (int ai = 0; ai < 2; ++ai)
#pragma unroll
            for (int m = 0; m < 4; ++m) { bf16* rowp = O + (size_t)(row0 + ai * HALF + m * 16) * DFF + col0;
#pragma unroll
                for (int bj = 0; bj < 2; ++bj) { f32x4 v0 = acc[ai][bj][m][0], v1 = acc[ai][bj][m][1];
                    v0 = __builtin_elementwise_max(v0, (f32x4){0.f, 0.f, 0.f, 0.f}); v1 = __builtin_elementwise_max(v1, (f32x4){0.f, 0.f, 0.f, 0.f});
                    *(v4u*)(rowp + bj * HALF) = pack2x4(v0 * v0, v1 * v1); } }
    }
};
struct EpiProj1 {
    static constexpr bool PERM = true, AFTER_DRAIN = false;
    bf16* O; const float* LB;
    __device__ __forceinline__ void operator()(const f32x4 (&acc)[2][2][4][2], const Unit& u, int wr, int wc, int fr, int fq) const {
        const int row0 = u.pm * BM + wr * 64 + fr, col0 = u.pn * BM + wc * 32 + 8 * fq;
        const int kind = u.pn >> 2;
        const bool gatek = (kind == 1) || (kind == 2);
        f32x4 lb[2][2];
#pragma unroll
        for (int bj = 0; bj < 2; ++bj)
#pragma unroll
            for (int n = 0; n < 2; ++n) lb[bj][n] = gatek ? *(const f32x4*)(LB + (size_t)(kind - 1) * 1024 + ((col0 + bj * HALF) & 1023) + 4 * n) : (f32x4){0.f, 0.f, 0.f, 0.f};
#pragma unroll
        for (int ai = 0; ai < 2; ++ai)
#pragma unroll
            for (int m = 0; m < 4; ++m) { bf16* rowp = O + (size_t)(row0 + ai * HALF + m * 16) * 5120 + col0;
#pragma unroll
                for (int bj = 0; bj < 2; ++bj) { const f32x4 v0 = acc[ai][bj][m][0], v1 = acc[ai][bj][m][1];
                    v4u w;
                    if (gatek) {
                        float l0[4], l1[4];
#pragma unroll
                        for (int i = 0; i < 4; ++i) { l0[i] = __logf(lb[bj][0][i] + (1.0f - lb[bj][0][i]) * sigmoidf_(v0[i])); l1[i] = __logf(lb[bj][1][i] + (1.0f - lb[bj][1][i]) * sigmoidf_(v1[i])); }
                        w.x = pk_f16(l0[0], l0[1]); w.y = pk_f16(l0[2], l0[3]); w.z = pk_f16(l1[0], l1[1]); w.w = pk_f16(l1[2], l1[3]);
                    } else w = pack2x4(v0, v1);
                    *(v4u*)(rowp + bj * HALF) = w; } }
    }
};

struct EpiHloc {
    static constexpr bool PERM = false, AFTER_DRAIN = false;
    float* C;
    __device__ __forceinline__ void operator()(const f32x4 (&acc)[2][2][4][2], const Unit& u, int wr, int wc, int fr, int fq) const {
        const int row0 = u.pm * BM + wr * 64 + fr, col0 = wc * 32 + 4 * fq;
#pragma unroll
        for (int ai = 0; ai < 2; ++ai)
#pragma unroll
            for (int m = 0; m < 4; ++m) { float* rowp = C + (size_t)(row0 + ai * HALF + m * 16) * 256 + col0;
#pragma unroll
                for (int bj = 0; bj < 2; ++bj)
#pragma unroll
                    for (int n = 0; n < 2; ++n) *(f32x4*)(rowp + bj * HALF + n * 16) = acc[ai][bj][m][n]; }
    }
};
struct EpiS5Out {
    static constexpr bool PERM = true, AFTER_DRAIN = false;
    const bf16* UA; const float* dskip; bf16* Y;
    __device__ __forceinline__ void operator()(const f32x4 (&acc)[2][2][4][2], const Unit& u, int wr, int wc, int fr, int fq) const {
        const int g5 = u.pm / 5, pml = u.pm - 5 * g5, pnl = u.pn - 2 * g5;
        const int r0 = pml * BM + wr * 64 + fr, col0 = pnl * BM + wc * 32 + 8 * fq;
#pragma unroll
        for (int ai = 0; ai < 2; ++ai)
#pragma unroll
            for (int m = 0; m < 4; ++m) { const int r = r0 + ai * HALF + m * 16;
                if (r < S5R) {
                    const int b = r / 136, ch = r - b * 136;
#pragma unroll
                    for (int bj = 0; bj < 2; ++bj) { const int col = col0 + bj * HALF, i5 = col >> 4, m0 = col & 15;
                        const int trow = ch < 8 ? ML + b * CTXL + ch * 32 + i5 : b * SEQL + (ch - 8) * 32 + i5;
                        const v4u uw = *(const v4u*)(UA + ((size_t)(g5 * S5RP + r) * S5K + col)); float uu[8]; unpack8(uw, uu);
                        const f32x4 d0 = *(const f32x4*)(dskip + g5 * 16 + m0), d1 = *(const f32x4*)(dskip + g5 * 16 + m0 + 4);
                        const f32x4 a0 = acc[ai][bj][m][0], a1 = acc[ai][bj][m][1];
                        const f32x4 y0 = (f32x4){gelu_tanh(a0[0] + d0[0] * uu[0]), gelu_tanh(a0[1] + d0[1] * uu[1]), gelu_tanh(a0[2] + d0[2] * uu[2]), gelu_tanh(a0[3] + d0[3] * uu[3])};
                        const f32x4 y1 = (f32x4){gelu_tanh(a1[0] + d1[0] * uu[4]), gelu_tanh(a1[1] + d1[1] * uu[5]), gelu_tanh(a1[2] + d1[2] * uu[6]), gelu_tanh(a1[3] + d1[3] * uu[7])};
                        *(v4u*)(Y + (size_t)trow * 512 + g5 * 16 + m0) = pack2x4(y0, y1); } } }
    }
};

__device__ __forceinline__ f32x2 cmul(f32x2 a, f32x2 b) { return (f32x2){a.x * b.x - a.y * b.y, a.x * b.y + a.y * b.x}; }
__device__ __forceinline__ void s5_tables_item(LAS unsigned char* lds, int g, const float* a_re, const float* a_im, const float* log_dt, const float* b_re, const float* b_im,
                                               const float* c_re, const float* c_im, bf16* Bc, bf16* Ws5) {
    const int tid = threadIdx.x;
    LAS f32x2* POW = (LAS f32x2*)lds;
    LAS f32x2* BBl = (LAS f32x2*)(lds + 33792);
    LAS f32x2* CCl = (LAS f32x2*)(lds + 50176);
    LAS float* KRN = (LAS float*)(lds + 66560);
    if (tid < 128) {
        const int d = tid >> 6, p = tid & 63, i = (d * 32 + g) * 64 + p;
        const float dt = expf(log_dt[d * 32 + g]); const float are = a_re[i], aim = a_im[i];
        const float mag = expf(are * dt), ang = aim * dt; const f32x2 ab = (f32x2){mag * cosf(ang), mag * sinf(ang)};
        const float nr = ab.x - 1.0f, ni = ab.y, den = are * are + aim * aim; const float fr = (nr * are + ni * aim) / den, fi = (ni * are - nr * aim) / den;
        f32x2 pw = (f32x2){1.f, 0.f};
        for (int e = 0; e <= 32; ++e) { POW[(d * 64 + p) * 33 + e] = pw; pw = cmul(pw, ab); }
        for (int n = 0; n < 16; ++n) { const float br = b_re[(size_t)i * 16 + n], bi = b_im[(size_t)i * 16 + n]; BBl[(d * 64 + p) * 16 + n] = (f32x2){fr * br - fi * bi, fr * bi + fi * br}; }
    }
    for (int o = tid; o < 2048; o += NWAVES * 64) { const int d = o >> 10, m = (o >> 6) & 15, p = o & 63; const size_t ci = ((size_t)(d * 32 + g) * 16 + m) * 64 + p; CCl[o] = (f32x2){c_re[ci], c_im[ci]}; }
    __syncthreads();
    for (int k = 0; k < 8; ++k) { const int o4 = tid + 512 * k, d = o4 >> 11, tau = (o4 >> 6) & 31, m = (o4 >> 2) & 15, nq = o4 & 3;
        float a0 = 0.f, a1 = 0.f, a2 = 0.f, a3 = 0.f;
        for (int p = 0; p < 64; ++p) { const f32x2 cp = cmul(CCl[(d * 16 + m) * 64 + p], POW[(d * 64 + p) * 33 + tau]); const LAS f32x2* bb = BBl + (d * 64 + p) * 16 + nq * 4;
            a0 += cp.x * bb[0].x - cp.y * bb[0].y; a1 += cp.x * bb[1].x - cp.y * bb[1].y; a2 += cp.x * bb[2].x - cp.y * bb[2].y; a3 += cp.x * bb[3].x - cp.y * bb[3].y; }
        *(LAS f32x4*)(KRN + ((d * 32 + tau) * 16 + m) * 16 + nq * 4) = (f32x4){a0, a1, a2, a3}; }
    __syncthreads();
    for (int k = 0; k < 96; ++k) { const int ch = tid + 512 * k, row = ch / 96, kc = ch - row * 96, k0 = kc * 8, i = row >> 4, m = row & 15;
        float v[8];
        if (k0 < 512) { const int j = k0 >> 4, n0 = k0 & 15;
            if (i > j) { const LAS float* s = KRN + ((0 * 32 + (i - j)) * 16 + m) * 16 + n0;
#pragma unroll
                for (int t = 0; t < 8; ++t) v[t] = s[t]; }
            else if (i < j) { const LAS float* s = KRN + ((1 * 32 + (j - i)) * 16 + m) * 16 + n0;
#pragma unroll
                for (int t = 0; t < 8; ++t) v[t] = s[t]; }
            else { const LAS float* s0 = KRN + ((0 * 32 + 0) * 16 + m) * 16 + n0; const LAS float* s1 = KRN + ((1 * 32 + 0) * 16 + m) * 16 + n0;
#pragma unroll
                for (int t = 0; t < 8; ++t) v[t] = s0[t] + s1[t]; }
        } else { const int q0 = k0 - 512, d = q0 >> 7, p0 = (q0 & 127) >> 1, e = d == 0 ? i + 1 : 32 - i;
#pragma unroll
            for (int t = 0; t < 4; ++t) { const f32x2 ca = cmul(CCl[(d * 16 + m) * 64 + p0 + t], POW[(d * 64 + p0 + t) * 33 + e]); v[2 * t] = ca.x; v[2 * t + 1] = -ca.y; } }
        *(v4u*)(Bc + ((size_t)(g * 512 + row) * S5K + k0)) = pack8(v); }
    for (int k = 0; k < 32; ++k) { const int ch = tid + 512 * k, q = ch >> 6, kc = ch & 63, k0 = kc * 8, j = k0 >> 4, n0 = k0 & 15;
        const int d = q >> 7, p = (q & 127) >> 1, ri = q & 1, ef = d == 0 ? 31 - j : j;
        const f32x2 pw = POW[(d * 64 + p) * 33 + ef]; float v[8];
#pragma unroll
        for (int t = 0; t < 8; ++t) { const f32x2 w = cmul(pw, BBl[(d * 64 + p) * 16 + n0 + t]); v[t] = ri ? w.y : w.x; }
        *(v4u*)(Ws5 + ((size_t)(g * 256 + q) * 512 + k0)) = pack8(v); }
    __syncthreads();
}
__device__ __forceinline__ void s5_scan(const float* HL, bf16* UA, const f32x2* AB, int gw, int NGW, int lane) {
    for (int w = gw; w < 512; w += NGW) {
        const int b = w >> 6, g = (w >> 1) & 31, d = w & 1;
        f32x2 a32 = AB[(d * 32 + g) * 64 + lane];
#pragma unroll
        for (int i = 0; i < 5; ++i) a32 = cmul(a32, a32);
        f32x2 h = (f32x2){0.f, 0.f};
        const size_t rbase = (size_t)g * S5RP + b * 136;
#pragma unroll 1
        for (int s0 = 0; s0 < 136; s0 += 34) {
            f32x2 hl[34];
#pragma unroll
            for (int k = 0; k < 34; ++k) { const int s = s0 + k, c = d == 0 ? s : (s < 8 ? 7 - s : 143 - s); hl[k] = *(const f32x2*)(HL + (rbase + c) * 256 + d * 128 + lane * 2); }
#pragma unroll
            for (int k = 0; k < 34; ++k) { const int s = s0 + k, c = d == 0 ? s : (s < 8 ? 7 - s : 143 - s);
                *(unsigned*)(UA + (rbase + c) * S5K + 512 + d * 128 + lane * 2) = pk2(h.x, h.y);
                h = cmul(a32, h) + hl[k]; }
        }
    }
}

typedef short bf16x8_t __attribute__((ext_vector_type(8)));
__device__ __forceinline__ bf16x8_t frag_rm(const LAS unsigned char* T, int RS, int r0, int k0, int lane) { return *(const LAS bf16x8_t*)(T + (r0 + (lane & 15)) * RS + (k0 + 8 * (lane >> 4)) * 2); }
#define MFMA16(a, b, c) __builtin_amdgcn_mfma_f32_16x16x32_bf16((a), (b), (c), 0, 0, 0)
__device__ __forceinline__ bf16x8_t scale_frag(bf16x8_t f, float sc) {
    const v4u w = __builtin_bit_cast(v4u, f); float t[8]; unpack8(w, t);
    v4u o; o.x = pk2(t[0] * sc, t[1] * sc); o.y = pk2(t[2] * sc, t[3] * sc); o.z = pk2(t[4] * sc, t[5] * sc); o.w = pk2(t[6] * sc, t[7] * sc);
    return __builtin_bit_cast(bf16x8_t, o);
}
constexpr int RCH = 34;
__device__ __forceinline__ int ret_row0(int b, int s) { return s < 2 ? ML + b * CTXL + s * 128 : b * SEQL + (s - 2) * 128; }
__device__ __forceinline__ void stage_vt(LAS unsigned char* Vt, const bf16* P0, int row0, int h, int tid) {
#pragma unroll
    for (int k = 0; k < 4; ++k) { const int c = tid + 512 * k, j = c & 127, e0 = (c >> 7) * 8;
        const v4u w = *(const v4u*)(P0 + (size_t)(row0 + j) * P0LD + 512 + h * 128 + e0);
        LAS unsigned short* p = (LAS unsigned short*)(Vt + e0 * 272 + j * 2);
        p[0 * 136] = (unsigned short)(w.x & 0xffffu); p[1 * 136] = (unsigned short)(w.x >> 16); p[2 * 136] = (unsigned short)(w.y & 0xffffu); p[3 * 136] = (unsigned short)(w.y >> 16);
        p[4 * 136] = (unsigned short)(w.z & 0xffffu); p[5 * 136] = (unsigned short)(w.z >> 16); p[6 * 136] = (unsigned short)(w.w & 0xffffu); p[7 * 136] = (unsigned short)(w.w >> 16); }
}
__device__ __forceinline__ void ret_passA_item(LAS unsigned char* lds, int it, const bf16* P0, const float* ret_logit, bf16* ULOC) {
    int tid_ = threadIdx.x; asm volatile("" : "+v"(tid_)); const int tid = tid_, lane = tid & 63, w = tid >> 6, g4 = lane >> 4;
    const int bh = it / RCH, s = it - bh * RCH, b = bh >> 2, h = bh & 3, row0 = ret_row0(b, s);
    const float lgf = log2f(1.0f / (1.0f + expf(-ret_logit[h]))), lgb = log2f(1.0f / (1.0f + expf(-ret_logit[4 + h])));
    LAS unsigned char* KtF = lds; LAS unsigned char* KtB = lds + 17408; LAS unsigned char* Vt = lds + 34816;
#pragma unroll
    for (int k = 0; k < 2; ++k) { const int c = tid + 512 * k, j = c & 127, d0 = (c >> 7) * 8;
        const v4u wv = *(const v4u*)(P0 + (size_t)(row0 + j) * P0LD + 256 + h * 64 + d0); float t[8]; unpack8(wv, t);
        const float sf = exp2f((float)(127 - j) * lgf), sb = exp2f((float)j * lgb);
        LAS unsigned short* pf = (LAS unsigned short*)(KtF + d0 * 272 + j * 2); LAS unsigned short* pb = (LAS unsigned short*)(KtB + d0 * 272 + j * 2);
#pragma unroll
        for (int i = 0; i < 8; ++i) { pf[i * 136] = (unsigned short)f2bf(t[i] * sf); pb[i * 136] = (unsigned short)f2bf(t[i] * sb); } }
    stage_vt(Vt, P0, row0, h, tid);
    __syncthreads();
    f32x4 acc[2][4];
#pragma unroll
    for (int d = 0; d < 2; ++d)
#pragma unroll
        for (int dt = 0; dt < 4; ++dt) acc[d][dt] = (f32x4){0.f, 0.f, 0.f, 0.f};
#pragma unroll
    for (int ks = 0; ks < 4; ++ks) { const bf16x8_t vb = frag_rm(Vt, 272, 16 * w, 32 * ks, lane);
#pragma unroll
        for (int dt = 0; dt < 4; ++dt) { acc[0][dt] = MFMA16(frag_rm(KtF, 272, 16 * dt, 32 * ks, lane), vb, acc[0][dt]); acc[1][dt] = MFMA16(frag_rm(KtB, 272, 16 * dt, 32 * ks, lane), vb, acc[1][dt]); } }
    const int e = 16 * w + (lane & 15);
#pragma unroll
    for (int d = 0; d < 2; ++d)
#pragma unroll
        for (int dt = 0; dt < 4; ++dt) { v2u o; o.x = pk2(acc[d][dt][0], acc[d][dt][1]); o.y = pk2(acc[d][dt][2], acc[d][dt][3]);
            *(v2u*)(ULOC + ((size_t)((bh * 2 + d) * RCH + s) * 128 + e) * 64 + 16 * dt + 4 * g4) = o; }
    __syncthreads();
}
__device__ __forceinline__ void ret_scan(const bf16* ULOC, bf16* SIN, const float* ret_logit, int gt, int NT) {
    for (int idx = gt; idx < 64 * 2048; idx += NT) {
        const int bhd = idx >> 11, off = (idx & 2047) * 4, dir = bhd & 1, h = (bhd >> 1) & 3;
        const float g128 = exp2f(128.0f * log2f(1.0f / (1.0f + expf(-ret_logit[dir * 4 + h]))));
        const size_t base = (size_t)bhd * RCH * 8192 + off;
        v2u u[RCH];
#pragma unroll
        for (int k = 0; k < RCH; ++k) { const int s = dir == 0 ? k : (k < 2 ? 1 - k : 35 - k); u[k] = *(const v2u*)(ULOC + base + (size_t)s * 8192); }
        float st[4] = {0.f, 0.f, 0.f, 0.f};
#pragma unroll
        for (int k = 0; k < RCH; ++k) { const int s = dir == 0 ? k : (k < 2 ? 1 - k : 35 - k);
            v2u o; o.x = pg8::cvt_pk_bf16(st[0], st[1]); o.y = pg8::cvt_pk_bf16(st[2], st[3]); *(v2u*)(SIN + base + (size_t)s * 8192) = o;
            st[0] = g128 * st[0] + bflo(u[k].x); st[1] = g128 * st[1] + bfhi(u[k].x); st[2] = g128 * st[2] + bflo(u[k].y); st[3] = g128 * st[3] + bfhi(u[k].y); }
    }
}
__device__ __forceinline__ void ret_passC_item(LAS unsigned char* lds, int it, const bf16* P0, const float* ret_logit, const bf16* SIN, bf16* RZ) {
    int tid_ = threadIdx.x; asm volatile("" : "+v"(tid_)); const int tid = tid_, lane = tid & 63, w = tid >> 6, g4 = lane >> 4, l15 = lane & 15;
    const int bh = it / RCH, s = it - bh * RCH, b = bh >> 2, h = bh & 3, row0 = ret_row0(b, s);
    const float lgf = log2f(1.0f / (1.0f + expf(-ret_logit[h]))), lgb = log2f(1.0f / (1.0f + expf(-ret_logit[4 + h])));
    LAS unsigned char* Qs = lds; LAS unsigned char* Ks = lds + 18432; LAS unsigned char* SfT = lds + 36864; LAS unsigned char* SbT = lds + 55296; LAS unsigned char* Vt = lds + 73728;
    LAS unsigned char* Pm = lds + 108544;
#pragma unroll
    for (int k = 0; k < 2; ++k) { const int c = tid + 512 * k, j = c >> 3, ch = c & 7;
        *(LAS v4u*)(Qs + j * 144 + ch * 16) = *(const v4u*)(P0 + (size_t)(row0 + j) * P0LD + h * 64 + ch * 8);
        *(LAS v4u*)(Ks + j * 144 + ch * 16) = *(const v4u*)(P0 + (size_t)(row0 + j) * P0LD + 256 + h * 64 + ch * 8);
        *(LAS v4u*)(SfT + j * 144 + ch * 16) = *(const v4u*)(SIN + ((size_t)((bh * 2 + 0) * RCH + s) * 128 + j) * 64 + ch * 8);
        *(LAS v4u*)(SbT + j * 144 + ch * 16) = *(const v4u*)(SIN + ((size_t)((bh * 2 + 1) * RCH + s) * 128 + j) * 64 + ch * 8); }
    stage_vt(Vt, P0, row0, h, tid);
    __syncthreads();
    f32x4 accO[8], accA[8];
#pragma unroll
    for (int t = 0; t < 8; ++t) { accO[t] = (f32x4){0.f, 0.f, 0.f, 0.f}; accA[t] = (f32x4){0.f, 0.f, 0.f, 0.f}; }
    { const int il = 16 * w + l15;
      const float af = exp2f((float)(il + 1) * lgf), ab = exp2f((float)(128 - il) * lgb);
#pragma unroll
      for (int ks = 0; ks < 2; ++ks) { const bf16x8_t q = frag_rm(Qs, 144, 16 * w, 32 * ks, lane); const bf16x8_t qf = scale_frag(q, af), qb = scale_frag(q, ab);
#pragma unroll
          for (int t = 0; t < 8; ++t) { accA[t] = MFMA16(q, frag_rm(Ks, 144, 16 * t, 32 * ks, lane), accA[t]);
              accO[t] = MFMA16(qf, frag_rm(SfT, 144, 16 * t, 32 * ks, lane), accO[t]); accO[t] = MFMA16(qb, frag_rm(SbT, 144, 16 * t, 32 * ks, lane), accO[t]); } } }
    __syncthreads();
#pragma unroll
    for (int t = 0; t < 8; ++t)
#pragma unroll
        for (int r = 0; r < 4; ++r) { const int i = 16 * w + 4 * g4 + r, j = 16 * t + l15;
            const float dm = i > j ? exp2f((float)(i - j) * lgf) : (i < j ? exp2f((float)(j - i) * lgb) : 2.0f);
            *(LAS unsigned short*)(Pm + i * 272 + j * 2) = (unsigned short)f2bf(accA[t][r] * dm); }
    __syncthreads();
#pragma unroll
    for (int ks = 0; ks < 4; ++ks) { const bf16x8_t p = frag_rm(Pm, 272, 16 * w, 32 * ks, lane);
#pragma unroll
        for (int t = 0; t < 8; ++t) accO[t] = MFMA16(p, frag_rm(Vt, 272, 16 * t, 32 * ks, lane), accO[t]); }
#pragma unroll
    for (int r = 0; r < 4; ++r) { float ss = 0.f;
#pragma unroll
        for (int t = 0; t < 8; ++t) ss += accO[t][r] * accO[t][r];
        const float rs = 1.0f / sqrtf(sum16(ss) * (1.f / 128.f) + EPSN);
        const size_t row = (size_t)(row0 + 16 * w + 4 * g4 + r);
#pragma unroll
        for (int t = 0; t < 8; ++t) { const int e = 16 * t + l15; const float gt = bf2f(P0[row * P0LD + 1024 + h * 128 + e]);
            RZ[row * 1024 + h * 128 + e] = (bf16)f2bf(accO[t][r] * rs * siluf_(gt)); } }
    __syncthreads();
}
__device__ __forceinline__ int hg_row0(int b, int dir, int st) {
    if (st < 8) { const int c = dir ? 7 - st : st; return ML + b * CTXL + c * 32; }
    const int c = dir ? 135 - st : st - 8; return b * SEQL + c * 32;
}
struct HgRaw { v4u q0, q1, l0, l1, v; };
#define HG_ISSUE(R_, st_) do { const int r0_ = hg_row0(b, dir, (st_)); \
        const bf16* qp_ = P1 + (size_t)(r0_ + rtok) * 5120 + h * 128 + rseg; \
        (R_).q0 = *(const v4u*)qp_; (R_).q1 = *(const v4u*)(qp_ + (size_t)16 * 5120); (R_).l0 = *(const v4u*)(qp_ + 1024 + dir * 1024); (R_).l1 = *(const v4u*)(qp_ + (size_t)16 * 5120 + 1024 + dir * 1024); \
        (R_).v = *(const v4u*)(P1 + (size_t)(r0_ + tv) * 5120 + 3072 + h * 128 + eh * 64 + eseg); } while (0)
__device__ __forceinline__ float f16bits(unsigned short hbits) { return (float)__builtin_bit_cast(_Float16, hbits); }
__device__ __forceinline__ void hgrn_item(LAS unsigned char* lds, int it, const bf16* P1, bf16* OS, unsigned char* ws) {
    int tid_ = threadIdx.x; asm volatile("" : "+v"(tid_)); const int tid = tid_;
    const int lane = tid & 63, w = tid >> 6, g4 = lane >> 4, l15 = lane & 15;
    const bool active = w < 4;
    const int dir = it & 1, et = w & 3, td = tid & 255, d = td & 127, tq = td >> 7, tv = td >> 3, eseg = (td & 7) * 8;
    const int rtok = td >> 4, rseg = (td & 15) * 8;
    const int b = it >> 5, h = (it >> 2) & 7, eh = (it >> 1) & 1;
    LAS unsigned char* base = lds;
    LAS unsigned char* QI = base; LAS unsigned char* KI = base + 8704; LAS unsigned char* LR = base + 17408; LAS unsigned char* KT = base + 26112; LAS unsigned char* VT = base + 36352; LAS unsigned char* PM = base + 41472;
    LAS float* DEC = (LAS float*)(base + 44032);
    f32x4 S[8];
#pragma unroll
    for (int t = 0; t < 8; ++t) S[t] = (f32x4){0.f, 0.f, 0.f, 0.f};
    HgRaw R[4];
    v2u pend[2] = {(v2u){0u, 0u}, (v2u){0u, 0u}};
    if (active) { HG_ISSUE(R[0], 0); HG_ISSUE(R[1], 1); HG_ISSUE(R[2], 2); }
#pragma unroll 1
    for (int st4 = 0; st4 < 136; st4 += 4) {
#pragma unroll
    for (int u = 0; u < 4; ++u) {
        const int st = st4 + u;
        const int row0 = hg_row0(b, dir, st);
        __syncthreads();
        if (active) {
        *(LAS v4u*)(QI + rtok * 272 + rseg * 2) = R[u].q0; *(LAS v4u*)(QI + (rtok + 16) * 272 + rseg * 2) = R[u].q1;
        *(LAS v4u*)(LR + rtok * 272 + rseg * 2) = R[u].l0; *(LAS v4u*)(LR + (rtok + 16) * 272 + rseg * 2) = R[u].l1;
        const v4u vr = R[u].v;
        { LAS unsigned short* vp = (LAS unsigned short*)(VT + eseg * 80 + tv * 2);
          vp[0 * 40] = (unsigned short)(vr.x & 0xffffu); vp[1 * 40] = (unsigned short)(vr.x >> 16); vp[2 * 40] = (unsigned short)(vr.y & 0xffffu); vp[3 * 40] = (unsigned short)(vr.y >> 16);
          vp[4 * 40] = (unsigned short)(vr.z & 0xffffu); vp[5 * 40] = (unsigned short)(vr.z >> 16); vp[6 * 40] = (unsigned short)(vr.w & 0xffffu); vp[7 * 40] = (unsigned short)(vr.w >> 16); }
        if (st >= 9) { const int prow = hg_row0(b, dir, st - 1);
            bf16* obase = dir == 0 ? OS + (size_t)prow * 1024 : (bf16*)(ws + ws_ob(b)) + (size_t)(prow - b * SEQL) * 1024;
#pragma unroll
            for (int t2 = 0; t2 < 2; ++t2) *(v2u*)(obase + (size_t)(16 * t2 + l15) * 1024 + h * 128 + eh * 64 + 16 * et + 4 * g4) = pend[t2]; }
        if (st + 3 < 136) HG_ISSUE(R[(u + 3) & 3], st + 3);
        }
        __syncthreads();
        if (active) {
            const int dpl = lane & 15, tq8 = lane >> 4, d0 = 2 * ((w & 3) * 16 + dpl), t0 = tq8 * 8;
            float la[8], lb[8], Ta = 0.f, Tb = 0.f;
#pragma unroll
            for (int i = 0; i < 8; ++i) { const unsigned wv = *(const LAS unsigned*)(LR + (t0 + i) * 272 + d0 * 2); la[i] = f16lo(wv); lb[i] = f16hi(wv); Ta += la[i]; Tb += lb[i]; }
            const float A0 = __shfl(Ta, dpl), A1 = __shfl(Ta, 16 + dpl), A2 = __shfl(Ta, 32 + dpl), A3 = __shfl(Ta, 48 + dpl);
            const float B0 = __shfl(Tb, dpl), B1 = __shfl(Tb, 16 + dpl), B2 = __shfl(Tb, 32 + dpl), B3 = __shfl(Tb, 48 + dpl);
            const float tota = (A0 + A1) + (A2 + A3), totb = (B0 + B1) + (B2 + B3);
            float basea, baseb;
            if (dir == 0) { basea = (tq8 > 0 ? A0 : 0.f) + (tq8 > 1 ? A1 : 0.f) + (tq8 > 2 ? A2 : 0.f); baseb = (tq8 > 0 ? B0 : 0.f) + (tq8 > 1 ? B1 : 0.f) + (tq8 > 2 ? B2 : 0.f); }
            else          { basea = (tq8 < 3 ? A3 : 0.f) + (tq8 < 2 ? A2 : 0.f) + (tq8 < 1 ? A1 : 0.f); baseb = (tq8 < 3 ? B3 : 0.f) + (tq8 < 2 ? B2 : 0.f) + (tq8 < 1 ? B1 : 0.f); }
            float ea = __expf(basea), eb = __expf(baseb); const float eta = __expf(tota), etb = __expf(totb);
            float koa[8], kob[8];
#pragma unroll
            for (int ii = 0; ii < 8; ++ii) { const int i = dir == 0 ? ii : 7 - ii;
                const float fa = __expf(la[i]), fb = __expf(lb[i]); ea *= fa; eb *= fb;
                LAS unsigned* qp = (LAS unsigned*)(QI + (t0 + i) * 272 + d0 * 2); const unsigned qw = *qp;
                const float kia = (1.0f - fa) * __builtin_amdgcn_rcpf(ea), kib = (1.0f - fb) * __builtin_amdgcn_rcpf(eb);
                *qp = pk2(bflo(qw) * ea, bfhi(qw) * eb);
                *(LAS unsigned*)(KI + (t0 + i) * 272 + d0 * 2) = pk2(kia, kib);
                koa[i] = kia * eta; kob[i] = kib * etb; }
            v4u k0, k1;
            k0.x = pk2(koa[0], koa[1]); k0.y = pk2(koa[2], koa[3]); k0.z = pk2(koa[4], koa[5]); k0.w = pk2(koa[6], koa[7]);
            k1.x = pk2(kob[0], kob[1]); k1.y = pk2(kob[2], kob[3]); k1.z = pk2(kob[4], kob[5]); k1.w = pk2(kob[6], kob[7]);
            *(LAS v4u*)(KT + d0 * 80 + t0 * 2) = k0; *(LAS v4u*)(KT + (d0 + 1) * 80 + t0 * 2) = k1;
            if (tq8 == 0) { DEC[d0] = eta; DEC[d0 + 1] = etb; }
        }
        __syncthreads();
        if (active) {
            const int it1 = et >> 1, jt1 = et & 1;
            f32x4 ap = (f32x4){0.f, 0.f, 0.f, 0.f};
#pragma unroll
            for (int ks = 0; ks < 4; ++ks) ap = MFMA16(frag_rm(QI, 272, 16 * it1, 32 * ks, lane), frag_rm(KI, 272, 16 * jt1, 32 * ks, lane), ap);
#pragma unroll
            for (int r = 0; r < 4; ++r) { const int i = 16 * it1 + 4 * g4 + r, j = 16 * jt1 + l15; const bool keep = dir == 0 ? (j <= i) : (j >= i);
                *(LAS unsigned short*)(PM + i * 80 + j * 2) = keep ? (unsigned short)f2bf(ap[r]) : (unsigned short)0; }
        }
        __syncthreads();
        if (active) {
            bf16x8_t sb[4];
#pragma unroll
            for (int ks = 0; ks < 4; ++ks) { v4u t; t.x = pk2(S[2 * ks][0], S[2 * ks][1]); t.y = pk2(S[2 * ks][2], S[2 * ks][3]); t.z = pk2(S[2 * ks + 1][0], S[2 * ks + 1][1]); t.w = pk2(S[2 * ks + 1][2], S[2 * ks + 1][3]);
                sb[ks] = __builtin_bit_cast(bf16x8_t, t); }
            const bf16x8_t vfrag = frag_rm(VT, 80, 16 * et, 0, lane);
            f32x4 o[2];
#pragma unroll
            for (int t2 = 0; t2 < 2; ++t2) {
                o[t2] = MFMA16(vfrag, frag_rm(PM, 80, 16 * t2, 0, lane), ((f32x4){0.f, 0.f, 0.f, 0.f}));
#pragma unroll
                for (int ks = 0; ks < 4; ++ks) { const LAS unsigned char* qrow = QI + (16 * t2 + l15) * 272 + (32 * ks + 4 * g4) * 2;
                    const v2u qa = *(const LAS v2u*)qrow, qb = *(const LAS v2u*)(qrow + 32);
                    v4u qq; qq.x = qa.x; qq.y = qa.y; qq.z = qb.x; qq.w = qb.y;
                    o[t2] = MFMA16(sb[ks], __builtin_bit_cast(bf16x8_t, qq), o[t2]); }
            }
#pragma unroll
            for (int dt = 0; dt < 8; ++dt) { const f32x4 dv = *(const LAS f32x4*)(DEC + 16 * dt + 4 * g4);
                S[dt] = MFMA16(frag_rm(KT, 80, 16 * dt, 0, lane), vfrag, S[dt] * dv); }
#pragma unroll
            for (int t2 = 0; t2 < 2; ++t2) { pend[t2].x = pk2(o[t2][0], o[t2][1]); pend[t2].y = pk2(o[t2][2], o[t2][3]); }
        }
    }
    }
    if (active) { const int prow = hg_row0(b, dir, 135);
      bf16* obase = dir == 0 ? OS + (size_t)prow * 1024 : (bf16*)(ws + ws_ob(b)) + (size_t)(prow - b * SEQL) * 1024;
#pragma unroll
      for (int t2 = 0; t2 < 2; ++t2) *(v2u*)(obase + (size_t)(16 * t2 + l15) * 1024 + h * 128 + eh * 64 + 16 * et + 4 * g4) = pend[t2]; }
    __syncthreads();
}

struct Args { const float* in[28]; float* out; unsigned char* ws; };
enum { I_X = 0, I_C, I_CTX, I_CCTX, I_WMOD, I_BMOD, I_NMIX, I_NMLP, I_W1, I_W2, I_ABWIN, I_ABWOUT, I_RETL, I_S5ARE, I_S5AIM, I_S5DT, I_S5BRE, I_S5BIM, I_S5CRE, I_S5CIM, I_S5D, I_S5WGLU, I_S5BGLU, I_HGWIN, I_HGWOUT, I_HGLB, I_HGNORM, I_NFIN };

__global__ void __launch_bounds__(NWAVES * 64, 2) mk_fwd(Args args) {
    extern __shared__ __attribute__((aligned(16))) unsigned char lds_raw[];
    LAS unsigned char* lds = (LAS unsigned char*)lds_raw;
    volatile LAS unsigned* MISC = (volatile LAS unsigned*)(lds + MISC_OFF);
    const int tid = threadIdx.x, lane = tid & 63, wave = __builtin_amdgcn_readfirstlane(tid >> 6);
    const int G = gridDim.x;
    const int vcu = (G % 8 == 0) ? ((int)blockIdx.x % 8) * (G / 8) + (int)blockIdx.x / 8 : (int)blockIdx.x;
    const int gw = vcu * NWAVES + wave, NGW = G * NWAVES;
    unsigned char* ws = args.ws;
    gu32* ctl = (gu32*)(ws + WS_CTL);
    for (int u = tid; u < (LDS_BYTES - LDSCTL_OFF) / 4; u += NWAVES * 64) ((LAS unsigned*)(lds + LDSCTL_OFF))[u] = 0u;
    __syncthreads();
    XcdBarrier bar = xcd_barrier_post((unsigned*)(ctl + CW_BAR), MISC + 8);
#define GRID_BAR() xcd_barrier(bar)

    float* MOD = (float*)(ws + WS_MOD); float* CS = (float*)(ws + WS_CS);
    f32x2* AB = (f32x2*)(ws + WS_S5T); float* LB = (float*)(ws + WS_LB);
    float* HC = (float*)(ws + WS_HC);
    bf16* Win0 = (bf16*)(ws + WS_WIN0); bf16* Wout0 = (bf16*)(ws + WS_WOUT0); bf16* Wglu = (bf16*)(ws + WS_WGLU);
    bf16* W1t0 = (bf16*)(ws + WS_W1_0); bf16* W2t0 = (bf16*)(ws + WS_W2_0); bf16* W1t1 = (bf16*)(ws + WS_W1_1); bf16* W2t1 = (bf16*)(ws + WS_W2_1); bf16* Whg = (bf16*)(ws + WS_WHG); bf16* Whgo = (bf16*)(ws + WS_WHGO);
    bf16* XN = (bf16*)(ws + WS_XN); bf16* P0b = (bf16*)(ws + WS_P0); bf16* P1b = (bf16*)(ws + WS_P1); bf16* Hb = (bf16*)(ws + WS_H);
    bf16* ULOC = (bf16*)(ws + WS_ULOC); bf16* SIN = (bf16*)(ws + WS_SIN);
    bf16* UA = (bf16*)(ws + WS_UA); bf16* Bc = (bf16*)(ws + WS_BC); bf16* Ws5 = (bf16*)(ws + WS_WS5); float* HLOC = (float*)(ws + WS_HLOC);
    bf16* RZ = (bf16*)(ws + WS_RZ); bf16* Yb = (bf16*)(ws + WS_Y); bf16* OS = (bf16*)(ws + WS_XN);
    float* OUT = args.out;

    {
        LAS float* scr = (LAS float*)(lds + RING_OFF + wave * 16384);
        constexpr int I_A = 16 * 64, I_B = 16 * 32, I_G = 8 * 16, I_1 = 16 * 128, I_2 = 64 * 32, I_H = 16 * 160, I_O = 16 * 32;
        constexpr int NITEMS = I_A + I_B + I_G + 2 * I_1 + 2 * I_2 + I_H + I_O;
        for (int it = gw; it < NITEMS; it += NGW) {
            int r = it;
            if (r < I_A) { p0_transpose_item<true>(args.in[I_ABWIN], 1024, 2048, Win0, scr, r, lane); continue; } r -= I_A;
            if (r < I_B) { p0_transpose_item<false>(args.in[I_ABWOUT], 1024, 1024, Wout0, scr, r, lane); continue; } r -= I_B;
            if (r < I_G) { p0_transpose_item<false>(args.in[I_S5WGLU], 512, 512, Wglu, scr, r, lane); continue; } r -= I_G;
            if (r < 2 * I_1) { const int l = r / I_1; p0_transpose_item<false>(args.in[I_W1] + (size_t)l * 1024 * 4096, 1024, 4096, l ? W1t1 : W1t0, scr, r % I_1, lane); continue; } r -= 2 * I_1;
            if (r < 2 * I_2) { const int l = r / I_2; p0_transpose_item<false>(args.in[I_W2] + (size_t)l * 1024 * 4096, 4096, 1024, l ? W2t1 : W2t0, scr, r % I_2, lane); continue; } r -= 2 * I_2;
            if (r < I_H) { p0_transpose_item<false>(args.in[I_HGWIN], 1024, 5120, Whg, scr, r, lane); continue; } r -= I_H;
            p0_transpose_item<false>(args.in[I_HGWOUT], 1024, 1024, Whgo, scr, r, lane);
        }
        __syncthreads();
        if ((int)blockIdx.x < 96) {
            LAS float* Ssil = (LAS float*)lds; LAS float* red = (LAS float*)(lds + 36864);
            for (int i = tid; i < 9 * 1024; i += NWAVES * 64) { const int r = i >> 10, k = i & 1023; const float v = r < 8 ? args.in[I_C][r * 1024 + k] : args.in[I_CCTX][k]; Ssil[i] = v / (1.0f + expf(-v)); }
            __syncthreads();
            for (int it = blockIdx.x; it < 96; it += G) {
                const int l = it / 48, col0 = (it % 48) * 128, cgp = tid & 31, ksl = tid >> 5;
                const float* W = args.in[I_WMOD] + (size_t)l * 1024 * NMOD + col0 + 4 * cgp;
                f32x4 a[9];
#pragma unroll
                for (int r = 0; r < 9; ++r) a[r] = (f32x4){0.f, 0.f, 0.f, 0.f};
                for (int kk = 0; kk < 64; ++kk) { const int k = ksl * 64 + kk; const f32x4 w = *(const f32x4*)(W + (size_t)k * NMOD);
#pragma unroll
                    for (int r = 0; r < 9; ++r) a[r] += w * Ssil[r * 1024 + k]; }
#pragma unroll
                for (int r = 0; r < 9; ++r) *(LAS f32x4*)(red + (ksl * 9 + r) * 128 + 4 * cgp) = a[r];
                __syncthreads();
                for (int o = tid; o < 9 * 128; o += NWAVES * 64) { const int r = o >> 7, cc = o & 127; float s = args.in[I_BMOD][l * NMOD + col0 + cc];
                    for (int q = 0; q < 16; ++q) s += red[(q * 9 + r) * 128 + cc];
                    MOD[(size_t)(l * 9 + r) * NMOD + col0 + cc] = s; }
                __syncthreads();
            }
        }
        { const int first = G >= 128 ? 96 : 0, nb_ = G >= 128 ? 32 : G;
          if ((int)blockIdx.x >= first && (int)blockIdx.x < first + nb_) { __syncthreads();
            for (int g5 = (int)blockIdx.x - first; g5 < 32; g5 += nb_)
                s5_tables_item(lds, g5, args.in[I_S5ARE], args.in[I_S5AIM], args.in[I_S5DT], args.in[I_S5BRE], args.in[I_S5BIM], args.in[I_S5CRE], args.in[I_S5CIM], Bc, Ws5); } }
        const int gt = gw * 64 + lane, NT = NGW * 64;
        for (int i = gt; i < SEQL * 32; i += NT) { const int t = i >> 5, dd = i & 31; const float inv = powf(10000.0f, -(float)(dd & 15) / 16.0f);
            const float a = (dd < 16 ? (float)(t >> 6) : (float)(t & 63)) * inv; CS[2 * i] = cosf(a); CS[2 * i + 1] = sinf(a); }
        for (int i = gt; i < 2 * 32 * 64; i += NT) {
            const float dt = expf(args.in[I_S5DT][i >> 6]); const float are = args.in[I_S5ARE][i], aim = args.in[I_S5AIM][i];
            const float mag = expf(are * dt), ang = aim * dt; const float abr = mag * cosf(ang), abi = mag * sinf(ang);
            const float nr = abr - 1.0f, ni = abi, den = are * are + aim * aim; const float fr = (nr * are + ni * aim) / den, fi = (ni * are - nr * aim) / den;
            AB[i] = (f32x2){abr, abi}; (void)fr; (void)fi;
        }
        for (int i = gt; i < 2 * 1024; i += NT) { const int d = i >> 10, j = i & 1023; const float x0 = args.in[I_HGLB][(d * 2 + 0) * 1024 + j], x1 = args.in[I_HGLB][(d * 2 + 1) * 1024 + j];
            const float mx = fmaxf(x0, x1), e0 = expf(x0 - mx), e1 = expf(x1 - mx); const float g0 = e0 / (e0 + e1), g1 = e1 / (e0 + e1); LB[i] = (g0 + g1) - g0; }
    }
    GRID_BAR();
    norm_mod_rows(args.in[I_X], args.in[I_CTX], MT, args.in[I_NMIX], MOD, 0, DM, XN, gw, NGW, lane);
    GRID_BAR();
    { pg8::Gemm g{XN, Win0, MT, 2048, 1024, 1024, 1024}; pg8::StaticOrder S; S.init(MT, 2048, G, (int)blockIdx.x); EpiProj0 E{P0b, CS, UA};
      pg8::gemm_phase<EpiProj0, pg8::StaticOrder, true, true>(lds + RING_OFF, g, S, E); }
    GRID_BAR();
    { pg8::Gemm g{UA, Ws5, 32 * S5RP, 32 * 256, 512, S5K, 512}; pg8::BatchOrder S; S.init(32, 5, 1, G, (int)blockIdx.x); EpiHloc E{HLOC};
      pg8::gemm_phase<EpiHloc, pg8::BatchOrder, true, true>(lds + RING_OFF, g, S, E);
      __syncthreads();
      for (int it = (int)blockIdx.x; it < 32 * RCH; it += G) ret_passA_item(lds, it, P0b, args.in[I_RETL], ULOC); }
    GRID_BAR();
    s5_scan(HLOC, UA, AB, gw, NGW, lane);
    ret_scan(ULOC, SIN, args.in[I_RETL], gw * 64 + lane, NGW * 64);
    GRID_BAR();
    { pg8::Gemm g{UA, Bc, 32 * S5RP, 32 * 512, S5K, S5K, S5K}; pg8::BatchOrder S; S.init(32, 5, 2, G, (int)blockIdx.x); EpiS5Out E{UA, args.in[I_S5D], Yb};
      pg8::gemm_phase<EpiS5Out, pg8::BatchOrder, true, true>(lds + RING_OFF, g, S, E);
      __syncthreads();
      for (int it = (int)blockIdx.x; it < 32 * RCH; it += G) ret_passC_item(lds, it, P0b, args.in[I_RETL], SIN, RZ); }
    GRID_BAR();
    { pg8::Gemm g{Yb, Wglu, MT, 512, 512, 512, 512}; pg8::StaticOrder S; S.init(MT, 512, G, (int)blockIdx.x); EpiGlu E{Yb, args.in[I_S5BGLU], RZ + 512};
      pg8::gemm_phase<EpiGlu, pg8::StaticOrder, true, true>(lds + RING_OFF, g, S, E); }
    GRID_BAR();
    { pg8::Gemm g{RZ, Wout0, MT, 1024, 1024, 1024, 1024}; pg8::StaticOrder S; S.init(MT, 1024, G, (int)blockIdx.x); EpiResid E{args.in[I_X], args.in[I_CTX], OUT, HC, MOD + 2 * DM};
      pg8::gemm_phase<EpiResid, pg8::StaticOrder, true, true>(lds + RING_OFF, g, S, E); }
    GRID_BAR();
    norm_mod_rows(OUT, HC, MT, args.in[I_NMLP], MOD, 3 * DM, 4 * DM, XN, gw, NGW, lane);
    GRID_BAR();
    { pg8::Gemm g{XN, W1t0, MT, DFF, 1024, 1024, 1024}; pg8::StaticOrder S; S.init(MT, DFF, G, (int)blockIdx.x); EpiSqrelu E{Hb};
      pg8::gemm_phase<EpiSqrelu, pg8::StaticOrder, true, true>(lds + RING_OFF, g, S, E); }
    GRID_BAR();
    { pg8::Gemm g{Hb, W2t0, MT, 1024, DFF, DFF, DFF}; pg8::StaticOrder S; S.init(MT, 1024, G, (int)blockIdx.x); EpiResid E{OUT, HC, OUT, HC, MOD + 5 * DM};
      pg8::gemm_phase<EpiResid, pg8::StaticOrder, true, true>(lds + RING_OFF, g, S, E); }
    GRID_BAR();
    const float* MOD1 = MOD + (size_t)9 * NMOD;
    norm_mod_rows(OUT, HC, MT, args.in[I_NMIX] + DM, MOD1, 0, DM, XN, gw, NGW, lane);
    GRID_BAR();
    { pg8::Gemm g{XN, Whg, MT, 5120, 1024, 1024, 1024}; pg8::StaticOrder S; S.init(MT, 5120, G, (int)blockIdx.x); EpiProj1 E{P1b, LB};
      pg8::gemm_phase<EpiProj1, pg8::StaticOrder, true, true>(lds + RING_OFF, g, S, E); }
    GRID_BAR();
    for (int i = blockIdx.x; i < 256; i += G) hgrn_item(lds, i, P1b, OS, ws);
    GRID_BAR();
    merge1_rows(OS, ws, P1b, args.in[I_HGNORM], gw, NGW, lane);
    GRID_BAR();
    { pg8::Gemm g{OS, Whgo, ML, 1024, 1024, 1024, 1024}; pg8::StaticOrder S; S.init(ML, 1024, G, (int)blockIdx.x); EpiResid E{OUT, HC, OUT, HC, MOD1 + 2 * DM};
      pg8::gemm_phase<EpiResid, pg8::StaticOrder, true, true>(lds + RING_OFF, g, S, E); }
    GRID_BAR();
    norm_mod_rows(OUT, HC, ML, args.in[I_NMLP] + DM, MOD1, 3 * DM, 4 * DM, XN, gw, NGW, lane);
    GRID_BAR();
    { pg8::Gemm g{XN, W1t1, ML, DFF, 1024, 1024, 1024}; pg8::StaticOrder S; S.init(ML, DFF, G, (int)blockIdx.x); EpiSqrelu E{Hb};
      pg8::gemm_phase<EpiSqrelu, pg8::StaticOrder, true, true>(lds + RING_OFF, g, S, E); }
    GRID_BAR();
    { pg8::Gemm g{Hb, W2t1, ML, 1024, DFF, DFF, DFF}; pg8::StaticOrder S; S.init(ML, 1024, G, (int)blockIdx.x); EpiResid E{OUT, HC, OUT, HC, MOD1 + 5 * DM};
      pg8::gemm_phase<EpiResid, pg8::StaticOrder, true, true>(lds + RING_OFF, g, S, E); }
    GRID_BAR();
    final_norm_rows(OUT, args.in[I_NFIN], gw, NGW, lane);
}

extern "C" void kernel_launch(void* const* d_in, const int* in_sizes, int n_in, void* d_out, int out_size, void* d_ws, size_t ws_size, hipStream_t stream) {
    static int grid = 0;
    if (grid == 0) {
        if (n_in != 28 || in_sizes[0] != ML * DM || out_size != ML * DM || ws_size < WS_END) { fprintf(stderr, "kernel_launch: unexpected shapes (n_in %d, in0 %d, out %d, ws %zu)\n", n_in, n_in > 0 ? in_sizes[0] : -1, out_size, ws_size); grid = -1; return; }
        int dev = 0, cus = 0, per_cu = 0;
        if (hipGetDevice(&dev) != hipSuccess || hipDeviceGetAttribute(&cus, hipDeviceAttributeMultiprocessorCount, dev) != hipSuccess) { grid = -1; return; }
        if (hipFuncSetAttribute((const void*)mk_fwd, hipFuncAttributeMaxDynamicSharedMemorySize, LDS_BYTES) != hipSuccess) { fprintf(stderr, "kernel_launch: hipFuncSetAttribute failed\n"); grid = -1; return; }
        if (hipOccupancyMaxActiveBlocksPerMultiprocessor(&per_cu, (const void*)mk_fwd, NWAVES * 64, LDS_BYTES) != hipSuccess || per_cu < 1) { fprintf(stderr, "kernel_launch: occupancy query says %d blocks per CU\n", per_cu); }
        (void)hipGetLastError();
        grid = cus;
    }
    if (grid < 0) return;
    if (hipMemsetAsync((char*)d_ws + WS_CTL, 0, CTL_ZERO_BYTES, stream) != hipSuccess) return;
    Args a{};
    for (int i = 0; i < 28; ++i) a.in[i] = (const float*)d_in[i];
    a.out = (float*)d_out; a.ws = (unsigned char*)d_ws;
    hipLaunchKernelGGL(mk_fwd, dim3(grid), dim3(NWAVES * 64), LDS_BYTES, stream, a);
}
```

```cpp
#include <hip/hip_runtime.h>
#include <cstdio>
#include <cstdint>

namespace pg8 {
#define PG8_LAS __attribute__((address_space(3)))
typedef unsigned short bf16_t;
typedef short bf16x8 __attribute__((ext_vector_type(8)));
typedef float f32x4 __attribute__((ext_vector_type(4)));
typedef unsigned u32x4 __attribute__((ext_vector_type(4)));
constexpr int BM = 256, BK = 64, HALF = 128, HTB = HALF * BK * 2, STAGE_BYTES = 8 * HTB, NXCD = 8, WGM = 8;

__host__ __device__ __forceinline__ int lds_byte(int r, int c) { const int st = (r >> 4) * 2 + (c >> 5), rr = r & 15, cc = c & 31, ob = rr * 64 + cc * 2; return st * 1024 + (ob ^ (((ob >> 9) & 1) << 5)); }
__host__ __device__ __forceinline__ void stage_rc(int b, int& R, int& C) { const int st = b / 1024, sb = b % 1024, swz = sb ^ (((sb >> 9) & 1) << 5); R = (st >> 1) * 16 + swz / 64; C = (st & 1) * 32 + (swz % 64) / 2; }
__host__ __device__ __forceinline__ int perm32(int rho) { const int n = rho >> 4, i = rho & 15; return 8 * (i >> 2) + 4 * n + (i & 3); }

struct Unit { int pm, pn; };
struct Gemm { const bf16_t* A; const bf16_t* Bt; int M, N, K, lda, ldb; };

struct StaticOrder {
    int nM, nN, nwg, G, c;
    __host__ __device__ void init(int M, int N, int G_, int c_) { nM = M / BM; nN = N / BM; nwg = nM * nN; G = G_; c = c_; }
    __host__ __device__ bool next(int i, Unit& u) const {
        const long L = (long)i * G + c; if (L >= nwg) return false;
        int wgid = (int)L; { const int q = nwg / NXCD, r = nwg % NXCD, xcd = wgid % NXCD, off = wgid / NXCD; wgid = (xcd < r ? xcd * (q + 1) : r * (q + 1) + (xcd - r) * q) + off; }
        const int nig = WGM * nN, gid = wgid / nig, fm = gid * WGM, gsz = (nM - fm) < WGM ? (nM - fm) : WGM;
        u.pm = fm + ((wgid % nig) % gsz); u.pn = (wgid % nig) / gsz; return true;
    }
    __device__ __forceinline__ void a_ready(const Unit&) const {}
    __device__ __forceinline__ void done(const Unit&) const {}
};

struct BatchOrder {
    int nb, tm, tn, G, c;
    __host__ __device__ void init(int nb_, int tm_, int tn_, int G_, int c_) { nb = nb_; tm = tm_; tn = tn_; G = G_; c = c_; }
    __host__ __device__ bool next(int i, Unit& u) const {
        const long L = (long)i * G + c; if (c < 0 || L >= (long)nb * tm * tn) return false;
        const int per = tm * tn, g = (int)L / per, rem = (int)L % per;
        u.pm = g * tm + rem % tm; u.pn = g * tn + rem / tm; return true;
    }
    __device__ __forceinline__ void a_ready(const Unit&) const {}
    __device__ __forceinline__ void done(const Unit&) const {}
};

__device__ __forceinline__ unsigned cvt_pk_bf16(float lo, float hi) { unsigned r; asm volatile("v_cvt_pk_bf16_f32 %0, %1, %2" : "=v"(r) : "v"(lo), "v"(hi)); return r; }

template <class Epi, class Sched, bool ALIGN_EPI = false, bool SP2 = false>
__device__ __forceinline__ void gemm_phase(PG8_LAS unsigned char* lds, const Gemm g, const Sched& S, const Epi& E) {
    int tid_ = threadIdx.x; asm volatile("" : "+v"(tid_));
    const int tid = tid_, wid = __builtin_amdgcn_readfirstlane(tid >> 6), lane = tid & 63, wr = wid >> 2, wc = wid & 3, fr = lane & 15, fq = lane >> 4;
    const int K = g.K, nt = K / BK;
    unsigned voffA[2], voffB[2];
#pragma unroll
    for (int i = 0; i < 2; ++i) { int R, C; stage_rc(tid * 16 + i * 8192, R, C); const int Rb = Epi::PERM ? ((R & ~31) + perm32(R & 31)) : R;
        voffA[i] = (unsigned)(R * g.lda + C) * 2u; voffB[i] = (unsigned)(Rb * g.ldb + C) * 2u; }
    const size_t kstep = (size_t)(BK * 2);
    const size_t hstepA = (size_t)HALF * g.lda * 2, hstepB = (size_t)HALF * g.ldb * 2;
    const size_t tstepA = 2 * hstepA, tstepB = 2 * hstepB;
    const unsigned ldsw = (unsigned)wid * 1024u;
    const int aoff = lds_byte(wr * 64 + fr, fq * 8), boff = lds_byte(wc * 32 + fr, fq * 8);
#define PG8_SA(b, h) (((b) * 2 + (h)) * HTB)
#define PG8_SB(b, h) ((4 + (b) * 2 + (h)) * HTB)
#define PG8_STAGE(bufoff, gbase, voff) do { _Pragma("unroll") for (int _i = 0; _i < 2; ++_i) \
        __builtin_amdgcn_global_load_lds((const unsigned*)((const char*)(gbase) + (voff)[_i]), (PG8_LAS unsigned*)(lds + (bufoff) + ldsw + _i * 8192), 16, 0, 0); } while (0)
#define PG8_LDA(dst, b, h) do { _Pragma("unroll") for (int m = 0; m < 4; ++m) _Pragma("unroll") for (int k = 0; k < 2; ++k) dst[m][k] = *(const PG8_LAS bf16x8*)(lds + PG8_SA(b, h) + aoff + m * 2048 + k * 1024); } while (0)
#define PG8_LDB(dst, b, h) do { _Pragma("unroll") for (int n = 0; n < 2; ++n) _Pragma("unroll") for (int k = 0; k < 2; ++k) dst[n][k] = *(const PG8_LAS bf16x8*)(lds + PG8_SB(b, h) + boff + n * 2048 + k * 1024); } while (0)
#define PG8_MMA(ai, bj, At, Bt) do { __builtin_amdgcn_s_setprio(1); _Pragma("unroll") for (int m = 0; m < 4; ++m) _Pragma("unroll") for (int n = 0; n < 2; ++n) _Pragma("unroll") for (int k = 0; k < 2; ++k) \
        acc[ai][bj][m][n] = __builtin_amdgcn_mfma_f32_16x16x32_bf16(Bt[n][k], At[m][k], acc[ai][bj][m][n], 0, 0, 0); __builtin_amdgcn_s_setprio(0); } while (0)
#define PG8_WAIT_V(n) asm volatile("s_waitcnt vmcnt(" #n ")" ::: "memory")
#define PG8_WAIT_L(n) asm volatile("s_waitcnt lgkmcnt(" #n ")" ::: "memory")
#define PG8_BAR __builtin_amdgcn_s_barrier()
#define PG8_SCHED __builtin_amdgcn_sched_barrier(0)
    Unit cur, nxt; int ui = 0;
    if (!S.next(0, cur)) return;
    f32x4 acc[2][2][4][2];
#pragma unroll
    for (int a = 0; a < 2; ++a)
#pragma unroll
        for (int b = 0; b < 2; ++b)
#pragma unroll
            for (int m = 0; m < 4; ++m)
#pragma unroll
                for (int n = 0; n < 2; ++n) acc[a][b][m][n] = (f32x4){0.f, 0.f, 0.f, 0.f};
    bf16x8 At[4][2], B0[2][2], B1[2][2];
    const char* cA = (const char*)g.A + (size_t)cur.pm * tstepA; const char* cB = (const char*)g.Bt + (size_t)cur.pn * tstepB;
    S.a_ready(cur);
    if constexpr (SP2) {
        PG8_STAGE(PG8_SB(0, 0), cB, voffB); PG8_STAGE(PG8_SB(0, 1), cB + hstepB, voffB); PG8_STAGE(PG8_SA(0, 0), cA, voffA); PG8_STAGE(PG8_SA(0, 1), cA + hstepA, voffA);
        if (wr == 1) PG8_BAR;
        PG8_WAIT_V(2); PG8_BAR;
        PG8_STAGE(PG8_SB(1, 0), cB + kstep, voffB); PG8_STAGE(PG8_SA(1, 0), cA + kstep, voffA); PG8_STAGE(PG8_SB(1, 1), cB + hstepB + kstep, voffB);
        PG8_WAIT_V(6); PG8_BAR;
    } else {
        PG8_STAGE(PG8_SB(0, 0), cB, voffB); PG8_STAGE(PG8_SA(0, 0), cA, voffA); PG8_STAGE(PG8_SB(0, 1), cB + hstepB, voffB); PG8_STAGE(PG8_SA(0, 1), cA + hstepA, voffA);
        if (wr == 1) PG8_BAR;
        PG8_WAIT_V(4); PG8_BAR;
        PG8_STAGE(PG8_SB(1, 0), cB + kstep, voffB); PG8_STAGE(PG8_SA(1, 0), cA + kstep, voffA); PG8_STAGE(PG8_SB(1, 1), cB + hstepB + kstep, voffB);
        PG8_WAIT_V(6); PG8_BAR;
    }
    for (;;) {
        const bool has_next = S.next(ui + 1, nxt);
        const char* nA = has_next ? (const char*)g.A + (size_t)nxt.pm * tstepA : cA; const char* nB = has_next ? (const char*)g.Bt + (size_t)nxt.pn * tstepB : cB;
        for (int t = 0; t < nt; t += 2) {
            const bool last = (t == nt - 2);
            const char* a1 = cA + (size_t)(t + 1) * kstep;
            const char* a2 = last ? nA : cA + (size_t)(t + 2) * kstep; const char* b2 = last ? nB : cB + (size_t)(t + 2) * kstep;
            const char* a3 = a2 + kstep; const char* b3 = b2 + kstep;
            if (last && has_next) S.a_ready(nxt);
            if constexpr (SP2) {
            PG8_LDB(B0, 0, 0); PG8_LDB(B1, 0, 1); PG8_SCHED; PG8_LDA(At, 0, 0); PG8_STAGE(PG8_SA(1, 1), a1 + hstepA, voffA);
            PG8_WAIT_V(8); PG8_WAIT_L(0); PG8_BAR; PG8_MMA(0, 0, At, B0); PG8_MMA(0, 1, At, B1); PG8_BAR; PG8_SCHED;
            PG8_LDA(At, 0, 1); PG8_STAGE(PG8_SB(0, 0), b2, voffB); PG8_STAGE(PG8_SB(0, 1), b2 + hstepB, voffB); PG8_STAGE(PG8_SA(0, 0), a2, voffA);
            PG8_WAIT_V(8); PG8_WAIT_L(0); PG8_BAR; PG8_MMA(1, 0, At, B0); PG8_MMA(1, 1, At, B1); PG8_BAR; PG8_SCHED;
            PG8_LDB(B0, 1, 0); PG8_LDB(B1, 1, 1); PG8_SCHED; PG8_LDA(At, 1, 0); PG8_STAGE(PG8_SA(0, 1), a2 + hstepA, voffA);
            PG8_WAIT_V(8); PG8_WAIT_L(0); PG8_BAR; PG8_MMA(0, 0, At, B0); PG8_MMA(0, 1, At, B1); PG8_BAR; PG8_SCHED;
            PG8_LDA(At, 1, 1); PG8_STAGE(PG8_SB(1, 0), b3, voffB); PG8_STAGE(PG8_SB(1, 1), b3 + hstepB, voffB); PG8_STAGE(PG8_SA(1, 0), a3, voffA);
            PG8_WAIT_V(8); PG8_WAIT_L(0); PG8_BAR; PG8_MMA(1, 0, At, B0); PG8_MMA(1, 1, At, B1); PG8_BAR; PG8_SCHED;
            } else {
            PG8_LDB(B0, 0, 0); PG8_SCHED; PG8_LDA(At, 0, 0); PG8_STAGE(PG8_SA(1, 1), a1 + hstepA, voffA);
            PG8_WAIT_L(8); PG8_BAR; PG8_WAIT_L(0); PG8_MMA(0, 0, At, B0); PG8_BAR; PG8_SCHED;
            PG8_LDB(B1, 0, 1); PG8_STAGE(PG8_SB(0, 0), b2, voffB);
            PG8_BAR; PG8_WAIT_L(0); PG8_MMA(0, 1, At, B1); PG8_BAR;
            PG8_LDA(At, 0, 1); PG8_STAGE(PG8_SA(0, 0), a2, voffA);
            PG8_BAR; PG8_WAIT_L(0); PG8_MMA(1, 0, At, B0); PG8_BAR; PG8_SCHED;
            PG8_STAGE(PG8_SB(0, 1), b2 + hstepB, voffB);
            PG8_WAIT_V(6); PG8_BAR; PG8_MMA(1, 1, At, B1); PG8_BAR;
            PG8_LDB(B0, 1, 0); PG8_SCHED; PG8_LDA(At, 1, 0); PG8_STAGE(PG8_SA(0, 1), a2 + hstepA, voffA);
            PG8_WAIT_L(8); PG8_BAR; PG8_WAIT_L(0); PG8_MMA(0, 0, At, B0); PG8_BAR; PG8_SCHED;
            PG8_LDB(B1, 1, 1); PG8_STAGE(PG8_SB(1, 0), b3, voffB);
            PG8_BAR; PG8_WAIT_L(0); PG8_MMA(0, 1, At, B1); PG8_BAR;
            PG8_LDA(At, 1, 1); PG8_STAGE(PG8_SA(1, 0), a3, voffA);
            PG8_BAR; PG8_WAIT_L(0); PG8_MMA(1, 0, At, B0); PG8_BAR; PG8_SCHED;
            PG8_STAGE(PG8_SB(1, 1), b3 + hstepB, voffB);
            PG8_WAIT_V(6); PG8_BAR; PG8_MMA(1, 1, At, B1); PG8_BAR;
            }
        }
        if constexpr (ALIGN_EPI) { if (wr == 0) PG8_BAR; }
        if constexpr (!Epi::AFTER_DRAIN) { E(acc, cur, wr, wc, fr, fq); S.done(cur); }
        if (!has_next) break;
#pragma unroll
        for (int a = 0; a < 2; ++a)
#pragma unroll
            for (int b = 0; b < 2; ++b)
#pragma unroll
                for (int m = 0; m < 4; ++m)
#pragma unroll
                    for (int n = 0; n < 2; ++n) acc[a][b][m][n] = (f32x4){0.f, 0.f, 0.f, 0.f};
        cur = nxt; cA = nA; cB = nB; ++ui;
        if constexpr (ALIGN_EPI) { if (wr == 1) PG8_BAR; }
    }
    PG8_WAIT_V(0);
    if constexpr (!ALIGN_EPI) { if (wr == 0) PG8_BAR; }
    PG8_BAR;
#undef PG8_SA
#undef PG8_SB
#undef PG8_STAGE
#undef PG8_LDA
#undef PG8_LDB
#undef PG8_MMA
#undef PG8_WAIT_V
#undef PG8_WAIT_L
#undef PG8_BAR
#undef PG8_SCHED
}
}

#define GAS __attribute__((address_space(1)))
#define LAS __attribute__((address_space(3)))
typedef unsigned short bf16;
typedef unsigned v4u __attribute__((ext_vector_type(4)));
typedef unsigned v2u __attribute__((ext_vector_type(2)));
typedef float f32x4 __attribute__((ext_vector_type(4)));
typedef float f32x2 __attribute__((ext_vector_type(2)));

constexpr int NWAVES = 8;
constexpr int DM = 1024, NBATCH = 8, SEQL = 4096, CTXL = 256, DFF = 4096;
constexpr int ML = NBATCH * SEQL;
constexpr int MC = NBATCH * CTXL;
constexpr int MT = ML + MC;
constexpr int NMOD = 6 * DM;
constexpr float EPSN = 1e-6f;

constexpr size_t MiB = 1u << 20;
constexpr size_t WS_CTL = 0, CTL_ZERO_BYTES = 1 * MiB;
constexpr size_t WS_MOD = 1 * MiB;
constexpr size_t WS_CS = 2 * MiB;
constexpr size_t WS_S5T = 3 * MiB;
constexpr size_t WS_S5T_BB = WS_S5T + 32768, WS_LB = WS_S5T_BB + 524288;
constexpr size_t WS_HC = 4 * MiB;
constexpr size_t WS_WIN0 = 12 * MiB, WS_WOUT0 = 16 * MiB, WS_WGLU = 18 * MiB, WS_W1_0 = 19 * MiB, WS_W2_0 = 27 * MiB, WS_W1_1 = 35 * MiB, WS_W2_1 = 43 * MiB, WS_WHG = 51 * MiB, WS_WHGO = 61 * MiB;
__host__ __device__ __forceinline__ size_t ws_ob(int b) { return b < 5 ? 472 * MiB + (size_t)b * 8 * MiB : (b < 7 ? 12 * MiB + (size_t)(b - 5) * 8 * MiB : 4 * MiB); }
constexpr size_t WS_XN = 64 * MiB;
constexpr size_t WS_BIG = 132 * MiB;
constexpr int P0LD = 1536;
constexpr size_t WS_P0 = WS_BIG;
constexpr int S5R = 1088, S5RP = 1280, S5K = 768;
constexpr size_t WS_UA = WS_BIG + 102 * MiB;
constexpr size_t WS_BC = WS_BIG + 162 * MiB;
constexpr size_t WS_WS5 = WS_BIG + 186 * MiB;
constexpr size_t WS_ULOC = WS_BIG + 194 * MiB;
constexpr size_t WS_SIN = WS_BIG + 228 * MiB;
constexpr size_t WS_RZ = WS_BIG + 262 * MiB;
constexpr size_t WS_HLOC = WS_XN;
constexpr size_t WS_H = WS_BIG;
constexpr size_t WS_P1 = WS_BIG;
constexpr size_t WS_Y = 472 * MiB;
constexpr size_t WS_END = 512 * MiB;

constexpr int CW_BAR = 4096;

constexpr int RING_OFF = 0, RING_BYTES = 131072;
constexpr int LDSCTL_OFF = 143360, MISC_OFF = LDSCTL_OFF + 320;
constexpr int LDS_BYTES = 147456;

typedef GAS unsigned gu32;
#define LDS_WAIT() asm volatile("s_waitcnt lgkmcnt(0)" ::: "memory")
typedef __bf16 hwbf2 __attribute__((ext_vector_type(2)));
__device__ __forceinline__ unsigned pk2(float lo, float hi) { hwbf2 v; v.x = (__bf16)lo; v.y = (__bf16)hi; return __builtin_bit_cast(unsigned, v); }
__device__ __forceinline__ unsigned f2bf(float f) { return (unsigned)__builtin_bit_cast(unsigned short, (__bf16)f); }
__device__ __forceinline__ float bflo(unsigned w) { return __builtin_bit_cast(float, w << 16); }
__device__ __forceinline__ float bfhi(unsigned w) { return __builtin_bit_cast(float, w & 0xffff0000u); }
__device__ __forceinline__ float bf2f(bf16 h) { return __builtin_bit_cast(float, (unsigned)h << 16); }
typedef _Float16 h16x2 __attribute__((ext_vector_type(2)));
__device__ __forceinline__ unsigned pk_f16(float a, float b) { h16x2 v; v.x = (_Float16)a; v.y = (_Float16)b; return __builtin_bit_cast(unsigned, v); }
__device__ __forceinline__ float f16lo(unsigned w) { h16x2 v = __builtin_bit_cast(h16x2, w); return (float)v.x; }
__device__ __forceinline__ float f16hi(unsigned w) { h16x2 v = __builtin_bit_cast(h16x2, w); return (float)v.y; }
__device__ __forceinline__ float sigmoidf_(float x) { return 1.0f / (1.0f + __expf(-x)); }
__device__ __forceinline__ float siluf_(float x) { return x / (1.0f + __expf(-x)); }
__device__ __forceinline__ float gelu_tanh(float x) { const float u = 0.7978845608028654f * (x + 0.044715f * x * x * x); return 0.5f * x * (1.0f + tanhf(u)); }

#define XB_TMO      128
#define XB_XCNT(j)  (256  + 64 * (j))
#define XB_XSUB(j)  (1280 + 64 * (j))
#define XB_XGEN(j)  (2304 + 64 * (j))
#define XB_TOP      3328
#define XB_TOPGEN   3392
#define XCD_BAR_WORDS 3456
#define XB_SPIN_CAP (1u << 22)
__device__ __forceinline__ unsigned xb_ld(unsigned* p)              { return __hip_atomic_load(p, __ATOMIC_RELAXED, __HIP_MEMORY_SCOPE_AGENT); }
__device__ __forceinline__ unsigned xb_add(unsigned* p, unsigned v) { return __hip_atomic_fetch_add(p, v, __ATOMIC_RELAXED, __HIP_MEMORY_SCOPE_AGENT); }
__device__ __forceinline__ unsigned xb_xcc_id() { return (unsigned)__builtin_amdgcn_s_getreg((3 << 11) | 20) & 0xFu; }
#define XB_SPIN(cond, bar) do { unsigned _sp = 0; while (cond) { __builtin_amdgcn_s_sleep(1); \
    if ((++_sp & 255u) == 0u) { if (xb_ld(&(bar)[XB_TMO])) break; if (_sp > XB_SPIN_CAP) { atomicAdd(&(bar)[XB_TMO], 1u); break; } } } } while (0)
struct XcdBarrier { unsigned* bar; unsigned x; volatile LAS unsigned* st; };
__device__ __forceinline__ XcdBarrier xcd_barrier_post(unsigned* bar, volatile LAS unsigned* st) {
    XcdBarrier b; b.bar = bar; b.x = xb_xcc_id(); b.st = st;
    if (threadIdx.x == 0) (void)xb_add(&bar[XB_XCNT(b.x)], 1u);
    return b;
}
__device__ __forceinline__ void xcd_barrier_complete(unsigned* bar, unsigned x, unsigned& nloc, unsigned& nx) {
    const unsigned G = gridDim.x * gridDim.y * gridDim.z;
    unsigned sum, cnt, mine, sp = 0u;
    for (;;) {
        sum = 0u; cnt = 0u; mine = 0u;
#pragma unroll
        for (unsigned j = 0; j < 16; ++j) { const unsigned c = xb_ld(&bar[XB_XCNT(j)]); sum += c; cnt += (c > 0u) ? 1u : 0u; mine = (j == x) ? c : mine; }
        if (sum == G) break;
        __builtin_amdgcn_s_sleep(1);
        if ((++sp & 255u) == 0u) { if (xb_ld(&bar[XB_TMO])) break; if (sp > XB_SPIN_CAP) { atomicAdd(&bar[XB_TMO], 1u); break; } }
    }
    nloc = mine > 0u ? mine : 1u; nx = cnt > 0u ? cnt : 1u;
}
__device__ __forceinline__ void xcd_barrier(const XcdBarrier& b) {
    asm volatile("s_waitcnt vmcnt(0)" ::: "memory");
    __syncthreads();
    if (threadIdx.x == 0) {
        unsigned* bar = b.bar;
        __builtin_amdgcn_s_waitcnt(0);
        unsigned nloc = b.st[0], nx = b.st[1];
        if (nloc == 0u) { xcd_barrier_complete(bar, b.x, nloc, nx); b.st[0] = nloc; b.st[1] = nx; }
        const unsigned old = xb_add(&bar[XB_XSUB(b.x)], 1u);
        const unsigned gen = old / nloc;
        if (old + 1u == (gen + 1u) * nloc) {
            __builtin_amdgcn_fence(__ATOMIC_RELEASE, "agent");
            asm volatile("s_waitcnt vmcnt(0)" ::: "memory");
            const unsigned og = xb_add(&bar[XB_TOP], 1u);
            const unsigned tg = og / nx;
            if (og + 1u == (tg + 1u) * nx) xb_add(&bar[XB_TOPGEN], 1u);
            else XB_SPIN(xb_ld(&bar[XB_TOPGEN]) == tg, bar);
            __builtin_amdgcn_fence(__ATOMIC_ACQUIRE, "agent");
            xb_add(&bar[XB_XGEN(b.x)], 1u);
            asm volatile("s_waitcnt vmcnt(0)" ::: "memory");
        } else {
            XB_SPIN(xb_ld(&bar[XB_XGEN(b.x)]) == gen, bar);
            __builtin_amdgcn_fence(__ATOMIC_ACQUIRE, "agent");
            asm volatile("s_waitcnt vmcnt(0)" ::: "memory");
        }
    }
    __syncthreads();
}

__device__ __forceinline__ float wave_sum(float v) {
#pragma unroll
    for (int o = 1; o < 64; o <<= 1) v += __shfl_xor(v, o);
    return v;
}
__device__ __forceinline__ float sum16(float v) {
#pragma unroll
    for (int o = 1; o < 16; o <<= 1) v += __shfl_xor(v, o);
    return v;
}

__device__ __forceinline__ int rowof(int n, int b, int dir) {
    if (n < CTXL) { const int tc = dir ? (CTXL - 1 - n) : n; return ML + b * CTXL + tc; }
    const int tl = n - CTXL; const int t = dir ? (SEQL - 1 - tl) : tl; return b * SEQL + t;
}

__device__ __forceinline__ int permqk(int n) {
    const int d = n & 63, half = d >> 5, dd = d & 31, i = dd >> 2, j = dd & 3; return (n & ~63) + 8 * i + 4 * half + j;
}
template <bool PERMQK>
__device__ __forceinline__ void p0_transpose_item(const float* W, int K, int N, bf16* WT, LAS float* scr, int item, int lane) {
    const int nblk = N / 32, kb = item / nblk, nb = item % nblk, k0 = 64 * kb, n0 = 32 * nb;
#pragma unroll 8
    for (int i = 0; i < 32; ++i) { const int kk = 2 * i + (lane >> 5); scr[kk * 33 + (lane & 31)] = W[(size_t)(k0 + kk) * N + n0 + (lane & 31)]; }
    LDS_WAIT(); asm volatile("" ::: "memory");
    const int c = lane & 7;
#pragma unroll
    for (int j = 0; j < 4; ++j) { const int n = (lane >> 3) + 8 * j; const LAS float* s = scr + (8 * c) * 33 + n;
        v4u o; o.x = pk2(s[0 * 33], s[1 * 33]); o.y = pk2(s[2 * 33], s[3 * 33]); o.z = pk2(s[4 * 33], s[5 * 33]); o.w = pk2(s[6 * 33], s[7 * 33]);
        int nd = n0 + n; if (PERMQK && nd < 512) nd = permqk(nd);
        *(GAS v4u*)(WT + (size_t)nd * K + k0 + 8 * c) = o; }
    LDS_WAIT(); asm volatile("" ::: "memory");
}

__device__ __forceinline__ void norm_mod_rows(const float* hl, const float* hc, int nrows, const float* g, const float* mod, int shift_off, int scale_off, bf16* XN, int gw, int NGW, int lane) {
    for (int row = gw; row < nrows; row += NGW) {
        const float* xr = row < ML ? hl + (size_t)row * DM : hc + (size_t)(row - ML) * DM;
        const int mr = row < ML ? (row >> 12) : 8;
        const f32x4* x4 = (const f32x4*)xr + lane;
        f32x4 v[4]; float s = 0.f;
#pragma unroll
        for (int j = 0; j < 4; ++j) { v[j] = x4[64 * j]; s += (v[j].x * v[j].x + v[j].y * v[j].y) + (v[j].z * v[j].z + v[j].w * v[j].w); }
        const float rstd = 1.0f / sqrtf(wave_sum(s) * (1.f / DM) + EPSN);
        const f32x4* g4 = (const f32x4*)g + lane; const f32x4* sc4 = (const f32x4*)(mod + (size_t)mr * NMOD + scale_off) + lane; const f32x4* sh4 = (const f32x4*)(mod + (size_t)mr * NMOD + shift_off) + lane;
        unsigned long long* o8 = (unsigned long long*)(XN + (size_t)row * DM) + lane;
#pragma unroll
        for (int j = 0; j < 4; ++j) { const f32x4 gg = g4[64 * j], sc = sc4[64 * j], sh = sh4[64 * j];
            const f32x4 y = (v[j] * rstd) * gg * (sc + 1.0f) + sh;
            o8[64 * j] = (unsigned long long)pk2(y.x, y.y) | ((unsigned long long)pk2(y.z, y.w) << 32); }
    }
}
__device__ __forceinline__ void final_norm_rows(float* h, const float* g, int gw, int NGW, int lane) {
    for (int row = gw; row < ML; row += NGW) {
        f32x4* x4 = (f32x4*)(h + (size_t)row * DM) + lane;
        f32x4 v[4]; float s = 0.f;
#pragma unroll
        for (int j = 0; j < 4; ++j) { v[j] = x4[64 * j]; s += (v[j].x * v[j].x + v[j].y * v[j].y) + (v[j].z * v[j].z + v[j].w * v[j].w); }
        const float rstd = 1.0f / sqrtf(wave_sum(s) * (1.f / DM) + EPSN);
        const f32x4* g4 = (const f32x4*)g + lane;
#pragma unroll
        for (int j = 0; j < 4; ++j) x4[64 * j] = (v[j] * rstd) * g4[64 * j];
    }
}
__device__ __forceinline__ void unpack8(const v4u w, float (&o)[8]) { o[0] = bflo(w.x); o[1] = bfhi(w.x); o[2] = bflo(w.y); o[3] = bfhi(w.y); o[4] = bflo(w.z); o[5] = bfhi(w.z); o[6] = bflo(w.w); o[7] = bfhi(w.w); }
__device__ __forceinline__ v4u pack8(const float (&o)[8]) { v4u w; w.x = pk2(o[0], o[1]); w.y = pk2(o[2], o[3]); w.z = pk2(o[4], o[5]); w.w = pk2(o[6], o[7]); return w; }

__device__ __forceinline__ void merge1_rows(bf16* OS, const unsigned char* ws, const bf16* P1, const float* hgn, int gw, int NGW, int lane) {
    for (int row = gw; row < ML; row += NGW) {
#pragma unroll
        for (int half = 0; half < 2; ++half) {
            const int c0 = half * 512 + lane * 8;
            const v4u ow = *(const v4u*)(OS + (size_t)row * 1024 + c0), gw4 = *(const v4u*)(P1 + (size_t)row * 5120 + 4096 + c0);
            const v4u ob = *(const v4u*)((const bf16*)(ws + ws_ob(row >> 12)) + (size_t)(row & (SEQL - 1)) * 1024 + c0);
            const f32x4 n0 = *(const f32x4*)(hgn + (c0 & 127)), n1 = *(const f32x4*)(hgn + (c0 & 127) + 4);
            float o[8], gg[8], o2[8]; unpack8(ow, o); unpack8(gw4, gg); unpack8(ob, o2);
            float ss = 0.f;
#pragma unroll
            for (int i = 0; i < 8; ++i) o[i] += o2[i];
#pragma unroll
            for (int i = 0; i < 8; ++i) ss += o[i] * o[i];
            const float rs = 1.0f / sqrtf(sum16(ss) * (1.f / 128.f) + EPSN);
            const float nn[8] = {n0.x, n0.y, n0.z, n0.w, n1.x, n1.y, n1.z, n1.w};
            float r[8];
#pragma unroll
            for (int i = 0; i < 8; ++i) r[i] = o[i] * rs * nn[i] * siluf_(gg[i]);
            *(v4u*)(OS + (size_t)row * 1024 + c0) = pack8(r);
        }
    }
}

using pg8::Unit; using pg8::HALF; using pg8::BM;
__device__ __forceinline__ v4u pack2x4(const f32x4 v0, const f32x4 v1) { v4u w; w.x = pg8::cvt_pk_bf16(v0[0], v0[1]); w.y = pg8::cvt_pk_bf16(v0[2], v0[3]); w.z = pg8::cvt_pk_bf16(v1[0], v1[1]); w.w = pg8::cvt_pk_bf16(v1[2], v1[3]); return w; }

struct EpiProj0 {
    static constexpr bool PERM = true, AFTER_DRAIN = false;
    bf16* O; const float* CS; bf16* UA;
    __device__ __forceinline__ void operator()(const f32x4 (&acc)[2][2][4][2], const Unit& u, int wr, int wc, int fr, int fq) const {
        const int row0 = u.pm * BM + wr * 64 + fr, col0 = u.pn * BM + wc * 32 + 8 * fq;
        const bool lat = u.pm < ML / BM;
        const bool rope = (u.pn < 2) && lat; const float sc = (u.pn == 1) ? 0.125f : 1.0f;
        const bool isu = (u.pn == 4) || (u.pn == 5);
        const int ocol0 = (u.pn >= 6) ? col0 - 512 : col0;
        const int i4 = 4 * (4 * (wc & 1) + fq);
#pragma unroll
        for (int ai = 0; ai < 2; ++ai)
#pragma unroll
            for (int m = 0; m < 4; ++m) { const int row = row0 + ai * HALF + m * 16;
                f32x4 ca = (f32x4){1.f, 0.f, 1.f, 0.f}, cb = ca;
                if (rope) { const float* p = CS + ((size_t)(row & (SEQL - 1)) * 32 + i4) * 2; ca = *(const f32x4*)p; cb = *(const f32x4*)(p + 4); }
                bf16* rowp = O + (size_t)row * P0LD + ocol0;
                int r5, i5;
                if (lat) { const int t = row & (SEQL - 1); r5 = (row >> 12) * 136 + 8 + (t >> 5); i5 = t & 31; }
                else { const int rc = row - ML, t = rc & (CTXL - 1); r5 = (rc >> 8) * 136 + (t >> 5); i5 = t & 31; }
#pragma unroll
                for (int bj = 0; bj < 2; ++bj) { f32x4 v0 = acc[ai][bj][m][0], v1 = acc[ai][bj][m][1];
                    if (rope) {
                        const f32x4 lo = (f32x4){v0[0] * ca[0] - v1[0] * ca[1], v0[1] * ca[2] - v1[1] * ca[3], v0[2] * cb[0] - v1[2] * cb[1], v0[3] * cb[2] - v1[3] * cb[3]};
                        const f32x4 hi = (f32x4){v0[0] * ca[1] + v1[0] * ca[0], v0[1] * ca[3] + v1[1] * ca[2], v0[2] * cb[1] + v1[2] * cb[0], v0[3] * cb[3] + v1[3] * cb[2]};
                        v0 = lo; v1 = hi; }
                    v0 = v0 * sc; v1 = v1 * sc;
                    const v4u w = pack2x4(v0, v1);
                    if (isu) { const int c = col0 + bj * HALF - 1024, g5 = c >> 4, m0 = c & 15;
                        *(v4u*)(UA + ((size_t)(g5 * S5RP + r5) * S5K + i5 * 16 + m0)) = w; }
                    else *(v4u*)(rowp + bj * HALF) = w; } }
    }
};
struct EpiGlu {
    static constexpr bool PERM = true, AFTER_DRAIN = false;
    const bf16* Y; const float* b; bf16* Z;
    __device__ __forceinline__ void operator()(const f32x4 (&acc)[2][2][4][2], const Unit& u, int wr, int wc, int fr, int fq) const {
        const int row0 = u.pm * BM + wr * 64 + fr, col0 = u.pn * BM + wc * 32 + 8 * fq;
        f32x4 bv[2][2];
#pragma unroll
        for (int bj = 0; bj < 2; ++bj)
#pragma unroll
            for (int n = 0; n < 2; ++n) bv[bj][n] = *(const f32x4*)(b + col0 + bj * HALF + 4 * n);
#pragma unroll
        for (int ai = 0; ai < 2; ++ai)
#pragma unroll
            for (int m = 0; m < 4; ++m) { const int row = row0 + ai * HALF + m * 16;
#pragma unroll
                for (int bj = 0; bj < 2; ++bj) { const int col = col0 + bj * HALF;
                    const v4u yw = *(const v4u*)(Y + (size_t)row * 512 + col); float yy[8]; unpack8(yw, yy);
                    const f32x4 a0 = acc[ai][bj][m][0] + bv[bj][0], a1 = acc[ai][bj][m][1] + bv[bj][1];
                    const f32x4 z0 = (f32x4){yy[0] * sigmoidf_(a0[0]), yy[1] * sigmoidf_(a0[1]), yy[2] * sigmoidf_(a0[2]), yy[3] * sigmoidf_(a0[3])};
                    const f32x4 z1 = (f32x4){yy[4] * sigmoidf_(a1[0]), yy[5] * sigmoidf_(a1[1]), yy[6] * sigmoidf_(a1[2]), yy[7] * sigmoidf_(a1[3])};
                    *(v4u*)(Z + (size_t)row * 1024 + col) = pack2x4(z0, z1); } }
    }
};
struct EpiResid {
    static constexpr bool PERM = false, AFTER_DRAIN = false;
    const float* baseL; const float* baseC; float* outL; float* outC; const float* gate;
    __device__ __forceinline__ void operator()(const f32x4 (&acc)[2][2][4][2], const Unit& u, int wr, int wc, int fr, int fq) const {
        const bool ctx = u.pm >= ML / BM; const int mr = ctx ? 8 : (u.pm >> 4);
        const int row0 = (ctx ? u.pm - ML / BM : u.pm) * BM + wr * 64 + fr, col0 = u.pn * BM + wc * 32 + 4 * fq;
        const float* B = ctx ? baseC : baseL; float* Oo = ctx ? outC : outL;
        f32x4 gv[2][2];
#pragma unroll
        for (int bj = 0; bj < 2; ++bj)
#pragma unroll
            for (int n = 0; n < 2; ++n) gv[bj][n] = *(const f32x4*)(gate + (size_t)mr * NMOD + col0 + bj * HALF + n * 16);
#pragma unroll
        for (int ai = 0; ai < 2; ++ai)
#pragma unroll
            for (int m = 0; m < 4; ++m) { const size_t off = (size_t)(row0 + ai * HALF + m * 16) * DM + col0;
#pragma unroll
                for (int bj = 0; bj < 2; ++bj)
#pragma unroll
                    for (int n = 0; n < 2; ++n) { const f32x4 bs = *(const f32x4*)(B + off + bj * HALF + n * 16);
                        *(f32x4*)(Oo + off + bj * HALF + n * 16) = bs + gv[bj][n] * acc[ai][bj][m][n]; } }
    }
};
struct EpiSqrelu {
    static constexpr bool PERM = true, AFTER_DRAIN = false;
    bf16* O;
    __device__ __forceinline__ void operator()(const f32x4 (&acc)[2][2][4][2], const Unit& u, int wr, int wc, int fr, int fq) const {
        const int row0 = u.pm * BM + wr * 64 + fr, col0 = u.pn * BM + wc * 32 + 8 * fq;
#pragma unroll
        for (int ai = 0; ai < 2; ++ai)
#pragma unroll
            for (int m = 0; m < 4; ++m) { bf16* rowp = O + (size_t)(row0 + ai * HALF + m * 16) * DFF + col0;
#pragma unroll
                for (int bj = 0; bj < 2; ++bj) { f32x4 v0 = acc[ai][bj][m][0], v1 = acc[ai][bj][m][1];
                    v0 = __builtin_elementwise_max(v0, (f32x4){0.f, 0.f, 0.f, 0.f}); v1 = __builtin_elementwise_max(v1, (f32x4){0.f, 0.f, 0.f, 0.f});
                    *(v4u*)(rowp + bj * HALF) = pack2x4(v0 * v0, v1 * v1); } }
    }
};
struct EpiProj1 {
    static constexpr bool PERM = true, AFTER_DRAIN = false;
    bf16* O; const float* LB;
    __device__ __forceinline__ void operator()(const f32x4 (&acc)[2][2][4][2], const Unit& u, int wr, int wc, int fr, int fq) const {
        const int row0 = u.pm * BM + wr * 64 + fr, col0 = u.pn * BM + wc * 32 + 8 * fq;
        const int kind = u.pn >> 2;
        const bool gatek = (kind == 1) || (kind == 2);
        f32x4 lb[2][2];
#pragma unroll
        for (int bj = 0; bj < 2; ++bj)
#pragma unroll
            for (int n = 0; n < 2; ++n) lb[bj][n] = gatek ? *(const f32x4*)(LB + (size_t)(kind - 1) * 1024 + ((col0 + bj * HALF) & 1023) + 4 * n) : (f32x4){0.f, 0.f, 0.f, 0.f};
#pragma unroll
        for (int ai = 0; ai < 2; ++ai)
#pragma unroll
            for (int m = 0; m < 4; ++m) { bf16* rowp = O + (size_t)(row0 + ai * HALF + m * 16) * 5120 + col0;
#pragma unroll
                for (int bj = 0; bj < 2; ++bj) { const f32x4 v0 = acc[ai][bj][m][0], v1 = acc[ai][bj][m][1];
                    v4u w;
                    if (gatek) {
                        float l0[4], l1[4];
#pragma unroll
                        for (int i = 0; i < 4; ++i) { l0[i] = __logf(lb[bj][0][i] + (1.0f - lb[bj][0][i]) * sigmoidf_(v0[i])); l1[i] = __logf(lb[bj][1][i] + (1.0f - lb[bj][1][i]) * sigmoidf_(v1[i])); }
                        w.x = pk_f16(l0[0], l0[1]); w.y = pk_f16(l0[2], l0[3]); w.z = pk_f16(l1[0], l1[1]); w.w = pk_f16(l1[2], l1[3]);
                    } else w = pack2x4(v0, v1);
                    *(v4u*)(rowp + bj * HALF) = w; } }
    }
};

struct EpiHloc {
    static constexpr bool PERM = false, AFTER_DRAIN = false;
    float* C;
    __device__ __forceinline__ void operator()(const f32x4 (&acc)[2][2][4][2], const Unit& u, int wr, int wc, int fr, int fq) const {
        const int row0 = u.pm * BM + wr * 64 + fr, col0 = wc * 32 + 4 * fq;
#pragma unroll
        for (int ai = 0; ai < 2; ++ai)
#pragma unroll
            for (int m = 0; m < 4; ++m) { float* rowp = C + (size_t)(row0 + ai * HALF + m * 16) * 256 + col0;
#pragma unroll
                for (int bj = 0; bj < 2; ++bj)
#pragma unroll
                    for (int n = 0; n < 2; ++n) *(f32x4*)(rowp + bj * HALF + n * 16) = acc[ai][bj][m][n]; }
    }
};
struct EpiS5Out {
    static constexpr bool PERM = true, AFTER_DRAIN = false;
    const bf16* UA; const float* dskip; bf16* Y;
    __device__ __forceinline__ void operator()(const f32x4 (&acc)[2][2][4][2], const Unit& u, int wr, int wc, int fr, int fq) const {
        const int g5 = u.pm / 5, pml = u.pm - 5 * g5, pnl = u.pn - 2 * g5;
        const int r0 = pml * BM + wr * 64 + fr, col0 = pnl * BM + wc * 32 + 8 * fq;
#pragma unroll
        for (int ai = 0; ai < 2; ++ai)
#pragma unroll
            for (int m = 0; m < 4; ++m) { const int r = r0 + ai * HALF + m * 16;
                if (r < S5R) {
                    const int b = r / 136, ch = r - b * 136;
#pragma unroll
                    for (int bj = 0; bj < 2; ++bj) { const int col = col0 + bj * HALF, i5 = col >> 4, m0 = col & 15;
                        const int trow = ch < 8 ? ML + b * CTXL + ch * 32 + i5 : b * SEQL + (ch - 8) * 32 + i5;
                        const v4u uw = *(const v4u*)(UA + ((size_t)(g5 * S5RP + r) * S5K + col)); float uu[8]; unpack8(uw, uu);
                        const f32x4 d0 = *(const f32x4*)(dskip + g5 * 16 + m0), d1 = *(const f32x4*)(dskip + g5 * 16 + m0 + 4);
                        const f32x4 a0 = acc[ai][bj][m][0], a1 = acc[ai][bj][m][1];
                        const f32x4 y0 = (f32x4){gelu_tanh(a0[0] + d0[0] * uu[0]), gelu_tanh(a0[1] + d0[1] * uu[1]), gelu_tanh(a0[2] + d0[2] * uu[2]), gelu_tanh(a0[3] + d0[3] * uu[3])};
                        const f32x4 y1 = (f32x4){gelu_tanh(a1[0] + d1[0] * uu[4]), gelu_tanh(a1[1] + d1[1] * uu[5]), gelu_tanh(a1[2] + d1[2] * uu[6]), gelu_tanh(a1[3] + d1[3] * uu[7])};
                        *(v4u*)(Y + (size_t)trow * 512 + g5 * 16 + m0) = pack2x4(y0, y1); } } }
    }
};

__device__ __forceinline__ f32x2 cmul(f32x2 a, f32x2 b) { return (f32x2){a.x * b.x - a.y * b.y, a.x * b.y + a.y * b.x}; }
__device__ __forceinline__ void s5_tables_item(LAS unsigned char* lds, int g, const float* a_re, const float* a_im, const float* log_dt, const float* b_re, const float* b_im,
                                               const float* c_re, const float* c_im, bf16* Bc, bf16* Ws5) {
    const int tid = threadIdx.x;
    LAS f32x2* POW = (LAS f32x2*)lds;
    LAS f32x2* BBl = (LAS f32x2*)(lds + 33792);
    LAS f32x2* CCl = (LAS f32x2*)(lds + 50176);
    LAS float* KRN = (LAS float*)(lds + 66560);
    if (tid < 128) {
        const int d = tid >> 6, p = tid & 63, i = (d * 32 + g) * 64 + p;
        const float dt = expf(log_dt[d * 32 + g]); const float are = a_re[i], aim = a_im[i];
        const float mag = expf(are * dt), ang = aim * dt; const f32x2 ab = (f32x2){mag * cosf(ang), mag * sinf(ang)};
        const float nr = ab.x - 1.0f, ni = ab.y, den = are * are + aim * aim; const float fr = (nr * are + ni * aim) / den, fi = (ni * are - nr * aim) / den;
        f32x2 pw = (f32x2){1.f, 0.f};
        for (int e = 0; e <= 32; ++e) { POW[(d * 64 + p) * 33 + e] = pw; pw = cmul(pw, ab); }
        for (int n = 0; n < 16; ++n) { const float br = b_re[(size_t)i * 16 + n], bi = b_im[(size_t)i * 16 + n]; BBl[(d * 64 + p) * 16 + n] = (f32x2){fr * br - fi * bi, fr * bi + fi * br}; }
    }
    for (int o = tid; o < 2048; o += NWAVES * 64) { const int d = o >> 10, m = (o >> 6) & 15, p = o & 63; const size_t ci = ((size_t)(d * 32 + g) * 16 + m) * 64 + p; CCl[o] = (f32x2){c_re[ci], c_im[ci]}; }
    __syncthreads();
    for (int k = 0; k < 8; ++k) { const int o4 = tid + 512 * k, d = o4 >> 11, tau = (o4 >> 6) & 31, m = (o4 >> 2) & 15, nq = o4 & 3;
        float a0 = 0.f, a1 = 0.f, a2 = 0.f, a3 = 0.f;
        for (int p = 0; p < 64; ++p) { const f32x2 cp = cmul(CCl[(d * 16 + m) * 64 + p], POW[(d * 64 + p) * 33 + tau]); const LAS f32x2* bb = BBl + (d * 64 + p) * 16 + nq * 4;
            a0 += cp.x * bb[0].x - cp.y * bb[0].y; a1 += cp.x * bb[1].x - cp.y * bb[1].y; a2 += cp.x * bb[2].x - cp.y * bb[2].y; a3 += cp.x * bb[3].x - cp.y * bb[3].y; }
        *(LAS f32x4*)(KRN + ((d * 32 + tau) * 16 + m) * 16 + nq * 4) = (f32x4){a0, a1, a2, a3}; }
    __syncthreads();
    for (int k = 0; k < 96; ++k) { const int ch = tid + 512 * k, row = ch / 96, kc = ch - row * 96, k0 = kc * 8, i = row >> 4, m = row & 15;
        float v[8];
        if (k0 < 512) { const int j = k0 >> 4, n0 = k0 & 15;
            if (i > j) { const LAS float* s = KRN + ((0 * 32 + (i - j)) * 16 + m) * 16 + n0;
#pragma unroll
                for (int t = 0; t < 8; ++t) v[t] = s[t]; }
            else if (i < j) { const LAS float* s = KRN + ((1 * 32 + (j - i)) * 16 + m) * 16 + n0;
#pragma unroll
                for (int t = 0; t < 8; ++t) v[t] = s[t]; }
            else { const LAS float* s0 = KRN + ((0 * 32 + 0) * 16 + m) * 16 + n0; const LAS float* s1 = KRN + ((1 * 32 + 0) * 16 + m) * 16 + n0;
#pragma unroll
                for (int t = 0; t < 8; ++t) v[t] = s0[t] + s1[t]; }
        } else { const int q0 = k0 - 512, d = q0 >> 7, p0 = (q0 & 127) >> 1, e = d == 0 ? i + 1 : 32 - i;
#pragma unroll
            for (int t = 0; t < 4; ++t) { const f32x2 ca = cmul(CCl[(d * 16 + m) * 64 + p0 + t], POW[(d * 64 + p0 + t) * 33 + e]); v[2 * t] = ca.x; v[2 * t + 1] = -ca.y; } }
        *(v4u*)(Bc + ((size_t)(g * 512 + row) * S5K + k0)) = pack8(v); }
    for (int k = 0; k < 32; ++k) { const int ch = tid + 512 * k, q = ch >> 6, kc = ch & 63, k0 = kc * 8, j = k0 >> 4, n0 = k0 & 15;
        const int d = q >> 7, p = (q & 127) >> 1, ri = q & 1, ef = d == 0 ? 31 - j : j;
        const f32x2 pw = POW[(d * 64 + p) * 33 + ef]; float v[8];
#pragma unroll
        for (int t = 0; t < 8; ++t) { const f32x2 w = cmul(pw, BBl[(d * 64 + p) * 16 + n0 + t]); v[t] = ri ? w.y : w.x; }
        *(v4u*)(Ws5 + ((size_t)(g * 256 + q) * 512 + k0)) = pack8(v); }
    __syncthreads();
}
__device__ __forceinline__ void s5_scan(const float* HL, bf16* UA, const f32x2* AB, int gw, int NGW, int lane) {
    for (int w = gw; w < 512; w += NGW) {
        const int b = w >> 6, g = (w >> 1) & 31, d = w & 1;
        f32x2 a32 = AB[(d * 32 + g) * 64 + lane];
#pragma unroll
        for (int i = 0; i < 5; ++i) a32 = cmul(a32, a32);
        f32x2 h = (f32x2){0.f, 0.f};
        const size_t rbase = (size_t)g * S5RP + b * 136;
#pragma unroll 1
        for (int s0 = 0; s0 < 136; s0 += 34) {
            f32x2 hl[34];
#pragma unroll
            for (int k = 0; k < 34; ++k) { const int s = s0 + k, c = d == 0 ? s : (s < 8 ? 7 - s : 143 - s); hl[k] = *(const f32x2*)(HL + (rbase + c) * 256 + d * 128 + lane * 2); }
#pragma unroll
            for (int k = 0; k < 34; ++k) { const int s = s0 + k, c = d == 0 ? s : (s < 8 ? 7 - s : 143 - s);
                *(unsigned*)(UA + (rbase + c) * S5K + 512 + d * 128 + lane * 2) = pk2(h.x, h.y);
                h = cmul(a32, h) + hl[k]; }
        }
    }
}

typedef short bf16x8_t __attribute__((ext_vector_type(8)));
__device__ __forceinline__ bf16x8_t frag_rm(const LAS unsigned char* T, int RS, int r0, int k0, int lane) { return *(const LAS bf16x8_t*)(T + (r0 + (lane & 15)) * RS + (k0 + 8 * (lane >> 4)) * 2); }
#define MFMA16(a, b, c) __builtin_amdgcn_mfma_f32_16x16x32_bf16((a), (b), (c), 0, 0, 0)
typedef short v4i16_t __attribute__((ext_vector_type(4)));
__device__ __forceinline__ bf16x8_t frag_tr(const LAS unsigned char* T, int RS, int k0, int n0, int lane) {
    const int g = lane >> 4, q = (lane & 15) >> 2, p = lane & 3;
    const LAS unsigned char* a = T + (k0 + 8 * g + q) * RS + (n0 + 4 * p) * 2;
    const v4i16_t lo = __builtin_amdgcn_ds_read_tr16_b64_v4i16((LAS v4i16_t*)a);
    const v4i16_t hi = __builtin_amdgcn_ds_read_tr16_b64_v4i16((LAS v4i16_t*)(a + 4 * RS));
    return (bf16x8_t){lo[0], lo[1], lo[2], lo[3], hi[0], hi[1], hi[2], hi[3]};
}
__device__ __forceinline__ bf16x8_t scale_frag(bf16x8_t f, float sc) {
    const v4u w = __builtin_bit_cast(v4u, f); float t[8]; unpack8(w, t);
    v4u o; o.x = pk2(t[0] * sc, t[1] * sc); o.y = pk2(t[2] * sc, t[3] * sc); o.z = pk2(t[4] * sc, t[5] * sc); o.w = pk2(t[6] * sc, t[7] * sc);
    return __builtin_bit_cast(bf16x8_t, o);
}
constexpr int RCH = 34;
__device__ __forceinline__ int ret_row0(int b, int s) { return s < 2 ? ML + b * CTXL + s * 128 : b * SEQL + (s - 2) * 128; }
__device__ __forceinline__ void stage_v(LAS unsigned char* Vs, const bf16* P0, int row0, int h, int tid) {
#pragma unroll
    for (int k = 0; k < 4; ++k) { const int c = tid + 512 * k, j = c >> 4, ch = c & 15;
        *(LAS v4u*)(Vs + j * 272 + ch * 16) = *(const v4u*)(P0 + (size_t)(row0 + j) * P0LD + 512 + h * 128 + ch * 8); }
}
__device__ __forceinline__ void ret_passA_item(LAS unsigned char* lds, int it, const bf16* P0, const float* ret_logit, bf16* ULOC) {
    int tid_ = threadIdx.x; asm volatile("" : "+v"(tid_)); const int tid = tid_, lane = tid & 63, w = tid >> 6, g4 = lane >> 4;
    const int bh = it / RCH, s = it - bh * RCH, b = bh >> 2, h = bh & 3, row0 = ret_row0(b, s);
    const float lgf = log2f(1.0f / (1.0f + expf(-ret_logit[h]))), lgb = log2f(1.0f / (1.0f + expf(-ret_logit[4 + h])));
    LAS unsigned char* Kf = lds; LAS unsigned char* Kb = lds + 18432; LAS unsigned char* Vs = lds + 36864;
#pragma unroll
    for (int k = 0; k < 2; ++k) { const int c = tid + 512 * k, j = c >> 3, ch = c & 7;
        const v4u wv = *(const v4u*)(P0 + (size_t)(row0 + j) * P0LD + 256 + h * 64 + ch * 8); float t[8]; unpack8(wv, t);
        const float sf = exp2f((float)(127 - j) * lgf), sb = exp2f((float)j * lgb);
        v4u of, ob; of.x = pk2(t[0] * sf, t[1] * sf); of.y = pk2(t[2] * sf, t[3] * sf); of.z = pk2(t[4] * sf, t[5] * sf); of.w = pk2(t[6] * sf, t[7] * sf);
        ob.x = pk2(t[0] * sb, t[1] * sb); ob.y = pk2(t[2] * sb, t[3] * sb); ob.z = pk2(t[4] * sb, t[5] * sb); ob.w = pk2(t[6] * sb, t[7] * sb);
        *(LAS v4u*)(Kf + j * 144 + ch * 16) = of; *(LAS v4u*)(Kb + j * 144 + ch * 16) = ob; }
    stage_v(Vs, P0, row0, h, tid);
    __syncthreads();
    f32x4 acc[2][4];
#pragma unroll
    for (int d = 0; d < 2; ++d)
#pragma unroll
        for (int dt = 0; dt < 4; ++dt) acc[d][dt] = (f32x4){0.f, 0.f, 0.f, 0.f};
#pragma unroll
    for (int ks = 0; ks < 4; ++ks) { const bf16x8_t vb = frag_tr(Vs, 272, 32 * ks, 16 * w, lane);
#pragma unroll
        for (int dt = 0; dt < 4; ++dt) { acc[0][dt] = MFMA16(frag_tr(Kf, 144, 32 * ks, 16 * dt, lane), vb, acc[0][dt]); acc[1][dt] = MFMA16(frag_tr(Kb, 144, 32 * ks, 16 * dt, lane), vb, acc[1][dt]); } }
    const int e = 16 * w + (lane & 15);
#pragma unroll
    for (int d = 0; d < 2; ++d)
#pragma unroll
        for (int dt = 0; dt < 4; ++dt) { v2u o; o.x = pk2(acc[d][dt][0], acc[d][dt][1]); o.y = pk2(acc[d][dt][2], acc[d][dt][3]);
            *(v2u*)(ULOC + ((size_t)((bh * 2 + d) * RCH + s) * 128 + e) * 64 + 16 * dt + 4 * g4) = o; }
    __syncthreads();
}
__device__ __forceinline__ void ret_scan(const bf16* ULOC, bf16* SIN, const float* ret_logit, int gt, int NT) {
    for (int idx = gt; idx < 64 * 2048; idx += NT) {
        const int bhd = idx >> 11, off = (idx & 2047) * 4, dir = bhd & 1, h = (bhd >> 1) & 3;
        const float g128 = exp2f(128.0f * log2f(1.0f / (1.0f + expf(-ret_logit[dir * 4 + h]))));
        const size_t base = (size_t)bhd * RCH * 8192 + off;
        v2u u[RCH];
#pragma unroll
        for (int k = 0; k < RCH; ++k) { const int s = dir == 0 ? k : (k < 2 ? 1 - k : 35 - k); u[k] = *(const v2u*)(ULOC + base + (size_t)s * 8192); }
        float st[4] = {0.f, 0.f, 0.f, 0.f};
#pragma unroll
        for (int k = 0; k < RCH; ++k) { const int s = dir == 0 ? k : (k < 2 ? 1 - k : 35 - k);
            v2u o; o.x = pg8::cvt_pk_bf16(st[0], st[1]); o.y = pg8::cvt_pk_bf16(st[2], st[3]); *(v2u*)(SIN + base + (size_t)s * 8192) = o;
            st[0] = g128 * st[0] + bflo(u[k].x); st[1] = g128 * st[1] + bfhi(u[k].x); st[2] = g128 * st[2] + bflo(u[k].y); st[3] = g128 * st[3] + bfhi(u[k].y); }
    }
}
__device__ __forceinline__ void ret_passC_item(LAS unsigned char* lds, int it, const bf16* P0, const float* ret_logit, const bf16* SIN, bf16* RZ) {
    int tid_ = threadIdx.x; asm volatile("" : "+v"(tid_)); const int tid = tid_, lane = tid & 63, w = tid >> 6, g4 = lane >> 4, l15 = lane & 15;
    const int bh = it / RCH, s = it - bh * RCH, b = bh >> 2, h = bh & 3, row0 = ret_row0(b, s);
    const float lgf = log2f(1.0f / (1.0f + expf(-ret_logit[h]))), lgb = log2f(1.0f / (1.0f + expf(-ret_logit[4 + h])));
    LAS unsigned char* Qs = lds; LAS unsigned char* Ks = lds + 18432; LAS unsigned char* SfT = lds + 36864; LAS unsigned char* SbT = lds + 55296; LAS unsigned char* Vs = lds + 73728;
    LAS unsigned char* Pm = lds + 108544;
#pragma unroll
    for (int k = 0; k < 2; ++k) { const int c = tid + 512 * k, j = c >> 3, ch = c & 7;
        *(LAS v4u*)(Qs + j * 144 + ch * 16) = *(const v4u*)(P0 + (size_t)(row0 + j) * P0LD + h * 64 + ch * 8);
        *(LAS v4u*)(Ks + j * 144 + ch * 16) = *(const v4u*)(P0 + (size_t)(row0 + j) * P0LD + 256 + h * 64 + ch * 8);
        *(LAS v4u*)(SfT + j * 144 + ch * 16) = *(const v4u*)(SIN + ((size_t)((bh * 2 + 0) * RCH + s) * 128 + j) * 64 + ch * 8);
        *(LAS v4u*)(SbT + j * 144 + ch * 16) = *(const v4u*)(SIN + ((size_t)((bh * 2 + 1) * RCH + s) * 128 + j) * 64 + ch * 8); }
    stage_v(Vs, P0, row0, h, tid);
    const int il = 16 * w + l15;
    const size_t row = (size_t)(row0 + il);
    v2u gatew[8];
#pragma unroll
    for (int t = 0; t < 8; ++t) gatew[t] = *(const v2u*)(P0 + row * P0LD + 1024 + h * 128 + 16 * t + 4 * g4);
    __syncthreads();
    f32x4 accO[8], accA[8];
#pragma unroll
    for (int t = 0; t < 8; ++t) { accO[t] = (f32x4){0.f, 0.f, 0.f, 0.f}; accA[t] = (f32x4){0.f, 0.f, 0.f, 0.f}; }
    { const float af = exp2f((float)(il + 1) * lgf), ab = exp2f((float)(128 - il) * lgb);
#pragma unroll
      for (int ks = 0; ks < 2; ++ks) { const bf16x8_t q = frag_rm(Qs, 144, 16 * w, 32 * ks, lane); const bf16x8_t qf = scale_frag(q, af), qb = scale_frag(q, ab);
#pragma unroll
          for (int t = 0; t < 8; ++t) { accA[t] = MFMA16(frag_rm(Ks, 144, 16 * t, 32 * ks, lane), q, accA[t]);
              accO[t] = MFMA16(frag_rm(SfT, 144, 16 * t, 32 * ks, lane), qf, accO[t]); accO[t] = MFMA16(frag_rm(SbT, 144, 16 * t, 32 * ks, lane), qb, accO[t]); } } }
#pragma unroll
    for (int t = 0; t < 8; ++t) { float pv[4];
#pragma unroll
        for (int r = 0; r < 4; ++r) { const int j = 16 * t + 4 * g4 + r;
            const float dm = il > j ? exp2f((float)(il - j) * lgf) : (il < j ? exp2f((float)(j - il) * lgb) : 2.0f); pv[r] = accA[t][r] * dm; }
        v2u pw; pw.x = pk2(pv[0], pv[1]); pw.y = pk2(pv[2], pv[3]); *(LAS v2u*)(Pm + il * 272 + (16 * t + 4 * g4) * 2) = pw; }
    __syncthreads();
#pragma unroll
    for (int ks = 0; ks < 4; ++ks) { const bf16x8_t p = frag_rm(Pm, 272, 16 * w, 32 * ks, lane);
#pragma unroll
        for (int t = 0; t < 8; ++t) accO[t] = MFMA16(frag_tr(Vs, 272, 32 * ks, 16 * t, lane), p, accO[t]); }
    float ss = 0.f;
#pragma unroll
    for (int t = 0; t < 8; ++t) ss += (accO[t][0] * accO[t][0] + accO[t][1] * accO[t][1]) + (accO[t][2] * accO[t][2] + accO[t][3] * accO[t][3]);
    ss += __shfl_xor(ss, 16); ss += __shfl_xor(ss, 32);
    const float rs = 1.0f / sqrtf(ss * (1.f / 128.f) + EPSN);
#pragma unroll
    for (int t = 0; t < 8; ++t) { const float g0 = bflo(gatew[t].x), g1 = bfhi(gatew[t].x), g2 = bflo(gatew[t].y), g3 = bfhi(gatew[t].y);
        v2u o; o.x = pk2(accO[t][0] * rs * siluf_(g0), accO[t][1] * rs * siluf_(g1)); o.y = pk2(accO[t][2] * rs * siluf_(g2), accO[t][3] * rs * siluf_(g3));
        *(v2u*)(RZ + row * 1024 + h * 128 + 16 * t + 4 * g4) = o; }
    __syncthreads();
}
__device__ __forceinline__ int hg_row0(int b, int dir, int st) {
    if (st < 8) { const int c = dir ? 7 - st : st; return ML + b * CTXL + c * 32; }
    const int c = dir ? 135 - st : st - 8; return b * SEQL + c * 32;
}
struct HgRaw { v4u q0, q1, l0, l1, v; };
#define HG_ISSUE(R_, st_) do { const int r0_ = hg_row0(b, dir, (st_)); \
        const bf16* qp_ = P1 + (size_t)(r0_ + rtok) * 5120 + h * 128 + rseg; \
        (R_).q0 = *(const v4u*)qp_; (R_).q1 = *(const v4u*)(qp_ + (size_t)16 * 5120); (R_).l0 = *(const v4u*)(qp_ + 1024 + dir * 1024); (R_).l1 = *(const v4u*)(qp_ + (size_t)16 * 5120 + 1024 + dir * 1024); \
        (R_).v = *(const v4u*)(P1 + (size_t)(r0_ + tv) * 5120 + 3072 + h * 128 + eh * 64 + eseg); } while (0)
__device__ __forceinline__ float f16bits(unsigned short hbits) { return (float)__builtin_bit_cast(_Float16, hbits); }
__device__ __forceinline__ void hgrn_item(LAS unsigned char* lds, int it, const bf16* P1, bf16* OS, unsigned char* ws) {
    int tid_ = threadIdx.x; asm volatile("" : "+v"(tid_)); const int tid = tid_;
    const int lane = tid & 63, w = tid >> 6, g4 = lane >> 4, l15 = lane & 15;
    const bool active = w < 4;
    const int dir = it & 1, et = w & 3, td = tid & 255, d = td & 127, tq = td >> 7, tv = td >> 3, eseg = (td & 7) * 8;
    const int rtok = td >> 4, rseg = (td & 15) * 8;
    const int b = it >> 5, h = (it >> 2) & 7, eh = (it >> 1) & 1;
    LAS unsigned char* base = lds;
    LAS unsigned char* QI = base; LAS unsigned char* KI = base + 8704; LAS unsigned char* LR = base + 17408; LAS unsigned char* KT = base + 26112; LAS unsigned char* VT = base + 36352; LAS unsigned char* PM = base + 41472;
    LAS float* DEC = (LAS float*)(base + 44032);
    f32x4 S[8];
#pragma unroll
    for (int t = 0; t < 8; ++t) S[t] = (f32x4){0.f, 0.f, 0.f, 0.f};
    HgRaw R[4];
    v2u pend[2] = {(v2u){0u, 0u}, (v2u){0u, 0u}};
    if (active) { HG_ISSUE(R[0], 0); HG_ISSUE(R[1], 1); HG_ISSUE(R[2], 2); }
#pragma unroll 1
    for (int st4 = 0; st4 < 136; st4 += 4) {
#pragma unroll
    for (int u = 0; u < 4; ++u) {
        const int st = st4 + u;
        const int row0 = hg_row0(b, dir, st);
        __syncthreads();
        if (active) {
        *(LAS v4u*)(QI + rtok * 272 + rseg * 2) = R[u].q0; *(LAS v4u*)(QI + (rtok + 16) * 272 + rseg * 2) = R[u].q1;
        *(LAS v4u*)(LR + rtok * 272 + rseg * 2) = R[u].l0; *(LAS v4u*)(LR + (rtok + 16) * 272 + rseg * 2) = R[u].l1;
        const v4u vr = R[u].v;
        { LAS unsigned short* vp = (LAS unsigned short*)(VT + eseg * 80 + tv * 2);
          vp[0 * 40] = (unsigned short)(vr.x & 0xffffu); vp[1 * 40] = (unsigned short)(vr.x >> 16); vp[2 * 40] = (unsigned short)(vr.y & 0xffffu); vp[3 * 40] = (unsigned short)(vr.y >> 16);
          vp[4 * 40] = (unsigned short)(vr.z & 0xffffu); vp[5 * 40] = (unsigned short)(vr.z >> 16); vp[6 * 40] = (unsigned short)(vr.w & 0xffffu); vp[7 * 40] = (unsigned short)(vr.w >> 16); }
        if (st >= 9) { const int prow = hg_row0(b, dir, st - 1);
            bf16* obase = dir == 0 ? OS + (size_t)prow * 1024 : (bf16*)(ws + ws_ob(b)) + (size_t)(prow - b * SEQL) * 1024;
#pragma unroll
            for (int t2 = 0; t2 < 2; ++t2) *(v2u*)(obase + (size_t)(16 * t2 + l15) * 1024 + h * 128 + eh * 64 + 16 * et + 4 * g4) = pend[t2]; }
        if (st + 3 < 136) HG_ISSUE(R[(u + 3) & 3], st + 3);
        }
        __syncthreads();
        if (active) {
            const int dpl = lane & 15, tq8 = lane >> 4, d0 = 2 * ((w & 3) * 16 + dpl), t0 = tq8 * 8;
            float la[8], lb[8], Ta = 0.f, Tb = 0.f;
#pragma unroll
            for (int i = 0; i < 8; ++i) { const unsigned wv = *(const LAS unsigned*)(LR + (t0 + i) * 272 + d0 * 2); la[i] = f16lo(wv); lb[i] = f16hi(wv); Ta += la[i]; Tb += lb[i]; }
            const float A0 = __shfl(Ta, dpl), A1 = __shfl(Ta, 16 + dpl), A2 = __shfl(Ta, 32 + dpl), A3 = __shfl(Ta, 48 + dpl);
            const float B0 = __shfl(Tb, dpl), B1 = __shfl(Tb, 16 + dpl), B2 = __shfl(Tb, 32 + dpl), B3 = __shfl(Tb, 48 + dpl);
            const float tota = (A0 + A1) + (A2 + A3), totb = (B0 + B1) + (B2 + B3);
            float basea, baseb;
            if (dir == 0) { basea = (tq8 > 0 ? A0 : 0.f) + (tq8 > 1 ? A1 : 0.f) + (tq8 > 2 ? A2 : 0.f); baseb = (tq8 > 0 ? B0 : 0.f) + (tq8 > 1 ? B1 : 0.f) + (tq8 > 2 ? B2 : 0.f); }
            else          { basea = (tq8 < 3 ? A3 : 0.f) + (tq8 < 2 ? A2 : 0.f) + (tq8 < 1 ? A1 : 0.f); baseb = (tq8 < 3 ? B3 : 0.f) + (tq8 < 2 ? B2 : 0.f) + (tq8 < 1 ? B1 : 0.f); }
            float ea = __expf(basea), eb = __expf(baseb); const float eta = __expf(tota), etb = __expf(totb);
            float koa[8], kob[8];
#pragma unroll
            for (int ii = 0; ii < 8; ++ii) { const int i = dir == 0 ? ii : 7 - ii;
                const float fa = __expf(la[i]), fb = __expf(lb[i]); ea *= fa; eb *= fb;
                LAS unsigned* qp = (LAS unsigned*)(QI + (t0 + i) * 272 + d0 * 2); const unsigned qw = *qp;
                const float kia = (1.0f - fa) * __builtin_amdgcn_rcpf(ea), kib = (1.0f - fb) * __builtin_amdgcn_rcpf(eb);
                *qp = pk2(bflo(qw) * ea, bfhi(qw) * eb);
                *(LAS unsigned*)(KI + (t0 + i) * 272 + d0 * 2) = pk2(kia, kib);
                koa[i] = kia * eta; kob[i] = kib * etb; }
            v4u k0, k1;
            k0.x = pk2(koa[0], koa[1]); k0.y = pk2(koa[2], koa[3]); k0.z = pk2(koa[4], koa[5]); k0.w = pk2(koa[6], koa[7]);
            k1.x = pk2(kob[0], kob[1]); k1.y = pk2(kob[2], kob[3]); k1.z = pk2(kob[4], kob[5]); k1.w = pk2(kob[6], kob[7]);
            *(LAS v4u*)(KT + d0 * 80 + t0 * 2) = k0; *(LAS v4u*)(KT + (d0 + 1) * 80 + t0 * 2) = k1;
            if (tq8 == 0) { DEC[d0] = eta; DEC[d0 + 1] = etb; }
        }
        __syncthreads();
        if (active) {
            const int it1 = et >> 1, jt1 = et & 1;
            f32x4 ap = (f32x4){0.f, 0.f, 0.f, 0.f};
#pragma unroll
            for (int ks = 0; ks < 4; ++ks) ap = MFMA16(frag_rm(QI, 272, 16 * it1, 32 * ks, lane), frag_rm(KI, 272, 16 * jt1, 32 * ks, lane), ap);
#pragma unroll
            for (int r = 0; r < 4; ++r) { const int i = 16 * it1 + 4 * g4 + r, j = 16 * jt1 + l15; const bool keep = dir == 0 ? (j <= i) : (j >= i);
                *(LAS unsigned short*)(PM + i * 80 + j * 2) = keep ? (unsigned short)f2bf(ap[r]) : (unsigned short)0; }
        }
        __syncthreads();
        if (active) {
            bf16x8_t sb[4];
#pragma unroll
            for (int ks = 0; ks < 4; ++ks) { v4u t; t.x = pk2(S[2 * ks][0], S[2 * ks][1]); t.y = pk2(S[2 * ks][2], S[2 * ks][3]); t.z = pk2(S[2 * ks + 1][0], S[2 * ks + 1][1]); t.w = pk2(S[2 * ks + 1][2], S[2 * ks + 1][3]);
                sb[ks] = __builtin_bit_cast(bf16x8_t, t); }
            const bf16x8_t vfrag = frag_rm(VT, 80, 16 * et, 0, lane);
            f32x4 o[2];
#pragma unroll
            for (int t2 = 0; t2 < 2; ++t2) {
                o[t2] = MFMA16(vfrag, frag_rm(PM, 80, 16 * t2, 0, lane), ((f32x4){0.f, 0.f, 0.f, 0.f}));
#pragma unroll
                for (int ks = 0; ks < 4; ++ks) { const LAS unsigned char* qrow = QI + (16 * t2 + l15) * 272 + (32 * ks + 4 * g4) * 2;
                    const v2u qa = *(const LAS v2u*)qrow, qb = *(const LAS v2u*)(qrow + 32);
                    v4u qq; qq.x = qa.x; qq.y = qa.y; qq.z = qb.x; qq.w = qb.y;
                    o[t2] = MFMA16(sb[ks], __builtin_bit_cast(bf16x8_t, qq), o[t2]); }
            }
#pragma unroll
            for (int dt = 0; dt < 8; ++dt) { const f32x4 dv = *(const LAS f32x4*)(DEC + 16 * dt + 4 * g4);
                S[dt] = MFMA16(frag_rm(KT, 80, 16 * dt, 0, lane), vfrag, S[dt] * dv); }
#pragma unroll
            for (int t2 = 0; t2 < 2; ++t2) { pend[t2].x = pk2(o[t2][0], o[t2][1]); pend[t2].y = pk2(o[t2][2], o[t2][3]); }
        }
    }
    }
    if (active) { const int prow = hg_row0(b, dir, 135);
      bf16* obase = dir == 0 ? OS + (size_t)prow * 1024 : (bf16*)(ws + ws_ob(b)) + (size_t)(prow - b * SEQL) * 1024;
#pragma unroll
      for (int t2 = 0; t2 < 2; ++t2) *(v2u*)(obase + (size_t)(16 * t2 + l15) * 1024 + h * 128 + eh * 64 + 16 * et + 4 * g4) = pend[t2]; }
    __syncthreads();
}

struct Args { const float* in[28]; float* out; unsigned char* ws; };
enum { I_X = 0, I_C, I_CTX, I_CCTX, I_WMOD, I_BMOD, I_NMIX, I_NMLP, I_W1, I_W2, I_ABWIN, I_ABWOUT, I_RETL, I_S5ARE, I_S5AIM, I_S5DT, I_S5BRE, I_S5BIM, I_S5CRE, I_S5CIM, I_S5D, I_S5WGLU, I_S5BGLU, I_HGWIN, I_HGWOUT, I_HGLB, I_HGNORM, I_NFIN };

__global__ void __launch_bounds__(NWAVES * 64, 2) mk_fwd(Args args) {
    extern __shared__ __attribute__((aligned(16))) unsigned char lds_raw[];
    LAS unsigned char* lds = (LAS unsigned char*)lds_raw;
    volatile LAS unsigned* MISC = (volatile LAS unsigned*)(lds + MISC_OFF);
    const int tid = threadIdx.x, lane = tid & 63, wave = __builtin_amdgcn_readfirstlane(tid >> 6);
    const int G = gridDim.x;
    const int vcu = (G % 8 == 0) ? ((int)blockIdx.x % 8) * (G / 8) + (int)blockIdx.x / 8 : (int)blockIdx.x;
    const int gw = vcu * NWAVES + wave, NGW = G * NWAVES;
    unsigned char* ws = args.ws;
    gu32* ctl = (gu32*)(ws + WS_CTL);
    for (int u = tid; u < (LDS_BYTES - LDSCTL_OFF) / 4; u += NWAVES * 64) ((LAS unsigned*)(lds + LDSCTL_OFF))[u] = 0u;
    __syncthreads();
    XcdBarrier bar = xcd_barrier_post((unsigned*)(ctl + CW_BAR), MISC + 8);
#define GRID_BAR() xcd_barrier(bar)

    float* MOD = (float*)(ws + WS_MOD); float* CS = (float*)(ws + WS_CS);
    f32x2* AB = (f32x2*)(ws + WS_S5T); float* LB = (float*)(ws + WS_LB);
    float* HC = (float*)(ws + WS_HC);
    bf16* Win0 = (bf16*)(ws + WS_WIN0); bf16* Wout0 = (bf16*)(ws + WS_WOUT0); bf16* Wglu = (bf16*)(ws + WS_WGLU);
    bf16* W1t0 = (bf16*)(ws + WS_W1_0); bf16* W2t0 = (bf16*)(ws + WS_W2_0); bf16* W1t1 = (bf16*)(ws + WS_W1_1); bf16* W2t1 = (bf16*)(ws + WS_W2_1); bf16* Whg = (bf16*)(ws + WS_WHG); bf16* Whgo = (bf16*)(ws + WS_WHGO);
    bf16* XN = (bf16*)(ws + WS_XN); bf16* P0b = (bf16*)(ws + WS_P0); bf16* P1b = (bf16*)(ws + WS_P1); bf16* Hb = (bf16*)(ws + WS_H);
    bf16* ULOC = (bf16*)(ws + WS_ULOC); bf16* SIN = (bf16*)(ws + WS_SIN);
    bf16* UA = (bf16*)(ws + WS_UA); bf16* Bc = (bf16*)(ws + WS_BC); bf16* Ws5 = (bf16*)(ws + WS_WS5); float* HLOC = (float*)(ws + WS_HLOC);
    bf16* RZ = (bf16*)(ws + WS_RZ); bf16* Yb = (bf16*)(ws + WS_Y); bf16* OS = (bf16*)(ws + WS_XN);
    float* OUT = args.out;

    {
        LAS float* scr = (LAS float*)(lds + RING_OFF + wave * 16384);
        constexpr int I_A = 16 * 64, I_B = 16 * 32, I_G = 8 * 16, I_1 = 16 * 128, I_2 = 64 * 32, I_H = 16 * 160, I_O = 16 * 32;
        constexpr int NITEMS = I_A + I_B + I_G + 2 * I_1 + 2 * I_2 + I_H + I_O;
        for (int it = gw; it < NITEMS; it += NGW) {
            int r = it;
            if (r < I_A) { p0_transpose_item<true>(args.in[I_ABWIN], 1024, 2048, Win0, scr, r, lane); continue; } r -= I_A;
            if (r < I_B) { p0_transpose_item<false>(args.in[I_ABWOUT], 1024, 1024, Wout0, scr, r, lane); continue; } r -= I_B;
            if (r < I_G) { p0_transpose_item<false>(args.in[I_S5WGLU], 512, 512, Wglu, scr, r, lane); continue; } r -= I_G;
            if (r < 2 * I_1) { const int l = r / I_1; p0_transpose_item<false>(args.in[I_W1] + (size_t)l * 1024 * 4096, 1024, 4096, l ? W1t1 : W1t0, scr, r % I_1, lane); continue; } r -= 2 * I_1;
            if (r < 2 * I_2) { const int l = r / I_2; p0_transpose_item<false>(args.in[I_W2] + (size_t)l * 1024 * 4096, 4096, 1024, l ? W2t1 : W2t0, scr, r % I_2, lane); continue; } r -= 2 * I_2;
            if (r < I_H) { p0_transpose_item<false>(args.in[I_HGWIN], 1024, 5120, Whg, scr, r, lane); continue; } r -= I_H;
            p0_transpose_item<false>(args.in[I_HGWOUT], 1024, 1024, Whgo, scr, r, lane);
        }
        __syncthreads();
        if ((int)blockIdx.x < 96) {
            LAS float* Ssil = (LAS float*)lds; LAS float* red = (LAS float*)(lds + 36864);
            for (int i = tid; i < 9 * 1024; i += NWAVES * 64) { const int r = i >> 10, k = i & 1023; const float v = r < 8 ? args.in[I_C][r * 1024 + k] : args.in[I_CCTX][k]; Ssil[i] = v / (1.0f + expf(-v)); }
            __syncthreads();
            for (int it = blockIdx.x; it < 96; it += G) {
                const int l = it / 48, col0 = (it % 48) * 128, cgp = tid & 31, ksl = tid >> 5;
                const float* W = args.in[I_WMOD] + (size_t)l * 1024 * NMOD + col0 + 4 * cgp;
                f32x4 a[9];
#pragma unroll
                for (int r = 0; r < 9; ++r) a[r] = (f32x4){0.f, 0.f, 0.f, 0.f};
                for (int kk = 0; kk < 64; ++kk) { const int k = ksl * 64 + kk; const f32x4 w = *(const f32x4*)(W + (size_t)k * NMOD);
#pragma unroll
                    for (int r = 0; r < 9; ++r) a[r] += w * Ssil[r * 1024 + k]; }
#pragma unroll
                for (int r = 0; r < 9; ++r) *(LAS f32x4*)(red + (ksl * 9 + r) * 128 + 4 * cgp) = a[r];
                __syncthreads();
                for (int o = tid; o < 9 * 128; o += NWAVES * 64) { const int r = o >> 7, cc = o & 127; float s = args.in[I_BMOD][l * NMOD + col0 + cc];
                    for (int q = 0; q < 16; ++q) s += red[(q * 9 + r) * 128 + cc];
                    MOD[(size_t)(l * 9 + r) * NMOD + col0 + cc] = s; }
                __syncthreads();
            }
        }
        { const int first = G >= 128 ? 96 : 0, nb_ = G >= 128 ? 32 : G;
          if ((int)blockIdx.x >= first && (int)blockIdx.x < first + nb_) { __syncthreads();
            for (int g5 = (int)blockIdx.x - first; g5 < 32; g5 += nb_)
                s5_tables_item(lds, g5, args.in[I_S5ARE], args.in[I_S5AIM], args.in[I_S5DT], args.in[I_S5BRE], args.in[I_S5BIM], args.in[I_S5CRE], args.in[I_S5CIM], Bc, Ws5); } }
        const int gt = gw * 64 + lane, NT = NGW * 64;
        for (int i = gt; i < SEQL * 32; i += NT) { const int t = i >> 5, dd = i & 31; const float inv = powf(10000.0f, -(float)(dd & 15) / 16.0f);
            const float a = (dd < 16 ? (float)(t >> 6) : (float)(t & 63)) * inv; CS[2 * i] = cosf(a); CS[2 * i + 1] = sinf(a); }
        for (int i = gt; i < 2 * 32 * 64; i += NT) {
            const float dt = expf(args.in[I_S5DT][i >> 6]); const float are = args.in[I_S5ARE][i], aim = args.in[I_S5AIM][i];
            const float mag = expf(are * dt), ang = aim * dt; const float abr = mag * cosf(ang), abi = mag * sinf(ang);
            const float nr = abr - 1.0f, ni = abi, den = are * are + aim * aim; const float fr = (nr * are + ni * aim) / den, fi = (ni * are - nr * aim) / den;
            AB[i] = (f32x2){abr, abi}; (void)fr; (void)fi;
        }
        for (int i = gt; i < 2 * 1024; i += NT) { const int d = i >> 10, j = i & 1023; const float x0 = args.in[I_HGLB][(d * 2 + 0) * 1024 + j], x1 = args.in[I_HGLB][(d * 2 + 1) * 1024 + j];
            const float mx = fmaxf(x0, x1), e0 = expf(x0 - mx), e1 = expf(x1 - mx); const float g0 = e0 / (e0 + e1), g1 = e1 / (e0 + e1); LB[i] = (g0 + g1) - g0; }
    }
    GRID_BAR();
    norm_mod_rows(args.in[I_X], args.in[I_CTX], MT, args.in[I_NMIX], MOD, 0, DM, XN, gw, NGW, lane);
    GRID_BAR();
    { pg8::Gemm g{XN, Win0, MT, 2048, 1024, 1024, 1024}; pg8::StaticOrder S; S.init(MT, 2048, G, (int)blockIdx.x); EpiProj0 E{P0b, CS, UA};
      pg8::gemm_phase<EpiProj0, pg8::StaticOrder, true, true>(lds + RING_OFF, g, S, E); }
    GRID_BAR();
    { pg8::Gemm g{UA, Ws5, 32 * S5RP, 32 * 256, 512, S5K, 512}; pg8::BatchOrder S; S.init(32, 5, 1, G, (int)blockIdx.x); EpiHloc E{HLOC};
      pg8::gemm_phase<EpiHloc, pg8::BatchOrder, true, true>(lds + RING_OFF, g, S, E);
      __syncthreads();
      for (int it = (int)blockIdx.x; it < 32 * RCH; it += G) ret_passA_item(lds, it, P0b, args.in[I_RETL], ULOC); }
    GRID_BAR();
    s5_scan(HLOC, UA, AB, gw, NGW, lane);
    ret_scan(ULOC, SIN, args.in[I_RETL], gw * 64 + lane, NGW * 64);
    GRID_BAR();
    { pg8::Gemm g{UA, Bc, 32 * S5RP, 32 * 512, S5K, S5K, S5K}; pg8::BatchOrder S; S.init(32, 5, 2, G, (int)blockIdx.x); EpiS5Out E{UA, args.in[I_S5D], Yb};
      pg8::gemm_phase<EpiS5Out, pg8::BatchOrder, true, true>(lds + RING_OFF, g, S, E);
      __syncthreads();
      for (int it = (int)blockIdx.x; it < 32 * RCH; it += G) ret_passC_item(lds, it, P0b, args.in[I_RETL], SIN, RZ); }
    GRID_BAR();
    { pg8::Gemm g{Yb, Wglu, MT, 512, 512, 512, 512}; pg8::StaticOrder S; S.init(MT, 512, G, (int)blockIdx.x); EpiGlu E{Yb, args.in[I_S5BGLU], RZ + 512};
      pg8::gemm_phase<EpiGlu, pg8::StaticOrder, true, true>(lds + RING_OFF, g, S, E); }
    GRID_BAR();
    { pg8::Gemm g{RZ, Wout0, MT, 1024, 1024, 1024, 1024}; pg8::StaticOrder S; S.init(MT, 1024, G, (int)blockIdx.x); EpiResid E{args.in[I_X], args.in[I_CTX], OUT, HC, MOD + 2 * DM};
      pg8::gemm_phase<EpiResid, pg8::StaticOrder, true, true>(lds + RING_OFF, g, S, E); }
    GRID_BAR();
    norm_mod_rows(OUT, HC, MT, args.in[I_NMLP], MOD, 3 * DM, 4 * DM, XN, gw, NGW, lane);
    GRID_BAR();
    { pg8::Gemm g{XN, W1t0, MT, DFF, 1024, 1024, 1024}; pg8::StaticOrder S; S.init(MT, DFF, G, (int)blockIdx.x); EpiSqrelu E{Hb};
      pg8::gemm_phase<EpiSqrelu, pg8::StaticOrder, true, true>(lds + RING_OFF, g, S, E); }
    GRID_BAR();
    { pg8::Gemm g{Hb, W2t0, MT, 1024, DFF, DFF, DFF}; pg8::StaticOrder S; S.init(MT, 1024, G, (int)blockIdx.x); EpiResid E{OUT, HC, OUT, HC, MOD + 5 * DM};
      pg8::gemm_phase<EpiResid, pg8::StaticOrder, true, true>(lds + RING_OFF, g, S, E); }
    GRID_BAR();
    const float* MOD1 = MOD + (size_t)9 * NMOD;
    norm_mod_rows(OUT, HC, MT, args.in[I_NMIX] + DM, MOD1, 0, DM, XN, gw, NGW, lane);
    GRID_BAR();
    { pg8::Gemm g{XN, Whg, MT, 5120, 1024, 1024, 1024}; pg8::StaticOrder S; S.init(MT, 5120, G, (int)blockIdx.x); EpiProj1 E{P1b, LB};
      pg8::gemm_phase<EpiProj1, pg8::StaticOrder, true, true>(lds + RING_OFF, g, S, E); }
    GRID_BAR();
    for (int i = blockIdx.x; i < 256; i += G) hgrn_item(lds, i, P1b, OS, ws);
    GRID_BAR();
    merge1_rows(OS, ws, P1b, args.in[I_HGNORM], gw, NGW, lane);
    GRID_BAR();
    { pg8::Gemm g{OS, Whgo, ML, 1024, 1024, 1024, 1024}; pg8::StaticOrder S; S.init(ML, 1024, G, (int)blockIdx.x); EpiResid E{OUT, HC, OUT, HC, MOD1 + 2 * DM};
      pg8::gemm_phase<EpiResid, pg8::StaticOrder, true, true>(lds + RING_OFF, g, S, E); }
    GRID_BAR();
    norm_mod_rows(OUT, HC, ML, args.in[I_NMLP] + DM, MOD1, 3 * DM, 4 * DM, XN, gw, NGW, lane);
    GRID_BAR();
    { pg8::Gemm g{XN, W1t1, ML, DFF, 1024, 1024, 1024}; pg8::StaticOrder S; S.init(ML, DFF, G, (int)blockIdx.x); EpiSqrelu E{Hb};
      pg8::gemm_phase<EpiSqrelu, pg8::StaticOrder, true, true>(lds + RING_OFF, g, S, E); }
    GRID_BAR();
    { pg8::Gemm g{Hb, W2t1, ML, 1024, DFF, DFF, DFF}; pg8::StaticOrder S; S.init(ML, 1024, G, (int)blockIdx.x); EpiResid E{OUT, HC, OUT, HC, MOD1 + 5 * DM};
      pg8::gemm_phase<EpiResid, pg8::StaticOrder, true, true>(lds + RING_OFF, g, S, E); }
    GRID_BAR();
    final_norm_rows(OUT, args.in[I_NFIN], gw, NGW, lane);
}

extern "C" void kernel_launch(void* const* d_in, const int* in_sizes, int n_in, void* d_out, int out_size, void* d_ws, size_t ws_size, hipStream_t stream) {
    static int grid = 0;
    if (grid == 0) {
        if (n_in != 28 || in_sizes[0] != ML * DM || out_size != ML * DM || ws_size < WS_END) { fprintf(stderr, "kernel_launch: unexpected shapes (n_in %d, in0 %d, out %d, ws %zu)\n", n_in, n_in > 0 ? in_sizes[0] : -1, out_size, ws_size); grid = -1; return; }
        int dev = 0, cus = 0, per_cu = 0;
        if (hipGetDevice(&dev) != hipSuccess || hipDeviceGetAttribute(&cus, hipDeviceAttributeMultiprocessorCount, dev) != hipSuccess) { grid = -1; return; }
        if (hipFuncSetAttribute((const void*)mk_fwd, hipFuncAttributeMaxDynamicSharedMemorySize, LDS_BYTES) != hipSuccess) { fprintf(stderr, "kernel_launch: hipFuncSetAttribute failed\n"); grid = -1; return; }
        if (hipOccupancyMaxActiveBlocksPerMultiprocessor(&per_cu, (const void*)mk_fwd, NWAVES * 64, LDS_BYTES) != hipSuccess || per_cu < 1) { fprintf(stderr, "kernel_launch: occupancy query says %d blocks per CU\n", per_cu); }
        (void)hipGetLastError();
        grid = cus;
    }
    if (grid < 0) return;
    if (hipMemsetAsync((char*)d_ws + WS_CTL, 0, CTL_ZERO_BYTES, stream) != hipSuccess) return;
    Args a{};
    for (int i = 0; i < 28; ++i) a.in[i] = (const float*)d_in[i];
    a.out = (float*)d_out; a.ws = (unsigned char*)d_ws;
    hipLaunchKernelGGL(mk_fwd, dim3(grid), dim3(NWAVES * 64), LDS_BYTES, stream, a);
}
```

```cpp
#include <hip/hip_runtime.h>
#include <cstdio>
#include <cstdint>

namespace pg8 {
#define PG8_LAS __attribute__((address_space(3)))
typedef unsigned short bf16_t;
typedef short bf16x8 __attribute__((ext_vector_type(8)));
typedef float f32x4 __attribute__((ext_vector_type(4)));
typedef unsigned u32x4 __attribute__((ext_vector_type(4)));
constexpr int BM = 256, BK = 64, HALF = 128, HTB = HALF * BK * 2, STAGE_BYTES = 8 * HTB, NXCD = 8, WGM = 8;

__host__ __device__ __forceinline__ int lds_byte(int r, int c) { const int st = (r >> 4) * 2 + (c >> 5), rr = r & 15, cc = c & 31, ob = rr * 64 + cc * 2; return st * 1024 + (ob ^ (((ob >> 9) & 1) << 5)); }
__host__ __device__ __forceinline__ void stage_rc(int b, int& R, int& C) { const int st = b / 1024, sb = b % 1024, swz = sb ^ (((sb >> 9) & 1) << 5); R = (st >> 1) * 16 + swz / 64; C = (st & 1) * 32 + (swz % 64) / 2; }
__host__ __device__ __forceinline__ int perm32(int rho) { const int n = rho >> 4, i = rho & 15; return 8 * (i >> 2) + 4 * n + (i & 3); }

struct Unit { int pm, pn; };
struct Gemm { const bf16_t* A; const bf16_t* Bt; int M, N, K, lda, ldb; };

struct StaticOrder {
    int nM, nN, nwg, G, c;
    __host__ __device__ void init(int M, int N, int G_, int c_) { nM = M / BM; nN = N / BM; nwg = nM * nN; G = G_; c = c_; }
    __host__ __device__ bool next(int i, Unit& u) const {
        const long L = (long)i * G + c; if (L >= nwg) return false;
        int wgid = (int)L; { const int q = nwg / NXCD, r = nwg % NXCD, xcd = wgid % NXCD, off = wgid / NXCD; wgid = (xcd < r ? xcd * (q + 1) : r * (q + 1) + (xcd - r) * q) + off; }
        const int nig = WGM * nN, gid = wgid / nig, fm = gid * WGM, gsz = (nM - fm) < WGM ? (nM - fm) : WGM;
        u.pm = fm + ((wgid % nig) % gsz); u.pn = (wgid % nig) / gsz; return true;
    }
    __device__ __forceinline__ void a_ready(const Unit&) const {}
    __device__ __forceinline__ void done(const Unit&) const {}
};

struct BatchOrder {
    int nb, tm, tn, G, c;
    __host__ __device__ void init(int nb_, int tm_, int tn_, int G_, int c_) { nb = nb_; tm = tm_; tn = tn_; G = G_; c = c_; }
    __host__ __device__ bool next(int i, Unit& u) const {
        const long L = (long)i * G + c; if (c < 0 || L >= (long)nb * tm * tn) return false;
        const int per = tm * tn, g = (int)L / per, rem = (int)L % per;
        u.pm = g * tm + rem % tm; u.pn = g * tn + rem / tm; return true;
    }
    __device__ __forceinline__ void a_ready(const Unit&) const {}
    __device__ __forceinline__ void done(const Unit&) const {}
};

__device__ __forceinline__ unsigned cvt_pk_bf16(float lo, float hi) { unsigned r; asm volatile("v_cvt_pk_bf16_f32 %0, %1, %2" : "=v"(r) : "v"(lo), "v"(hi)); return r; }

template <class Epi, class Sched, bool ALIGN_EPI = false, bool SP2 = false>
__device__ __forceinline__ void gemm_phase(PG8_LAS unsigned char* lds, const Gemm g, const Sched& S, const Epi& E) {
    int tid_ = threadIdx.x; asm volatile("" : "+v"(tid_));
    const int tid = tid_, wid = __builtin_amdgcn_readfirstlane(tid >> 6), lane = tid & 63, wr = wid >> 2, wc = wid & 3, fr = lane & 15, fq = lane >> 4;
    const int K = g.K, nt = K / BK;
    unsigned voffA[2], voffB[2];
#pragma unroll
    for (int i = 0; i < 2; ++i) { int R, C; stage_rc(tid * 16 + i * 8192, R, C); const int Rb = Epi::PERM ? ((R & ~31) + perm32(R & 31)) : R;
        voffA[i] = (unsigned)(R * g.lda + C) * 2u; voffB[i] = (unsigned)(Rb * g.ldb + C) * 2u; }
    const size_t kstep = (size_t)(BK * 2);
    const size_t hstepA = (size_t)HALF * g.lda * 2, hstepB = (size_t)HALF * g.ldb * 2;
    const size_t tstepA = 2 * hstepA, tstepB = 2 * hstepB;
    const unsigned ldsw = (unsigned)wid * 1024u;
    const int aoff = lds_byte(wr * 64 + fr, fq * 8), boff = lds_byte(wc * 32 + fr, fq * 8);
#define PG8_SA(b, h) (((b) * 2 + (h)) * HTB)
#define PG8_SB(b, h) ((4 + (b) * 2 + (h)) * HTB)
#define PG8_STAGE(bufoff, gbase, voff) do { _Pragma("unroll") for (int _i = 0; _i < 2; ++_i) \
        __builtin_amdgcn_global_load_lds((const unsigned*)((const char*)(gbase) + (voff)[_i]), (PG8_LAS unsigned*)(lds + (bufoff) + ldsw + _i * 8192), 16, 0, 0); } while (0)
#define PG8_LDA(dst, b, h) do { _Pragma("unroll") for (int m = 0; m < 4; ++m) _Pragma("unroll") for (int k = 0; k < 2; ++k) dst[m][k] = *(const PG8_LAS bf16x8*)(lds + PG8_SA(b, h) + aoff + m * 2048 + k * 1024); } while (0)
#define PG8_LDB(dst, b, h) do { _Pragma("unroll") for (int n = 0; n < 2; ++n) _Pragma("unroll") for (int k = 0; k < 2; ++k) dst[n][k] = *(const PG8_LAS bf16x8*)(lds + PG8_SB(b, h) + boff + n * 2048 + k * 1024); } while (0)
#define PG8_MMA(ai, bj, At, Bt) do { __builtin_amdgcn_s_setprio(1); _Pragma("unroll") for (int m = 0; m < 4; ++m) _Pragma("unroll") for (int n = 0; n < 2; ++n) _Pragma("unroll") for (int k = 0; k < 2; ++k) \
        acc[ai][bj][m][n] = __builtin_amdgcn_mfma_f32_16x16x32_bf16(Bt[n][k], At[m][k], acc[ai][bj][m][n], 0, 0, 0); __builtin_amdgcn_s_setprio(0); } while (0)
#define PG8_WAIT_V(n) asm volatile("s_waitcnt vmcnt(" #n ")" ::: "memory")
#define PG8_WAIT_L(n) asm volatile("s_waitcnt lgkmcnt(" #n ")" ::: "memory")
#define PG8_BAR __builtin_amdgcn_s_barrier()
#define PG8_SCHED __builtin_amdgcn_sched_barrier(0)
    Unit cur, nxt; int ui = 0;
    if (!S.next(0, cur)) return;
    f32x4 acc[2][2][4][2];
#pragma unroll
    for (int a = 0; a < 2; ++a)
#pragma unroll
        for (int b = 0; b < 2; ++b)
#pragma unroll
            for (int m = 0; m < 4; ++m)
#pragma unroll
                for (int n = 0; n < 2; ++n) acc[a][b][m][n] = (f32x4){0.f, 0.f, 0.f, 0.f};
    bf16x8 At[4][2], B0[2][2], B1[2][2];
    const char* cA = (const char*)g.A + (size_t)cur.pm * tstepA; const char* cB = (const char*)g.Bt + (size_t)cur.pn * tstepB;
    S.a_ready(cur);
    if constexpr (SP2) {
        PG8_STAGE(PG8_SB(0, 0), cB, voffB); PG8_STAGE(PG8_SB(0, 1), cB + hstepB, voffB); PG8_STAGE(PG8_SA(0, 0), cA, voffA); PG8_STAGE(PG8_SA(0, 1), cA + hstepA, voffA);
        if (wr == 1) PG8_BAR;
        PG8_WAIT_V(2); PG8_BAR;
        PG8_STAGE(PG8_SB(1, 0), cB + kstep, voffB); PG8_STAGE(PG8_SA(1, 0), cA + kstep, voffA); PG8_STAGE(PG8_SB(1, 1), cB + hstepB + kstep, voffB);
        PG8_WAIT_V(6); PG8_BAR;
    } else {
        PG8_STAGE(PG8_SB(0, 0), cB, voffB); PG8_STAGE(PG8_SA(0, 0), cA, voffA); PG8_STAGE(PG8_SB(0, 1), cB + hstepB, voffB); PG8_STAGE(PG8_SA(0, 1), cA + hstepA, voffA);
        if (wr == 1) PG8_BAR;
        PG8_WAIT_V(4); PG8_BAR;
        PG8_STAGE(PG8_SB(1, 0), cB + kstep, voffB); PG8_STAGE(PG8_SA(1, 0), cA + kstep, voffA); PG8_STAGE(PG8_SB(1, 1), cB + hstepB + kstep, voffB);
        PG8_WAIT_V(6); PG8_BAR;
    }
    for (;;) {
        const bool has_next = S.next(ui + 1, nxt);
        const char* nA = has_next ? (const char*)g.A + (size_t)nxt.pm * tstepA : cA; const char* nB = has_next ? (const char*)g.Bt + (size_t)nxt.pn * tstepB : cB;
        for (int t = 0; t < nt; t += 2) {
            const bool last = (t == nt - 2);
            const char* a1 = cA + (size_t)(t + 1) * kstep;
            const char* a2 = last ? nA : cA + (size_t)(t + 2) * kstep; const char* b2 = last ? nB : cB + (size_t)(t + 2) * kstep;
            const char* a3 = a2 + kstep; const char* b3 = b2 + kstep;
            if (last && has_next) S.a_ready(nxt);
            if constexpr (SP2) {
            PG8_LDB(B0, 0, 0); PG8_LDB(B1, 0, 1); PG8_SCHED; PG8_LDA(At, 0, 0); PG8_STAGE(PG8_SA(1, 1), a1 + hstepA, voffA);
            PG8_WAIT_V(8); PG8_WAIT_L(0); PG8_BAR; PG8_MMA(0, 0, At, B0); PG8_MMA(0, 1, At, B1); PG8_BAR; PG8_SCHED;
            PG8_LDA(At, 0, 1); PG8_STAGE(PG8_SB(0, 0), b2, voffB); PG8_STAGE(PG8_SB(0, 1), b2 + hstepB, voffB); PG8_STAGE(PG8_SA(0, 0), a2, voffA);
            PG8_WAIT_V(8); PG8_WAIT_L(0); PG8_BAR; PG8_MMA(1, 0, At, B0); PG8_MMA(1, 1, At, B1); PG8_BAR; PG8_SCHED;
            PG8_LDB(B0, 1, 0); PG8_LDB(B1, 1, 1); PG8_SCHED; PG8_LDA(At, 1, 0); PG8_STAGE(PG8_SA(0, 1), a2 + hstepA, voffA);
            PG8_WAIT_V(8); PG8_WAIT_L(0); PG8_BAR; PG8_MMA(0, 0, At, B0); PG8_MMA(0, 1, At, B1); PG8_BAR; PG8_SCHED;
            PG8_LDA(At, 1, 1); PG8_STAGE(PG8_SB(1, 0), b3, voffB); PG8_STAGE(PG8_SB(1, 1), b3 + hstepB, voffB); PG8_STAGE(PG8_SA(1, 0), a3, voffA);
            PG8_WAIT_V(8); PG8_WAIT_L(0); PG8_BAR; PG8_MMA(1, 0, At, B0); PG8_MMA(1, 1, At, B1); PG8_BAR; PG8_SCHED;
            } else {
            PG8_LDB(B0, 0, 0); PG8_SCHED; PG8_LDA(At, 0, 0); PG8_STAGE(PG8_SA(1, 1), a1 + hstepA, voffA);
            PG8_WAIT_L(8); PG8_BAR; PG8_WAIT_L(0); PG8_MMA(0, 0, At, B0); PG8_BAR; PG8_SCHED;
            PG8_LDB(B1, 0, 1); PG8_STAGE(PG8_SB(0, 0), b2, voffB);
            PG8_BAR; PG8_WAIT_L(0); PG8_MMA(0, 1, At, B1); PG8_BAR;
            PG8_LDA(At, 0, 1); PG8_STAGE(PG8_SA(0, 0), a2, voffA);
            PG8_BAR; PG8_WAIT_L(0); PG8_MMA(1, 0, At, B0); PG8_BAR; PG8_SCHED;
            PG8_STAGE(PG8_SB(0, 1), b2 + hstepB, voffB);
            PG8_WAIT_V(6); PG8_BAR; PG8_MMA(1, 1, At, B1); PG8_BAR;
            PG8_LDB(B0, 1, 0); PG8_SCHED; PG8_LDA(At, 1, 0); PG8_STAGE(PG8_SA(0, 1), a2 + hstepA, voffA);
            PG8_WAIT_L(8); PG8_BAR; PG8_WAIT_L(0); PG8_MMA(0, 0, At, B0); PG8_BAR; PG8_SCHED;
            PG8_LDB(B1, 1, 1); PG8_STAGE(PG8_SB(1, 0), b3, voffB);
            PG8_BAR; PG8_WAIT_L(0); PG8_MMA(0, 1, At, B1); PG8_BAR;
            PG8_LDA(At, 1, 1); PG8_STAGE(PG8_SA(1, 0), a3, voffA);
            PG8_BAR; PG8_WAIT_L(0); PG8_MMA(1, 0, At, B0); PG8_BAR; PG8_SCHED;
            PG8_STAGE(PG8_SB(1, 1), b3 + hstepB, voffB);
            PG8_WAIT_V(6); PG8_BAR; PG8_MMA(1, 1, At, B1); PG8_BAR;
            }
        }
        if constexpr (ALIGN_EPI) { if (wr == 0) PG8_BAR; }
        if constexpr (!Epi::AFTER_DRAIN) { E(acc, cur, wr, wc, fr, fq); S.done(cur); }
        if (!has_next) break;
#pragma unroll
        for (int a = 0; a < 2; ++a)
#pragma unroll
            for (int b = 0; b < 2; ++b)
#pragma unroll
                for (int m = 0; m < 4; ++m)
#pragma unroll
                    for (int n = 0; n < 2; ++n) acc[a][b][m][n] = (f32x4){0.f, 0.f, 0.f, 0.f};
        cur = nxt; cA = nA; cB = nB; ++ui;
        if constexpr (ALIGN_EPI) { if (wr == 1) PG8_BAR; }
    }
    PG8_WAIT_V(0);
    if constexpr (!ALIGN_EPI) { if (wr == 0) PG8_BAR; }
    PG8_BAR;
#undef PG8_SA
#undef PG8_SB
#undef PG8_STAGE
#undef PG8_LDA
#undef PG8_LDB
#undef PG8_MMA
#undef PG8_WAIT_V
#undef PG8_WAIT_L
#undef PG8_BAR
#undef PG8_SCHED
}
}

#define GAS __attribute__((address_space(1)))
#define LAS __attribute__((address_space(3)))
typedef unsigned short bf16;
typedef unsigned v4u __attribute__((ext_vector_type(4)));
typedef unsigned v2u __attribute__((ext_vector_type(2)));
typedef float f32x4 __attribute__((ext_vector_type(4)));
typedef float f32x2 __attribute__((ext_vector_type(2)));

constexpr int NWAVES = 8;
constexpr int DM = 1024, NBATCH = 8, SEQL = 4096, CTXL = 256, DFF = 4096;
constexpr int ML = NBATCH * SEQL;
constexpr int MC = NBATCH * CTXL;
constexpr int MT = ML + MC;
constexpr int NMOD = 6 * DM;
constexpr float EPSN = 1e-6f;

constexpr size_t MiB = 1u << 20;
constexpr size_t WS_CTL = 0, CTL_ZERO_BYTES = 1 * MiB;
constexpr size_t WS_MOD = 1 * MiB;
constexpr size_t WS_CS = 2 * MiB;
constexpr size_t WS_S5T = 3 * MiB;
constexpr size_t WS_S5T_BB = WS_S5T + 32768, WS_LB = WS_S5T_BB + 524288;
constexpr size_t WS_HC = 4 * MiB;
constexpr size_t WS_WIN0 = 12 * MiB, WS_WOUT0 = 16 * MiB, WS_WGLU = 18 * MiB, WS_W1_0 = 19 * MiB, WS_W2_0 = 27 * MiB, WS_W1_1 = 35 * MiB, WS_W2_1 = 43 * MiB, WS_WHG = 51 * MiB, WS_WHGO = 61 * MiB;
__host__ __device__ __forceinline__ size_t ws_ob(int b) { return b < 5 ? 472 * MiB + (size_t)b * 8 * MiB : (b < 7 ? 12 * MiB + (size_t)(b - 5) * 8 * MiB : 4 * MiB); }
constexpr size_t WS_XN = 64 * MiB;
constexpr size_t WS_BIG = 132 * MiB;
constexpr int P0LD = 1536;
constexpr size_t WS_P0 = WS_BIG;
constexpr int S5R = 1088, S5RP = 1280, S5K = 768;
constexpr size_t WS_UA = WS_BIG + 102 * MiB;
constexpr size_t WS_BC = WS_BIG + 162 * MiB;
constexpr size_t WS_WS5 = WS_BIG + 186 * MiB;
constexpr size_t WS_ULOC = WS_BIG + 194 * MiB;
constexpr size_t WS_SIN = WS_BIG + 228 * MiB;
constexpr size_t WS_RZ = WS_BIG + 262 * MiB;
constexpr size_t WS_HLOC = WS_XN;
constexpr size_t WS_H = WS_BIG;
constexpr size_t WS_P1 = WS_BIG;
constexpr size_t WS_Y = 472 * MiB;
constexpr size_t WS_END = 512 * MiB;

constexpr int CW_BAR = 4096;

constexpr int RING_OFF = 0, RING_BYTES = 131072;
constexpr int LDSCTL_OFF = 143360, MISC_OFF = LDSCTL_OFF + 320;
constexpr int LDS_BYTES = 147456;

typedef GAS unsigned gu32;
#define LDS_WAIT() asm volatile("s_waitcnt lgkmcnt(0)" ::: "memory")
typedef __bf16 hwbf2 __attribute__((ext_vector_type(2)));
__device__ __forceinline__ unsigned pk2(float lo, float hi) { hwbf2 v; v.x = (__bf16)lo; v.y = (__bf16)hi; return __builtin_bit_cast(unsigned, v); }
__device__ __forceinline__ unsigned f2bf(float f) { return (unsigned)__builtin_bit_cast(unsigned short, (__bf16)f); }
__device__ __forceinline__ float bflo(unsigned w) { return __builtin_bit_cast(float, w << 16); }
__device__ __forceinline__ float bfhi(unsigned w) { return __builtin_bit_cast(float, w & 0xffff0000u); }
__device__ __forceinline__ float bf2f(bf16 h) { return __builtin_bit_cast(float, (unsigned)h << 16); }
typedef _Float16 h16x2 __attribute__((ext_vector_type(2)));
__device__ __forceinline__ unsigned pk_f16(float a, float b) { h16x2 v; v.x = (_Float16)a; v.y = (_Float16)b; return __builtin_bit_cast(unsigned, v); }
__device__ __forceinline__ float f16lo(unsigned w) { h16x2 v = __builtin_bit_cast(h16x2, w); return (float)v.x; }
__device__ __forceinline__ float f16hi(unsigned w) { h16x2 v = __builtin_bit_cast(h16x2, w); return (float)v.y; }
__device__ __forceinline__ float sigmoidf_(float x) { return 1.0f / (1.0f + __expf(-x)); }
__device__ __forceinline__ float siluf_(float x) { return x / (1.0f + __expf(-x)); }
__device__ __forceinline__ float gelu_tanh(float x) { const float u = 0.7978845608028654f * (x + 0.044715f * x * x * x); return 0.5f * x * (1.0f + tanhf(u)); }

#define XB_TMO      128
#define XB_XCNT(j)  (256  + 64 * (j))
#define XB_XSUB(j)  (1280 + 64 * (j))
#define XB_XGEN(j)  (2304 + 64 * (j))
#define XB_TOP      3328
#define XB_TOPGEN   3392
#define XCD_BAR_WORDS 3456
#define XB_SPIN_CAP (1u << 22)
__device__ __forceinline__ unsigned xb_ld(unsigned* p)              { return __hip_atomic_load(p, __ATOMIC_RELAXED, __HIP_MEMORY_SCOPE_AGENT); }
__device__ __forceinline__ unsigned xb_add(unsigned* p, unsigned v) { return __hip_atomic_fetch_add(p, v, __ATOMIC_RELAXED, __HIP_MEMORY_SCOPE_AGENT); }
__device__ __forceinline__ unsigned xb_xcc_id() { return (unsigned)__builtin_amdgcn_s_getreg((3 << 11) | 20) & 0xFu; }
#define XB_SPIN(cond, bar) do { unsigned _sp = 0; while (cond) { __builtin_amdgcn_s_sleep(1); \
    if ((++_sp & 255u) == 0u) { if (xb_ld(&(bar)[XB_TMO])) break; if (_sp > XB_SPIN_CAP) { atomicAdd(&(bar)[XB_TMO], 1u); break; } } } } while (0)
struct XcdBarrier { unsigned* bar; unsigned x; volatile LAS unsigned* st; };
__device__ __forceinline__ XcdBarrier xcd_barrier_post(unsigned* bar, volatile LAS unsigned* st) {
    XcdBarrier b; b.bar = bar; b.x = xb_xcc_id(); b.st = st;
    if (threadIdx.x == 0) (void)xb_add(&bar[XB_XCNT(b.x)], 1u);
    return b;
}
__device__ __forceinline__ void xcd_barrier_complete(unsigned* bar, unsigned x, unsigned& nloc, unsigned& nx) {
    const unsigned G = gridDim.x * gridDim.y * gridDim.z;
    unsigned sum, cnt, mine, sp = 0u;
    for (;;) {
        sum = 0u; cnt = 0u; mine = 0u;
#pragma unroll
        for (unsigned j = 0; j < 16; ++j) { const unsigned c = xb_ld(&bar[XB_XCNT(j)]); sum += c; cnt += (c > 0u) ? 1u : 0u; mine = (j == x) ? c : mine; }
        if (sum == G) break;
        __builtin_amdgcn_s_sleep(1);
        if ((++sp & 255u) == 0u) { if (xb_ld(&bar[XB_TMO])) break; if (sp > XB_SPIN_CAP) { atomicAdd(&bar[XB_TMO], 1u); break; } }
    }
    nloc = mine > 0u ? mine : 1u; nx = cnt > 0u ? cnt : 1u;
}
__device__ __forceinline__ void xcd_barrier(const XcdBarrier& b) {
    asm volatile("s_waitcnt vmcnt(0)" ::: "memory");
    __syncthreads();
    if (threadIdx.x == 0) {
        unsigned* bar = b.bar;
        __builtin_amdgcn_s_waitcnt(0);
        unsigned nloc = b.st[0], nx = b.st[1];
        if (nloc == 0u) { xcd_barrier_complete(bar, b.x, nloc, nx); b.st[0] = nloc; b.st[1] = nx; }
        const unsigned old = xb_add(&bar[XB_XSUB(b.x)], 1u);
        const unsigned gen = old / nloc;
        if (old + 1u == (gen + 1u) * nloc) {
            __builtin_amdgcn_fence(__ATOMIC_RELEASE, "agent");
            asm volatile("s_waitcnt vmcnt(0)" ::: "memory");
            const unsigned og = xb_add(&bar[XB_TOP], 1u);
            const unsigned tg = og / nx;
            if (og + 1u == (tg + 1u) * nx) xb_add(&bar[XB_TOPGEN], 1u);
            else XB_SPIN(xb_ld(&bar[XB_TOPGEN]) == tg, bar);
            __builtin_amdgcn_fence(__ATOMIC_ACQUIRE, "agent");
            xb_add(&bar[XB_XGEN(b.x)], 1u);
            asm volatile("s_waitcnt vmcnt(0)" ::: "memory");
        } else {
            XB_SPIN(xb_ld(&bar[XB_XGEN(b.x)]) == gen, bar);
            __builtin_amdgcn_fence(__ATOMIC_ACQUIRE, "agent");
            asm volatile("s_waitcnt vmcnt(0)" ::: "memory");
        }
    }
    __syncthreads();
}

__device__ __forceinline__ float wave_sum(float v) {
#pragma unroll
    for (int o = 1; o < 64; o <<= 1) v += __shfl_xor(v, o);
    return v;
}
__device__ __forceinline__ float sum16(float v) {
#pragma unroll
    for (int o = 1; o < 16; o <<= 1) v += __shfl_xor(v, o);
    return v;
}

__device__ __forceinline__ int rowof(int n, int b, int dir) {
    if (n < CTXL) { const int tc = dir ? (CTXL - 1 - n) : n; return ML + b * CTXL + tc; }
    const int tl = n - CTXL; const int t = dir ? (SEQL - 1 - tl) : tl; return b * SEQL + t;
}

__device__ __forceinline__ int permqk(int n) {
    const int d = n & 63, half = d >> 5, dd = d & 31, i = dd >> 2, j = dd & 3; return (n & ~63) + 8 * i + 4 * half + j;
}
template <bool PERMQK>
__device__ __forceinline__ void p0_transpose_item(const float* W, int K, int N, bf16* WT, LAS float* scr, int item, int lane) {
    const int nblk = N / 32, kb = item / nblk, nb = item % nblk, k0 = 64 * kb, n0 = 32 * nb;
#pragma unroll 8
    for (int i = 0; i < 32; ++i) { const int kk = 2 * i + (lane >> 5); scr[kk * 33 + (lane & 31)] = W[(size_t)(k0 + kk) * N + n0 + (lane & 31)]; }
    LDS_WAIT(); asm volatile("" ::: "memory");
    const int c = lane & 7;
#pragma unroll
    for (int j = 0; j < 4; ++j) { const int n = (lane >> 3) + 8 * j; const LAS float* s = scr + (8 * c) * 33 + n;
        v4u o; o.x = pk2(s[0 * 33], s[1 * 33]); o.y = pk2(s[2 * 33], s[3 * 33]); o.z = pk2(s[4 * 33], s[5 * 33]); o.w = pk2(s[6 * 33], s[7 * 33]);
        int nd = n0 + n; if (PERMQK && nd < 512) nd = permqk(nd);
        *(GAS v4u*)(WT + (size_t)nd * K + k0 + 8 * c) = o; }
    LDS_WAIT(); asm volatile("" ::: "memory");
}

__device__ __forceinline__ void norm_mod_rows(const float* hl, const float* hc, int nrows, const float* g, const float* mod, int shift_off, int scale_off, bf16* XN, int gw, int NGW, int lane) {
    for (int row = gw; row < nrows; row += NGW) {
        const float* xr = row < ML ? hl + (size_t)row * DM : hc + (size_t)(row - ML) * DM;
        const int mr = row < ML ? (row >> 12) : 8;
        const f32x4* x4 = (const f32x4*)xr + lane;
        f32x4 v[4]; float s = 0.f;
#pragma unroll
        for (int j = 0; j < 4; ++j) { v[j] = x4[64 * j]; s += (v[j].x * v[j].x + v[j].y * v[j].y) + (v[j].z * v[j].z + v[j].w * v[j].w); }
        const float rstd = 1.0f / sqrtf(wave_sum(s) * (1.f / DM) + EPSN);
        const f32x4* g4 = (const f32x4*)g + lane; const f32x4* sc4 = (const f32x4*)(mod + (size_t)mr * NMOD + scale_off) + lane; const f32x4* sh4 = (const f32x4*)(mod + (size_t)mr * NMOD + shift_off) + lane;
        unsigned long long* o8 = (unsigned long long*)(XN + (size_t)row * DM) + lane;
#pragma unroll
        for (int j = 0; j < 4; ++j) { const f32x4 gg = g4[64 * j], sc = sc4[64 * j], sh = sh4[64 * j];
            const f32x4 y = (v[j] * rstd) * gg * (sc + 1.0f) + sh;
            o8[64 * j] = (unsigned long long)pk2(y.x, y.y) | ((unsigned long long)pk2(y.z, y.w) << 32); }
    }
}
__device__ __forceinline__ void final_norm_rows(float* h, const float* g, int gw, int NGW, int lane) {
    for (int row = gw; row < ML; row += NGW) {
        f32x4* x4 = (f32x4*)(h + (size_t)row * DM) + lane;
        f32x4 v[4]; float s = 0.f;
#pragma unroll
        for (int j = 0; j < 4; ++j) { v[j] = x4[64 * j]; s += (v[j].x * v[j].x + v[j].y * v[j].y) + (v[j].z * v[j].z + v[j].w * v[j].w); }
        const float rstd = 1.0f / sqrtf(wave_sum(s) * (1.f / DM) + EPSN);
        const f32x4* g4 = (const f32x4*)g + lane;
#pragma unroll
        for (int j = 0; j < 4; ++j) x4[64 * j] = (v[j] * rstd) * g4[64 * j];
    }
}
__device__ __forceinline__ void unpack8(const v4u w, float (&o)[8]) { o[0] = bflo(w.x); o[1] = bfhi(w.x); o[2] = bflo(w.y); o[3] = bfhi(w.y); o[4] = bflo(w.z); o[5] = bfhi(w.z); o[6] = bflo(w.w); o[7] = bfhi(w.w); }
__device__ __forceinline__ v4u pack8(const float (&o)[8]) { v4u w; w.x = pk2(o[0], o[1]); w.y = pk2(o[2], o[3]); w.z = pk2(o[4], o[5]); w.w = pk2(o[6], o[7]); return w; }

__device__ __forceinline__ void merge1_rows(bf16* OS, const unsigned char* ws, const bf16* P1, const float* hgn, int gw, int NGW, int lane) {
    for (int row = gw; row < ML; row += NGW) {
#pragma unroll
        for (int half = 0; half < 2; ++half) {
            const int c0 = half * 512 + lane * 8;
            const v4u ow = *(const v4u*)(OS + (size_t)row * 1024 + c0), gw4 = *(const v4u*)(P1 + (size_t)row * 5120 + 4096 + c0);
            const v4u ob = *(const v4u*)((const bf16*)(ws + ws_ob(row >> 12)) + (size_t)(row & (SEQL - 1)) * 1024 + c0);
            const f32x4 n0 = *(const f32x4*)(hgn + (c0 & 127)), n1 = *(const f32x4*)(hgn + (c0 & 127) + 4);
            float o[8], gg[8], o2[8]; unpack8(ow, o); unpack8(gw4, gg); unpack8(ob, o2);
            float ss = 0.f;
#pragma unroll
            for (int i = 0; i < 8; ++i) o[i] += o2[i];
#pragma unroll
            for (int i = 0; i < 8; ++i) ss += o[i] * o[i];
            const float rs = 1.0f / sqrtf(sum16(ss) * (1.f / 128.f) + EPSN);
            const float nn[8] = {n0.x, n0.y, n0.z, n0.w, n1.x, n1.y, n1.z, n1.w};
            float r[8];
#pragma unroll
            for (int i = 0; i < 8; ++i) r[i] = o[i] * rs * nn[i] * siluf_(gg[i]);
            *(v4u*)(OS + (size_t)row * 1024 + c0) = pack8(r);
        }
    }
}

using pg8::Unit; using pg8::HALF; using pg8::BM;
__device__ __forceinline__ v4u pack2x4(const f32x4 v0, const f32x4 v1) { v4u w; w.x = pg8::cvt_pk_bf16(v0[0], v0[1]); w.y = pg8::cvt_pk_bf16(v0[2], v0[3]); w.z = pg8::cvt_pk_bf16(v1[0], v1[1]); w.w = pg8::cvt_pk_bf16(v1[2], v1[3]); return w; }

struct EpiProj0 {
    static constexpr bool PERM = true, AFTER_DRAIN = false;
    bf16* O; const float* CS; bf16* UA;
    __device__ __forceinline__ void operator()(const f32x4 (&acc)[2][2][4][2], const Unit& u, int wr, int wc, int fr, int fq) const {
        const int row0 = u.pm * BM + wr * 64 + fr, col0 = u.pn * BM + wc * 32 + 8 * fq;
        const bool lat = u.pm < ML / BM;
        const bool rope = (u.pn < 2) && lat; const float sc = (u.pn == 1) ? 0.125f : 1.0f;
        const bool isu = (u.pn == 4) || (u.pn == 5);
        const int ocol0 = (u.pn >= 6) ? col0 - 512 : col0;
        const int i4 = 4 * (4 * (wc & 1) + fq);
#pragma unroll
        for (int ai = 0; ai < 2; ++ai)
#pragma unroll
            for (int m = 0; m < 4; ++m) { const int row = row0 + ai * HALF + m * 16;
                f32x4 ca = (f32x4){1.f, 0.f, 1.f, 0.f}, cb = ca;
                if (rope) { const float* p = CS + ((size_t)(row & (SEQL - 1)) * 32 + i4) * 2; ca = *(const f32x4*)p; cb = *(const f32x4*)(p + 4); }
                bf16* rowp = O + (size_t)row * P0LD + ocol0;
                int r5, i5;
                if (lat) { const int t = row & (SEQL - 1); r5 = (row >> 12) * 136 + 8 + (t >> 5); i5 = t & 31; }
                else { const int rc = row - ML, t = rc & (CTXL - 1); r5 = (rc >> 8) * 136 + (t >> 5); i5 = t & 31; }
#pragma unroll
                for (int bj = 0; bj < 2; ++bj) { f32x4 v0 = acc[ai][bj][m][0], v1 = acc[ai][bj][m][1];
                    if (rope) {
                        const f32x4 lo = (f32x4){v0[0] * ca[0] - v1[0] * ca[1], v0[1] * ca[2] - v1[1] * ca[3], v0[2] * cb[0] - v1[2] * cb[1], v0[3] * cb[2] - v1[3] * cb[3]};
                        const f32x4 hi = (f32x4){v0[0] * ca[1] + v1[0] * ca[0], v0[1] * ca[3] + v1[1] * ca[2], v0[2] * cb[1] + v1[2] * cb[0], v0[3] * cb[3] + v1[3] * cb[2]};
                        v0 = lo; v1 = hi; }
                    v0 = v0 * sc; v1 = v1 * sc;
                    const v4u w = pack2x4(v0, v1);
                    if (isu) { const int c = col0 + bj * HALF - 1024, g5 = c >> 4, m0 = c & 15;
                        *(v4u*)(UA + ((size_t)(g5 * S5RP + r5) * S5K + i5 * 16 + m0)) = w; }
                    else *(v4u*)(rowp + bj * HALF) = w; } }
    }
};
struct EpiGlu {
    static constexpr bool PERM = true, AFTER_DRAIN = false;
    const bf16* Y; const float* b; bf16* Z;
    __device__ __forceinline__ void operator()(const f32x4 (&acc)[2][2][4][2], const Unit& u, int wr, int wc, int fr, int fq) const {
        const int row0 = u.pm * BM + wr * 64 + fr, col0 = u.pn * BM + wc * 32 + 8 * fq;
        f32x4 bv[2][2];
#pragma unroll
        for (int bj = 0; bj < 2; ++bj)
#pragma unroll
            for (int n = 0; n < 2; ++n) bv[bj][n] = *(const f32x4*)(b + col0 + bj * HALF + 4 * n);
#pragma unroll
        for (int ai = 0; ai < 2; ++ai)
#pragma unroll
            for (int m = 0; m < 4; ++m) { const int row = row0 + ai * HALF + m * 16;
#pragma unroll
                for (int bj = 0; bj < 2; ++bj) { const int col = col0 + bj * HALF;
                    const v4u yw = *(const v4u*)(Y + (size_t)row * 512 + col); float yy[8]; unpack8(yw, yy);
                    const f32x4 a0 = acc[ai][bj][m][0] + bv[bj][0], a1 = acc[ai][bj][m][1] + bv[bj][1];
                    const f32x4 z0 = (f32x4){yy[0] * sigmoidf_(a0[0]), yy[1] * sigmoidf_(a0[1]), yy[2] * sigmoidf_(a0[2]), yy[3] * sigmoidf_(a0[3])};
                    const f32x4 z1 = (f32x4){yy[4] * sigmoidf_(a1[0]), yy[5] * sigmoidf_(a1[1]), yy[6] * sigmoidf_(a1[2]), yy[7] * sigmoidf_(a1[3])};
                    *(v4u*)(Z + (size_t)row * 1024 + col) = pack2x4(z0, z1); } }
    }
};
struct EpiResid {
    static constexpr bool PERM = false, AFTER_DRAIN = false;
    const float* baseL; const float* baseC; float* outL; float* outC; const float* gate;
    __device__ __forceinline__ void operator()(const f32x4 (&acc)[2][2][4][2], const Unit& u, int wr, int wc, int fr, int fq) const {
        const bool ctx = u.pm >= ML / BM; const int mr = ctx ? 8 : (u.pm >> 4);
        const int row0 = (ctx ? u.pm - ML / BM : u.pm) * BM + wr * 64 + fr, col0 = u.pn * BM + wc * 32 + 4 * fq;
        const float* B = ctx ? baseC : baseL; float* Oo = ctx ? outC : outL;
        f32x4 gv[2][2];
#pragma unroll
        for (int bj = 0; bj < 2; ++bj)
#pragma unroll
            for (int n = 0; n < 2; ++n) gv[bj][n] = *(const f32x4*)(gate + (size_t)mr * NMOD + col0 + bj * HALF + n * 16);
#pragma unroll
        for (int ai = 0; ai < 2; ++ai)
#pragma unroll
            for (int m = 0; m < 4; ++m) { const size_t off = (size_t)(row0 + ai * HALF + m * 16) * DM + col0;
#pragma unroll
                for (int bj = 0; bj < 2; ++bj)
#pragma unroll
                    for (int n = 0; n < 2; ++n) { const f32x4 bs = *(const f32x4*)(B + off + bj * HALF + n * 16);
                        *(f32x4*)(Oo + off + bj * HALF + n * 16) = bs + gv[bj][n] * acc[ai][bj][m][n]; } }
    }
};
struct EpiSqrelu {
    static constexpr bool PERM = true, AFTER_DRAIN = false;
    bf16* O;
    __device__ __forceinline__ void operator()(const f32x4 (&acc)[2][2][4][2], const Unit& u, int wr, int wc, int fr, int fq) const {
        const int row0 = u.pm * BM + wr * 64 + fr, col0 = u.pn * BM + wc * 32 + 8 * fq;
#pragma unroll
        for (int ai = 0; ai < 2; ++ai)
#pragma unroll
            for (int m = 0; m < 4; ++m) { bf16* rowp = O + (size_t)(row0 + ai * HALF + m * 16) * DFF + col0;
#pragma unroll
                for (int bj = 0; bj < 2; ++bj) { f32x4 v0 = acc[ai][bj][m][0], v1 = acc[ai][bj][m][1];
                    v0 = __builtin_elementwise_max(v0, (f32x4){0.f, 0.f, 0.f, 0.f}); v1 = __builtin_elementwise_max(v1, (f32x4){0.f, 0.f, 0.f, 0.f});
                    *(v4u*)(rowp + bj * HALF) = pack2x4(v0 * v0, v1 * v1); } }
    }
};
struct EpiProj1 {
    static constexpr bool PERM = true, AFTER_DRAIN = false;
    bf16* O; const float* LB;
    __device__ __forceinline__ void operator()(const f32x4 (&acc)[2][2][4][2], const Unit& u, int wr, int wc, int fr, int fq) const {
        const int row0 = u.pm * BM + wr * 64 + fr, col0 = u.pn * BM + wc * 32 + 8 * fq;
        const int kind = u.pn >> 2;
        const bool gatek = (kind == 1) || (kind == 2);
        f32x4 lb[2][2];
#pragma unroll
        for (int bj = 0; bj < 2; ++bj)
#pragma unroll
            for (int n = 0; n < 2; ++n) lb[bj][n] = gatek ? *(const f32x4*)(LB + (size_t)(kind - 1) * 1024 + ((col0 + bj * HALF) & 1023) + 4 * n) : (f32x4){0.f, 0.f, 0.f, 0.f};
#pragma unroll
        for (int ai = 0; ai < 2; ++ai)
#pragma unroll
            for (int m = 0; m < 4; ++m) { bf16* rowp = O + (size_t)(row0 + ai * HALF + m * 16) * 5120 + col0;
#pragma unroll
                for (int bj = 0; bj < 2; ++bj) { const f32x4 v0 = acc[ai][bj][m][0], v1 = acc[ai][bj][m][1];
                    v4u w;
                    if (gatek) {
                        float l0[4], l1[4];
#pragma unroll
                        for (int i = 0; i < 4; ++i) { l0[i] = __logf(lb[bj][0][i] + (1.0f - lb[bj][0][i]) * sigmoidf_(v0[i])); l1[i] = __logf(lb[bj][1][i] + (1.0f - lb[bj][1][i]) * sigmoidf_(v1[i])); }
                        w.x = pk_f16(l0[0], l0[1]); w.y = pk_f16(l0[2], l0[3]); w.z = pk_f16(l1[0], l1[1]); w.w = pk_f16(l1[2], l1[3]);
                    } else w = pack2x4(v0, v1);
                    *(v4u*)(rowp + bj * HALF) = w; } }
    }
};

struct EpiHloc {
    static constexpr bool PERM = false, AFTER_DRAIN = false;
    float* C;
    __device__ __forceinline__ void operator()(const f32x4 (&acc)[2][2][4][2], const Unit& u, int wr, int wc, int fr, int fq) const {
        const int row0 = u.pm * BM + wr * 64 + fr, col0 = wc * 32 + 4 * fq;
#pragma unroll
        for (int ai = 0; ai < 2; ++ai)
#pragma unroll
            for (int m = 0; m < 4; ++m) { float* rowp = C + (size_t)(row0 + ai * HALF + m * 16) * 256 + col0;
#pragma unroll
                for (int bj = 0; bj < 2; ++bj)
#pragma unroll
                    for (int n = 0; n < 2; ++n) *(f32x4*)(rowp + bj * HALF + n * 16) = acc[ai][bj][m][n]; }
    }
};
struct EpiS5Out {
    static constexpr bool PERM = true, AFTER_DRAIN = false;
    const bf16* UA; const float* dskip; bf16* Y;
    __device__ __forceinline__ void operator()(const f32x4 (&acc)[2][2][4][2], const Unit& u, int wr, int wc, int fr, int fq) const {
        const int g5 = u.pm / 5, pml = u.pm - 5 * g5, pnl = u.pn - 2 * g5;
        const int r0 = pml * BM + wr * 64 + fr, col0 = pnl * BM + wc * 32 + 8 * fq;
#pragma unroll
        for (int ai = 0; ai < 2; ++ai)
#pragma unroll
            for (int m = 0; m < 4; ++m) { const int r = r0 + ai * HALF + m * 16;
                if (r < S5R) {
                    const int b = r / 136, ch = r - b * 136;
#pragma unroll
                    for (int bj = 0; bj < 2; ++bj) { const int col = col0 + bj * HALF, i5 = col >> 4, m0 = col & 15;
                        const int trow = ch < 8 ? ML + b * CTXL + ch * 32 + i5 : b * SEQL + (ch - 8) * 32 + i5;
                        const v4u uw = *(const v4u*)(UA + ((size_t)(g5 * S5RP + r) * S5K + col)); float uu[8]; unpack8(uw, uu);
                        const f32x4 d0 = *(const f32x4*)(dskip + g5 * 16 + m0), d1 = *(const f32x4*)(dskip + g5 * 16 + m0 + 4);
                        const f32x4 a0 = acc[ai][bj][m][0], a1 = acc[ai][bj][m][1];
                        const f32x4 y0 = (f32x4){gelu_tanh(a0[0] + d0[0] * uu[0]), gelu_tanh(a0[1] + d0[1] * uu[1]), gelu_tanh(a0[2] + d0[2] * uu[2]), gelu_tanh(a0[3] + d0[3] * uu[3])};
                        const f32x4 y1 = (f32x4){gelu_tanh(a1[0] + d1[0] * uu[4]), gelu_tanh(a1[1] + d1[1] * uu[5]), gelu_tanh(a1[2] + d1[2] * uu[6]), gelu_tanh(a1[3] + d1[3] * uu[7])};
                        *(v4u*)(Y + (size_t)trow * 512 + g5 * 16 + m0) = pack2x4(y0, y1); } } }
    }
};

__device__ __forceinline__ f32x2 cmul(f32x2 a, f32x2 b) { return (f32x2){a.x * b.x - a.y * b.y, a.x * b.y + a.y * b.x}; }
__device__ __forceinline__ void s5_tables_item(LAS unsigned char* lds, int g, const float* a_re, const float* a_im, const float* log_dt, const float* b_re, const float* b_im,
                                               const float* c_re, const float* c_im, bf16* Bc, bf16* Ws5) {
    const int tid = threadIdx.x;
    LAS f32x2* POW = (LAS f32x2*)lds;
    LAS f32x2* BBl = (LAS f32x2*)(lds + 33792);
    LAS f32x2* CCl = (LAS f32x2*)(lds + 50176);
    LAS float* KRN = (LAS float*)(lds + 66560);
    if (tid < 128) {
        const int d = tid >> 6, p = tid & 63, i = (d * 32 + g) * 64 + p;
        const float dt = expf(log_dt[d * 32 + g]); const float are = a_re[i], aim = a_im[i];
        const float mag = expf(are * dt), ang = aim * dt; const f32x2 ab = (f32x2){mag * cosf(ang), mag * sinf(ang)};
        const float nr = ab.x - 1.0f, ni = ab.y, den = are * are + aim * aim; const float fr = (nr * are + ni * aim) / den, fi = (ni * are - nr * aim) / den;
        f32x2 pw = (f32x2){1.f, 0.f};
        for (int e = 0; e <= 32; ++e) { POW[(d * 64 + p) * 33 + e] = pw; pw = cmul(pw, ab); }
        for (int n = 0; n < 16; ++n) { const float br = b_re[(size_t)i * 16 + n], bi = b_im[(size_t)i * 16 + n]; BBl[(d * 64 + p) * 16 + n] = (f32x2){fr * br - fi * bi, fr * bi + fi * br}; }
    }
    for (int o = tid; o < 2048; o += NWAVES * 64) { const int d = o >> 10, m = (o >> 6) & 15, p = o & 63; const size_t ci = ((size_t)(d * 32 + g) * 16 + m) * 64 + p; CCl[o] = (f32x2){c_re[ci], c_im[ci]}; }
    __syncthreads();
    for (int k = 0; k < 8; ++k) { const int o4 = tid + 512 * k, d = o4 >> 11, tau = (o4 >> 6) & 31, m = (o4 >> 2) & 15, nq = o4 & 3;
        float a0 = 0.f, a1 = 0.f, a2 = 0.f, a3 = 0.f;
        for (int p = 0; p < 64; ++p) { const f32x2 cp = cmul(CCl[(d * 16 + m) * 64 + p], POW[(d * 64 + p) * 33 + tau]); const LAS f32x2* bb = BBl + (d * 64 + p) * 16 + nq * 4;
            a0 += cp.x * bb[0].x - cp.y * bb[0].y; a1 += cp.x * bb[1].x - cp.y * bb[1].y; a2 += cp.x * bb[2].x - cp.y * bb[2].y; a3 += cp.x * bb[3].x - cp.y * bb[3].y; }
        *(LAS f32x4*)(KRN + ((d * 32 + tau) * 16 + m) * 16 + nq * 4) = (f32x4){a0, a1, a2, a3}; }
    __syncthreads();
    for (int k = 0; k < 96; ++k) { const int ch = tid + 512 * k, row = ch / 96, kc = ch - row * 96, k0 = kc * 8, i = row >> 4, m = row & 15;
        float v[8];
        if (k0 < 512) { const int j = k0 >> 4, n0 = k0 & 15;
            if (i > j) { const LAS float* s = KRN + ((0 * 32 + (i - j)) * 16 + m) * 16 + n0;
#pragma unroll
                for (int t = 0; t < 8; ++t) v[t] = s[t]; }
            else if (i < j) { const LAS float* s = KRN + ((1 * 32 + (j - i)) * 16 + m) * 16 + n0;
#pragma unroll
                for (int t = 0; t < 8; ++t) v[t] = s[t]; }
            else { const LAS float* s0 = KRN + ((0 * 32 + 0) * 16 + m) * 16 + n0; const LAS float* s1 = KRN + ((1 * 32 + 0) * 16 + m) * 16 + n0;
#pragma unroll
                for (int t = 0; t < 8; ++t) v[t] = s0[t] + s1[t]; }
        } else { const int q0 = k0 - 512, d = q0 >> 7, p0 = (q0 & 127) >> 1, e = d == 0 ? i + 1 : 32 - i;
#pragma unroll
            for (int t = 0; t < 4; ++t) { const f32x2 ca = cmul(CCl[(d * 16 + m) * 64 + p0 + t], POW[(d * 64 + p0 + t) * 33 + e]); v[2 * t] = ca.x; v[2 * t + 1] = -ca.y; } }
        *(v4u*)(Bc + ((size_t)(g * 512 + row) * S5K + k0)) = pack8(v); }
    for (int k = 0; k < 32; ++k) { const int ch = tid + 512 * k, q = ch >> 6, kc = ch & 63, k0 = kc * 8, j = k0 >> 4, n0 = k0 & 15;
        const int d = q >> 7, p = (q & 127) >> 1, ri = q & 1, ef = d == 0 ? 31 - j : j;
        const f32x2 pw = POW[(d * 64 + p) * 33 + ef]; float v[8];
#pragma unroll
        for (int t = 0; t < 8; ++t) { const f32x2 w = cmul(pw, BBl[(d * 64 + p) * 16 + n0 + t]); v[t] = ri ? w.y : w.x; }
        *(v4u*)(Ws5 + ((size_t)(g * 256 + q) * 512 + k0)) = pack8(v); }
    __syncthreads();
}
__device__ __forceinline__ void s5_scan(const float* HL, bf16* UA, const f32x2* AB, int gw, int NGW, int lane) {
    for (int w = gw; w < 512; w += NGW) {
        const int b = w >> 6, g = (w >> 1) & 31, d = w & 1;
        f32x2 a32 = AB[(d * 32 + g) * 64 + lane];
#pragma unroll
        for (int i = 0; i < 5; ++i) a32 = cmul(a32, a32);
        f32x2 h = (f32x2){0.f, 0.f};
        const size_t rbase = (size_t)g * S5RP + b * 136;
#pragma unroll 1
        for (int s0 = 0; s0 < 136; s0 += 34) {
            f32x2 hl[34];
#pragma unroll
            for (int k = 0; k < 34; ++k) { const int s = s0 + k, c = d == 0 ? s : (s < 8 ? 7 - s : 143 - s); hl[k] = *(const f32x2*)(HL + (rbase + c) * 256 + d * 128 + lane * 2); }
#pragma unroll
            for (int k = 0; k < 34; ++k) { const int s = s0 + k, c = d == 0 ? s : (s < 8 ? 7 - s : 143 - s);
                *(unsigned*)(UA + (rbase + c) * S5K + 512 + d * 128 + lane * 2) = pk2(h.x, h.y);
                h = cmul(a32, h) + hl[k]; }
        }
    }
}

typedef short bf16x8_t __attribute__((ext_vector_type(8)));
__device__ __forceinline__ bf16x8_t frag_rm(const LAS unsigned char* T, int RS, int r0, int k0, int lane) { return *(const LAS bf16x8_t*)(T + (r0 + (lane & 15)) * RS + (k0 + 8 * (lane >> 4)) * 2); }
#define MFMA16(a, b, c) __builtin_amdgcn_mfma_f32_16x16x32_bf16((a), (b), (c), 0, 0, 0)
typedef short v4i16_t __attribute__((ext_vector_type(4)));
__device__ __forceinline__ bf16x8_t frag_tr(const LAS unsigned char* T, int RS, int k0, int n0, int lane) {
    const int g = lane >> 4, q = (lane & 15) >> 2, p = lane & 3;
    const LAS unsigned char* a = T + (k0 + 8 * g + q) * RS + (n0 + 4 * p) * 2;
    const v4i16_t lo = __builtin_amdgcn_ds_read_tr16_b64_v4i16((LAS v4i16_t*)a);
    const v4i16_t hi = __builtin_amdgcn_ds_read_tr16_b64_v4i16((LAS v4i16_t*)(a + 4 * RS));
    return (bf16x8_t){lo[0], lo[1], lo[2], lo[3], hi[0], hi[1], hi[2], hi[3]};
}
__device__ __forceinline__ bf16x8_t scale_frag(bf16x8_t f, float sc) {
    const v4u w = __builtin_bit_cast(v4u, f); float t[8]; unpack8(w, t);
    v4u o; o.x = pk2(t[0] * sc, t[1] * sc); o.y = pk2(t[2] * sc, t[3] * sc); o.z = pk2(t[4] * sc, t[5] * sc); o.w = pk2(t[6] * sc, t[7] * sc);
    return __builtin_bit_cast(bf16x8_t, o);
}
constexpr int RCH = 34;
__device__ __forceinline__ int ret_row0(int b, int s) { return s < 2 ? ML + b * CTXL + s * 128 : b * SEQL + (s - 2) * 128; }
__device__ __forceinline__ void stage_v(LAS unsigned char* Vs, const bf16* P0, int row0, int h, int tid) {
#pragma unroll
    for (int k = 0; k < 4; ++k) { const int c = tid + 512 * k, j = c >> 4, ch = c & 15;
        *(LAS v4u*)(Vs + j * 272 + ch * 16) = *(const v4u*)(P0 + (size_t)(row0 + j) * P0LD + 512 + h * 128 + ch * 8); }
}
__device__ __forceinline__ void ret_passA_item(LAS unsigned char* lds, int it, const bf16* P0, const float* ret_logit, bf16* ULOC) {
    int tid_ = threadIdx.x; asm volatile("" : "+v"(tid_)); const int tid = tid_, lane = tid & 63, w = tid >> 6, g4 = lane >> 4;
    const int bh = it / RCH, s = it - bh * RCH, b = bh >> 2, h = bh & 3, row0 = ret_row0(b, s);
    const float lgf = log2f(1.0f / (1.0f + expf(-ret_logit[h]))), lgb = log2f(1.0f / (1.0f + expf(-ret_logit[4 + h])));
    LAS unsigned char* Kf = lds; LAS unsigned char* Kb = lds + 18432; LAS unsigned char* Vs = lds + 36864;
#pragma unroll
    for (int k = 0; k < 2; ++k) { const int c = tid + 512 * k, j = c >> 3, ch = c & 7;
        const v4u wv = *(const v4u*)(P0 + (size_t)(row0 + j) * P0LD + 256 + h * 64 + ch * 8); float t[8]; unpack8(wv, t);
        const float sf = exp2f((float)(127 - j) * lgf), sb = exp2f((float)j * lgb);
        v4u of, ob; of.x = pk2(t[0] * sf, t[1] * sf); of.y = pk2(t[2] * sf, t[3] * sf); of.z = pk2(t[4] * sf, t[5] * sf); of.w = pk2(t[6] * sf, t[7] * sf);
        ob.x = pk2(t[0] * sb, t[1] * sb); ob.y = pk2(t[2] * sb, t[3] * sb); ob.z = pk2(t[4] * sb, t[5] * sb); ob.w = pk2(t[6] * sb, t[7] * sb);
        *(LAS v4u*)(Kf + j * 144 + ch * 16) = of; *(LAS v4u*)(Kb + j * 144 + ch * 16) = ob; }
    stage_v(Vs, P0, row0, h, tid);
    __syncthreads();
    f32x4 acc[2][4];
#pragma unroll
    for (int d = 0; d < 2; ++d)
#pragma unroll
        for (int dt = 0; dt < 4; ++dt) acc[d][dt] = (f32x4){0.f, 0.f, 0.f, 0.f};
#pragma unroll
    for (int ks = 0; ks < 4; ++ks) { const bf16x8_t vb = frag_tr(Vs, 272, 32 * ks, 16 * w, lane);
#pragma unroll
        for (int dt = 0; dt < 4; ++dt) { acc[0][dt] = MFMA16(frag_tr(Kf, 144, 32 * ks, 16 * dt, lane), vb, acc[0][dt]); acc[1][dt] = MFMA16(frag_tr(Kb, 144, 32 * ks, 16 * dt, lane), vb, acc[1][dt]); } }
    const int e = 16 * w + (lane & 15);
#pragma unroll
    for (int d = 0; d < 2; ++d)
#pragma unroll
        for (int dt = 0; dt < 4; ++dt) { v2u o; o.x = pk2(acc[d][dt][0], acc[d][dt][1]); o.y = pk2(acc[d][dt][2], acc[d][dt][3]);
            *(v2u*)(ULOC + ((size_t)((bh * 2 + d) * RCH + s) * 128 + e) * 64 + 16 * dt + 4 * g4) = o; }
    __syncthreads();
}
__device__ __forceinline__ void ret_scan(const bf16* ULOC, bf16* SIN, const float* ret_logit, int gt, int NT) {
    for (int idx = gt; idx < 64 * 2048; idx += NT) {
        const int bhd = idx >> 11, off = (idx & 2047) * 4, dir = bhd & 1, h = (bhd >> 1) & 3;
        const float g128 = exp2f(128.0f * log2f(1.0f / (1.0f + expf(-ret_logit[dir * 4 + h]))));
        const size_t base = (size_t)bhd * RCH * 8192 + off;
        v2u u[RCH];
#pragma unroll
        for (int k = 0; k < RCH; ++k) { const int s = dir == 0 ? k : (k < 2 ? 1 - k : 35 - k); u[k] = *(const v2u*)(ULOC + base + (size_t)s * 8192); }
        float st[4] = {0.f, 0.f, 0.f, 0.f};
#pragma unroll
        for (int k = 0; k < RCH; ++k) { const int s = dir == 0 ? k : (k < 2 ? 1 - k : 35 - k);
            v2u o; o.x = pg8::cvt_pk_bf16(st[0], st[1]); o.y = pg8::cvt_pk_bf16(st[2], st[3]); *(v2u*)(SIN + base + (size_t)s * 8192) = o;
            st[0] = g128 * st[0] + bflo(u[k].x); st[1] = g128 * st[1] + bfhi(u[k].x); st[2] = g128 * st[2] + bflo(u[k].y); st[3] = g128 * st[3] + bfhi(u[k].y); }
    }
}
__device__ __forceinline__ void ret_passC_item(LAS unsigned char* lds, int it, const bf16* P0, const float* ret_logit, const bf16* SIN, bf16* RZ) {
    int tid_ = threadIdx.x; asm volatile("" : "+v"(tid_)); const int tid = tid_, lane = tid & 63, w = tid >> 6, g4 = lane >> 4, l15 = lane & 15;
    const int bh = it / RCH, s = it - bh * RCH, b = bh >> 2, h = bh & 3, row0 = ret_row0(b, s);
    const float lgf = log2f(1.0f / (1.0f + expf(-ret_logit[h]))), lgb = log2f(1.0f / (1.0f + expf(-ret_logit[4 + h])));
    LAS unsigned char* Qs = lds; LAS unsigned char* Ks = lds + 18432; LAS unsigned char* SfT = lds + 36864; LAS unsigned char* SbT = lds + 55296; LAS unsigned char* Vs = lds + 73728;
    LAS unsigned char* Pm = lds + 108544;
#pragma unroll
    for (int k = 0; k < 2; ++k) { const int c = tid + 512 * k, j = c >> 3, ch = c & 7;
        *(LAS v4u*)(Qs + j * 144 + ch * 16) = *(const v4u*)(P0 + (size_t)(row0 + j) * P0LD + h * 64 + ch * 8);
        *(LAS v4u*)(Ks + j * 144 + ch * 16) = *(const v4u*)(P0 + (size_t)(row0 + j) * P0LD + 256 + h * 64 + ch * 8);
        *(LAS v4u*)(SfT + j * 144 + ch * 16) = *(const v4u*)(SIN + ((size_t)((bh * 2 + 0) * RCH + s) * 128 + j) * 64 + ch * 8);
        *(LAS v4u*)(SbT + j * 144 + ch * 16) = *(const v4u*)(SIN + ((size_t)((bh * 2 + 1) * RCH + s) * 128 + j) * 64 + ch * 8); }
    stage_v(Vs, P0, row0, h, tid);
    const int il = 16 * w + l15;
    const size_t row = (size_t)(row0 + il);
    v2u gatew[8];
#pragma unroll
    for (int t = 0; t < 8; ++t) gatew[t] = *(const v2u*)(P0 + row * P0LD + 1024 + h * 128 + 16 * t + 4 * g4);
    __syncthreads();
    f32x4 accO[8], accA[8];
#pragma unroll
    for (int t = 0; t < 8; ++t) { accO[t] = (f32x4){0.f, 0.f, 0.f, 0.f}; accA[t] = (f32x4){0.f, 0.f, 0.f, 0.f}; }
    { const float af = exp2f((float)(il + 1) * lgf), ab = exp2f((float)(128 - il) * lgb);
#pragma unroll
      for (int ks = 0; ks < 2; ++ks) { const bf16x8_t q = frag_rm(Qs, 144, 16 * w, 32 * ks, lane); const bf16x8_t qf = scale_frag(q, af), qb = scale_frag(q, ab);
#pragma unroll
          for (int t = 0; t < 8; ++t) { accA[t] = MFMA16(frag_rm(Ks, 144, 16 * t, 32 * ks, lane), q, accA[t]);
              accO[t] = MFMA16(frag_rm(SfT, 144, 16 * t, 32 * ks, lane), qf, accO[t]); accO[t] = MFMA16(frag_rm(SbT, 144, 16 * t, 32 * ks, lane), qb, accO[t]); } } }
#pragma unroll
    for (int t = 0; t < 8; ++t) { float pv[4];
#pragma unroll
        for (int r = 0; r < 4; ++r) { const int j = 16 * t + 4 * g4 + r;
            const float dm = il > j ? exp2f((float)(il - j) * lgf) : (il < j ? exp2f((float)(j - il) * lgb) : 2.0f); pv[r] = accA[t][r] * dm; }
        v2u pw; pw.x = pk2(pv[0], pv[1]); pw.y = pk2(pv[2], pv[3]); *(LAS v2u*)(Pm + il * 272 + (16 * t + 4 * g4) * 2) = pw; }
    __syncthreads();
#pragma unroll
    for (int ks = 0; ks < 4; ++ks) { const bf16x8_t p = frag_rm(Pm, 272, 16 * w, 32 * ks, lane);
#pragma unroll
        for (int t = 0; t < 8; ++t) accO[t] = MFMA16(frag_tr(Vs, 272, 32 * ks, 16 * t, lane), p, accO[t]); }
    float ss = 0.f;
#pragma unroll
    for (int t = 0; t < 8; ++t) ss += (accO[t][0] * accO[t][0] + accO[t][1] * accO[t][1]) + (accO[t][2] * accO[t][2] + accO[t][3] * accO[t][3]);
    ss += __shfl_xor(ss, 16); ss += __shfl_xor(ss, 32);
    const float rs = 1.0f / sqrtf(ss * (1.f / 128.f) + EPSN);
#pragma unroll
    for (int t = 0; t < 8; ++t) { const float g0 = bflo(gatew[t].x), g1 = bfhi(gatew[t].x), g2 = bflo(gatew[t].y), g3 = bfhi(gatew[t].y);
        v2u o; o.x = pk2(accO[t][0] * rs * siluf_(g0), accO[t][1] * rs * siluf_(g1)); o.y = pk2(accO[t][2] * rs * siluf_(g2), accO[t][3] * rs * siluf_(g3));
        *(v2u*)(RZ + row * 1024 + h * 128 + 16 * t + 4 * g4) = o; }
    __syncthreads();
}
__device__ __forceinline__ int hg_row0(int b, int dir, int st) {
    if (st < 8) { const int c = dir ? 7 - st : st; return ML + b * CTXL + c * 32; }
    const int c = dir ? 135 - st : st - 8; return b * SEQL + c * 32;
}
struct HgRaw { v4u q0, q1, l0, l1, v; };
#define HG_ISSUE(R_, st_) do { const int r0_ = hg_row0(b, dir, (st_)); \
        const bf16* qp_ = P1 + (size_t)(r0_ + rtok) * 5120 + h * 128 + rseg; \
        (R_).q0 = *(const v4u*)qp_; (R_).q1 = *(const v4u*)(qp_ + (size_t)16 * 5120); (R_).l0 = *(const v4u*)(qp_ + 1024 + dir * 1024); (R_).l1 = *(const v4u*)(qp_ + (size_t)16 * 5120 + 1024 + dir * 1024); \
        (R_).v = *(const v4u*)(P1 + (size_t)(r0_ + tv) * 5120 + 3072 + h * 128 + eh * 64 + eseg); } while (0)
__device__ __forceinline__ float f16bits(unsigned short hbits) { return (float)__builtin_bit_cast(_Float16, hbits); }
__device__ __forceinline__ void hgrn_item(LAS unsigned char* lds, int it, const bf16* P1, bf16* OS, unsigned char* ws) {
    int tid_ = threadIdx.x; asm volatile("" : "+v"(tid_)); const int tid = tid_;
    const int lane = tid & 63, w = tid >> 6, g4 = lane >> 4, l15 = lane & 15;
    const bool fe = w >= 4;
    const int dir = it & 1, et = w & 3, td = tid & 255, tv = td >> 3, eseg = (td & 7) * 8;
    const int rtok = td >> 4, rseg = (td & 15) * 8;
    const int b = it >> 5, h = (it >> 2) & 7, eh = (it >> 1) & 1;
    LAS unsigned char* LR = lds + 71680;
#define HG_QI(p) (lds + (p) * 35840)
#define HG_KT(p) (lds + (p) * 35840 + 8704)
#define HG_VT(p) (lds + (p) * 35840 + 18944)
#define HG_PM(p) (lds + (p) * 35840 + 24064)
#define HG_KI(p) (lds + (p) * 35840 + 27136)
#define HG_DEC(p) ((LAS float*)(lds + (p) * 35840 + 26624))
    f32x4 S[8];
#pragma unroll
    for (int t = 0; t < 8; ++t) S[t] = (f32x4){0.f, 0.f, 0.f, 0.f};
    HgRaw R[4];
    v2u pend[2] = {(v2u){0u, 0u}, (v2u){0u, 0u}};
    if (fe) { HG_ISSUE(R[0], 0); HG_ISSUE(R[1], 1); HG_ISSUE(R[2], 2); }
#pragma unroll 1
    for (int s4 = 0; s4 < 140; s4 += 4) {
#pragma unroll
    for (int u = 0; u < 4; ++u) {
        const int sl = s4 + u;
        const int pf = sl & 1, pb = pf ^ 1;
        const bool fe_on = fe && sl < 136, be_on = !fe && sl >= 1 && sl <= 136;
        if (fe_on) {
            LAS unsigned char* QI = HG_QI(pf); LAS unsigned char* VT = HG_VT(pf);
            *(LAS v4u*)(QI + rtok * 272 + rseg * 2) = R[u].q0; *(LAS v4u*)(QI + (rtok + 16) * 272 + rseg * 2) = R[u].q1;
            *(LAS v4u*)(LR + rtok * 272 + rseg * 2) = R[u].l0; *(LAS v4u*)(LR + (rtok + 16) * 272 + rseg * 2) = R[u].l1;
            const v4u vr = R[u].v;
            LAS unsigned short* vp = (LAS unsigned short*)(VT + eseg * 80 + tv * 2);
            vp[0 * 40] = (unsigned short)(vr.x & 0xffffu); vp[1 * 40] = (unsigned short)(vr.x >> 16); vp[2 * 40] = (unsigned short)(vr.y & 0xffffu); vp[3 * 40] = (unsigned short)(vr.y >> 16);
            vp[4 * 40] = (unsigned short)(vr.z & 0xffffu); vp[5 * 40] = (unsigned short)(vr.z >> 16); vp[6 * 40] = (unsigned short)(vr.w & 0xffffu); vp[7 * 40] = (unsigned short)(vr.w >> 16);
            if (sl + 3 < 136) HG_ISSUE(R[(u + 3) & 3], sl + 3);
        }
        if (be_on) {
            if (sl >= 10) { const int prow = hg_row0(b, dir, sl - 2);
                bf16* obase = dir == 0 ? OS + (size_t)prow * 1024 : (bf16*)(ws + ws_ob(b)) + (size_t)(prow - b * SEQL) * 1024;
#pragma unroll
                for (int t2 = 0; t2 < 2; ++t2) *(v2u*)(obase + (size_t)(16 * t2 + l15) * 1024 + h * 128 + eh * 64 + 16 * et + 4 * g4) = pend[t2]; }
            LAS unsigned char* QI = HG_QI(pb); LAS unsigned char* KI = HG_KI(pb); LAS unsigned char* PM = HG_PM(pb);
            const int it1 = et >> 1, jt1 = et & 1;
            f32x4 ap = (f32x4){0.f, 0.f, 0.f, 0.f};
#pragma unroll
            for (int ks = 0; ks < 4; ++ks) ap = MFMA16(frag_rm(QI, 272, 16 * it1, 32 * ks, lane), frag_rm(KI, 272, 16 * jt1, 32 * ks, lane), ap);
#pragma unroll
            for (int r = 0; r < 4; ++r) { const int i = 16 * it1 + 4 * g4 + r, j = 16 * jt1 + l15; const bool keep = dir == 0 ? (j <= i) : (j >= i);
                *(LAS unsigned short*)(PM + i * 80 + j * 2) = keep ? (unsigned short)f2bf(ap[r]) : (unsigned short)0; }
        }
        __syncthreads();
        if (fe_on) {
            LAS unsigned char* QI = HG_QI(pf); LAS unsigned char* KT = HG_KT(pf); LAS float* DEC = HG_DEC(pf); LAS unsigned char* KI = HG_KI(pf);
            const int dpl = lane & 15, tq8 = lane >> 4, d0 = 2 * ((w & 3) * 16 + dpl), t0 = tq8 * 8;
            float la[8], lb[8], Ta = 0.f, Tb = 0.f;
#pragma unroll
            for (int i = 0; i < 8; ++i) { const unsigned wv = *(const LAS unsigned*)(LR + (t0 + i) * 272 + d0 * 2); la[i] = f16lo(wv); lb[i] = f16hi(wv); Ta += la[i]; Tb += lb[i]; }
            const float A0 = __shfl(Ta, dpl), A1 = __shfl(Ta, 16 + dpl), A2 = __shfl(Ta, 32 + dpl), A3 = __shfl(Ta, 48 + dpl);
            const float B0 = __shfl(Tb, dpl), B1 = __shfl(Tb, 16 + dpl), B2 = __shfl(Tb, 32 + dpl), B3 = __shfl(Tb, 48 + dpl);
            const float tota = (A0 + A1) + (A2 + A3), totb = (B0 + B1) + (B2 + B3);
            float basea, baseb;
            if (dir == 0) { basea = (tq8 > 0 ? A0 : 0.f) + (tq8 > 1 ? A1 : 0.f) + (tq8 > 2 ? A2 : 0.f); baseb = (tq8 > 0 ? B0 : 0.f) + (tq8 > 1 ? B1 : 0.f) + (tq8 > 2 ? B2 : 0.f); }
            else          { basea = (tq8 < 3 ? A3 : 0.f) + (tq8 < 2 ? A2 : 0.f) + (tq8 < 1 ? A1 : 0.f); baseb = (tq8 < 3 ? B3 : 0.f) + (tq8 < 2 ? B2 : 0.f) + (tq8 < 1 ? B1 : 0.f); }
            float ea = __expf(basea), eb = __expf(baseb); const float eta = __expf(tota), etb = __expf(totb);
            float koa[8], kob[8];
#pragma unroll
            for (int ii = 0; ii < 8; ++ii) { const int i = dir == 0 ? ii : 7 - ii;
                const float fa = __expf(la[i]), fb = __expf(lb[i]); ea *= fa; eb *= fb;
                LAS unsigned* qp = (LAS unsigned*)(QI + (t0 + i) * 272 + d0 * 2); const unsigned qw = *qp;
                const float kia = (1.0f - fa) * __builtin_amdgcn_rcpf(ea), kib = (1.0f - fb) * __builtin_amdgcn_rcpf(eb);
                *qp = pk2(bflo(qw) * ea, bfhi(qw) * eb);
                *(LAS unsigned*)(KI + (t0 + i) * 272 + d0 * 2) = pk2(kia, kib);
                koa[i] = kia * eta; kob[i] = kib * etb; }
            v4u k0, k1;
            k0.x = pk2(koa[0], koa[1]); k0.y = pk2(koa[2], koa[3]); k0.z = pk2(koa[4], koa[5]); k0.w = pk2(koa[6], koa[7]);
            k1.x = pk2(kob[0], kob[1]); k1.y = pk2(kob[2], kob[3]); k1.z = pk2(kob[4], kob[5]); k1.w = pk2(kob[6], kob[7]);
            *(LAS v4u*)(KT + d0 * 80 + t0 * 2) = k0; *(LAS v4u*)(KT + (d0 + 1) * 80 + t0 * 2) = k1;
            if (tq8 == 0) { DEC[d0] = eta; DEC[d0 + 1] = etb; }
        }
        if (be_on) {
            LAS unsigned char* QI = HG_QI(pb); LAS unsigned char* VT = HG_VT(pb); LAS unsigned char* PM = HG_PM(pb);
            LAS unsigned char* KT = HG_KT(pb); LAS float* DEC = HG_DEC(pb);
            bf16x8_t sb[4];
#pragma unroll
            for (int ks = 0; ks < 4; ++ks) { v4u t; t.x = pk2(S[2 * ks][0], S[2 * ks][1]); t.y = pk2(S[2 * ks][2], S[2 * ks][3]); t.z = pk2(S[2 * ks + 1][0], S[2 * ks + 1][1]); t.w = pk2(S[2 * ks + 1][2], S[2 * ks + 1][3]);
                sb[ks] = __builtin_bit_cast(bf16x8_t, t); }
            const bf16x8_t vfrag = frag_rm(VT, 80, 16 * et, 0, lane);
            f32x4 o[2];
#pragma unroll
            for (int t2 = 0; t2 < 2; ++t2) {
                o[t2] = MFMA16(vfrag, frag_rm(PM, 80, 16 * t2, 0, lane), ((f32x4){0.f, 0.f, 0.f, 0.f}));
#pragma unroll
                for (int ks = 0; ks < 4; ++ks) { const LAS unsigned char* qrow = QI + (16 * t2 + l15) * 272 + (32 * ks + 4 * g4) * 2;
                    const v2u qa = *(const LAS v2u*)qrow, qb = *(const LAS v2u*)(qrow + 32);
                    v4u qq; qq.x = qa.x; qq.y = qa.y; qq.z = qb.x; qq.w = qb.y;
                    o[t2] = MFMA16(sb[ks], __builtin_bit_cast(bf16x8_t, qq), o[t2]); }
            }
#pragma unroll
            for (int dt = 0; dt < 8; ++dt) { const f32x4 dv = *(const LAS f32x4*)(DEC + 16 * dt + 4 * g4);
                S[dt] = MFMA16(frag_rm(KT, 80, 16 * dt, 0, lane), vfrag, S[dt] * dv); }
#pragma unroll
            for (int t2 = 0; t2 < 2; ++t2) { pend[t2].x = pk2(o[t2][0], o[t2][1]); pend[t2].y = pk2(o[t2][2], o[t2][3]); }
        }
        __syncthreads();
    }
    }
    if (!fe) { const int prow = hg_row0(b, dir, 135);
      bf16* obase = dir == 0 ? OS + (size_t)prow * 1024 : (bf16*)(ws + ws_ob(b)) + (size_t)(prow - b * SEQL) * 1024;
#pragma unroll
      for (int t2 = 0; t2 < 2; ++t2) *(v2u*)(obase + (size_t)(16 * t2 + l15) * 1024 + h * 128 + eh * 64 + 16 * et + 4 * g4) = pend[t2]; }
    __syncthreads();
#undef HG_QI
#undef HG_KT
#undef HG_VT
#undef HG_PM
#undef HG_DEC
#undef HG_KI
}

struct Args { const float* in[28]; float* out; unsigned char* ws; };
enum { I_X = 0, I_C, I_CTX, I_CCTX, I_WMOD, I_BMOD, I_NMIX, I_NMLP, I_W1, I_W2, I_ABWIN, I_ABWOUT, I_RETL, I_S5ARE, I_S5AIM, I_S5DT, I_S5BRE, I_S5BIM, I_S5CRE, I_S5CIM, I_S5D, I_S5WGLU, I_S5BGLU, I_HGWIN, I_HGWOUT, I_HGLB, I_HGNORM, I_NFIN };

__global__ void __launch_bounds__(NWAVES * 64, 2) mk_fwd(Args args) {
    extern __shared__ __attribute__((aligned(16))) unsigned char lds_raw[];
    LAS unsigned char* lds = (LAS unsigned char*)lds_raw;
    volatile LAS unsigned* MISC = (volatile LAS unsigned*)(lds + MISC_OFF);
    const int tid = threadIdx.x, lane = tid & 63, wave = __builtin_amdgcn_readfirstlane(tid >> 6);
    const int G = gridDim.x;
    const int vcu = (G % 8 == 0) ? ((int)blockIdx.x % 8) * (G / 8) + (int)blockIdx.x / 8 : (int)blockIdx.x;
    const int gw = vcu * NWAVES + wave, NGW = G * NWAVES;
    unsigned char* ws = args.ws;
    gu32* ctl = (gu32*)(ws + WS_CTL);
    for (int u = tid; u < (LDS_BYTES - LDSCTL_OFF) / 4; u += NWAVES * 64) ((LAS unsigned*)(lds + LDSCTL_OFF))[u] = 0u;
    __syncthreads();
    XcdBarrier bar = xcd_barrier_post((unsigned*)(ctl + CW_BAR), MISC + 8);
#define GRID_BAR() xcd_barrier(bar)

    float* MOD = (float*)(ws + WS_MOD); float* CS = (float*)(ws + WS_CS);
    f32x2* AB = (f32x2*)(ws + WS_S5T); float* LB = (float*)(ws + WS_LB);
    float* HC = (float*)(ws + WS_HC);
    bf16* Win0 = (bf16*)(ws + WS_WIN0); bf16* Wout0 = (bf16*)(ws + WS_WOUT0); bf16* Wglu = (bf16*)(ws + WS_WGLU);
    bf16* W1t0 = (bf16*)(ws + WS_W1_0); bf16* W2t0 = (bf16*)(ws + WS_W2_0); bf16* W1t1 = (bf16*)(ws + WS_W1_1); bf16* W2t1 = (bf16*)(ws + WS_W2_1); bf16* Whg = (bf16*)(ws + WS_WHG); bf16* Whgo = (bf16*)(ws + WS_WHGO);
    bf16* XN = (bf16*)(ws + WS_XN); bf16* P0b = (bf16*)(ws + WS_P0); bf16* P1b = (bf16*)(ws + WS_P1); bf16* Hb = (bf16*)(ws + WS_H);
    bf16* ULOC = (bf16*)(ws + WS_ULOC); bf16* SIN = (bf16*)(ws + WS_SIN);
    bf16* UA = (bf16*)(ws + WS_UA); bf16* Bc = (bf16*)(ws + WS_BC); bf16* Ws5 = (bf16*)(ws + WS_WS5); float* HLOC = (float*)(ws + WS_HLOC);
    bf16* RZ = (bf16*)(ws + WS_RZ); bf16* Yb = (bf16*)(ws + WS_Y); bf16* OS = (bf16*)(ws + WS_XN);
    float* OUT = args.out;

    {
        LAS float* scr = (LAS float*)(lds + RING_OFF + wave * 16384);
        constexpr int I_A = 16 * 64, I_B = 16 * 32, I_G = 8 * 16, I_1 = 16 * 128, I_2 = 64 * 32, I_H = 16 * 160, I_O = 16 * 32;
        constexpr int NITEMS = I_A + I_B + I_G + 2 * I_1 + 2 * I_2 + I_H + I_O;
        for (int it = gw; it < NITEMS; it += NGW) {
            int r = it;
            if (r < I_A) { p0_transpose_item<true>(args.in[I_ABWIN], 1024, 2048, Win0, scr, r, lane); continue; } r -= I_A;
            if (r < I_B) { p0_transpose_item<false>(args.in[I_ABWOUT], 1024, 1024, Wout0, scr, r, lane); continue; } r -= I_B;
            if (r < I_G) { p0_transpose_item<false>(args.in[I_S5WGLU], 512, 512, Wglu, scr, r, lane); continue; } r -= I_G;
            if (r < 2 * I_1) { const int l = r / I_1; p0_transpose_item<false>(args.in[I_W1] + (size_t)l * 1024 * 4096, 1024, 4096, l ? W1t1 : W1t0, scr, r % I_1, lane); continue; } r -= 2 * I_1;
            if (r < 2 * I_2) { const int l = r / I_2; p0_transpose_item<false>(args.in[I_W2] + (size_t)l * 1024 * 4096, 4096, 1024, l ? W2t1 : W2t0, scr, r % I_2, lane); continue; } r -= 2 * I_2;
            if (r < I_H) { p0_transpose_item<false>(args.in[I_HGWIN], 1024, 5120, Whg, scr, r, lane); continue; } r -= I_H;
            p0_transpose_item<false>(args.in[I_HGWOUT], 1024, 1024, Whgo, scr, r, lane);
        }
        __syncthreads();
        if ((int)blockIdx.x < 96) {
            LAS float* Ssil = (LAS float*)lds; LAS float* red = (LAS float*)(lds + 36864);
            for (int i = tid; i < 9 * 1024; i += NWAVES * 64) { const int r = i >> 10, k = i & 1023; const float v = r < 8 ? args.in[I_C][r * 1024 + k] : args.in[I_CCTX][k]; Ssil[i] = v / (1.0f + expf(-v)); }
            __syncthreads();
            for (int it = blockIdx.x; it < 96; it += G) {
                const int l = it / 48, col0 = (it % 48) * 128, cgp = tid & 31, ksl = tid >> 5;
                const float* W = args.in[I_WMOD] + (size_t)l * 1024 * NMOD + col0 + 4 * cgp;
                f32x4 a[9];
#pragma unroll
                for (int r = 0; r < 9; ++r) a[r] = (f32x4){0.f, 0.f, 0.f, 0.f};
                for (int kk = 0; kk < 64; ++kk) { const int k = ksl * 64 + kk; const f32x4 w = *(const f32x4*)(W + (size_t)k * NMOD);
#pragma unroll
                    for (int r = 0; r < 9; ++r) a[r] += w * Ssil[r * 1024 + k]; }
#pragma unroll
                for (int r = 0; r < 9; ++r) *(LAS f32x4*)(red + (ksl * 9 + r) * 128 + 4 * cgp) = a[r];
                __syncthreads();
                for (int o = tid; o < 9 * 128; o += NWAVES * 64) { const int r = o >> 7, cc = o & 127; float s = args.in[I_BMOD][l * NMOD + col0 + cc];
                    for (int q = 0; q < 16; ++q) s += red[(q * 9 + r) * 128 + cc];
                    MOD[(size_t)(l * 9 + r) * NMOD + col0 + cc] = s; }
                __syncthreads();
            }
        }
        { const int first = G >= 128 ? 96 : 0, nb_ = G >= 128 ? 32 : G;
          if ((int)blockIdx.x >= first && (int)blockIdx.x < first + nb_) { __syncthreads();
            for (int g5 = (int)blockIdx.x - first; g5 < 32; g5 += nb_)
                s5_tables_item(lds, g5, args.in[I_S5ARE], args.in[I_S5AIM], args.in[I_S5DT], args.in[I_S5BRE], args.in[I_S5BIM], args.in[I_S5CRE], args.in[I_S5CIM], Bc, Ws5); } }
        const int gt = gw * 64 + lane, NT = NGW * 64;
        for (int i = gt; i < SEQL * 32; i += NT) { const int t = i >> 5, dd = i & 31; const float inv = powf(10000.0f, -(float)(dd & 15) / 16.0f);
            const float a = (dd < 16 ? (float)(t >> 6) : (float)(t & 63)) * inv; CS[2 * i] = cosf(a); CS[2 * i + 1] = sinf(a); }
        for (int i = gt; i < 2 * 32 * 64; i += NT) {
            const float dt = expf(args.in[I_S5DT][i >> 6]); const float are = args.in[I_S5ARE][i], aim = args.in[I_S5AIM][i];
            const float mag = expf(are * dt), ang = aim * dt; const float abr = mag * cosf(ang), abi = mag * sinf(ang);
            const float nr = abr - 1.0f, ni = abi, den = are * are + aim * aim; const float fr = (nr * are + ni * aim) / den, fi = (ni * are - nr * aim) / den;
            AB[i] = (f32x2){abr, abi}; (void)fr; (void)fi;
        }
        for (int i = gt; i < 2 * 1024; i += NT) { const int d = i >> 10, j = i & 1023; const float x0 = args.in[I_HGLB][(d * 2 + 0) * 1024 + j], x1 = args.in[I_HGLB][(d * 2 + 1) * 1024 + j];
            const float mx = fmaxf(x0, x1), e0 = expf(x0 - mx), e1 = expf(x1 - mx); const float g0 = e0 / (e0 + e1), g1 = e1 / (e0 + e1); LB[i] = (g0 + g1) - g0; }
    }
    GRID_BAR();
    norm_mod_rows(args.in[I_X], args.in[I_CTX], MT, args.in[I_NMIX], MOD, 0, DM, XN, gw, NGW, lane);
    GRID_BAR();
    { pg8::Gemm g{XN, Win0, MT, 2048, 1024, 1024, 1024}; pg8::StaticOrder S; S.init(MT, 2048, G, (int)blockIdx.x); EpiProj0 E{P0b, CS, UA};
      pg8::gemm_phase<EpiProj0, pg8::StaticOrder, true, true>(lds + RING_OFF, g, S, E); }
    GRID_BAR();
    { pg8::Gemm g{UA, Ws5, 32 * S5RP, 32 * 256, 512, S5K, 512}; pg8::BatchOrder S; S.init(32, 5, 1, G, (int)blockIdx.x); EpiHloc E{HLOC};
      pg8::gemm_phase<EpiHloc, pg8::BatchOrder, true, true>(lds + RING_OFF, g, S, E);
      __syncthreads();
      for (int it = (int)blockIdx.x; it < 32 * RCH; it += G) ret_passA_item(lds, it, P0b, args.in[I_RETL], ULOC); }
    GRID_BAR();
    s5_scan(HLOC, UA, AB, gw, NGW, lane);
    ret_scan(ULOC, SIN, args.in[I_RETL], gw * 64 + lane, NGW * 64);
    GRID_BAR();
    { pg8::Gemm g{UA, Bc, 32 * S5RP, 32 * 512, S5K, S5K, S5K}; pg8::BatchOrder S; S.init(32, 5, 2, G, (int)blockIdx.x); EpiS5Out E{UA, args.in[I_S5D], Yb};
      pg8::gemm_phase<EpiS5Out, pg8::BatchOrder, true, true>(lds + RING_OFF, g, S, E);
      __syncthreads();
      for (int it = (int)blockIdx.x; it < 32 * RCH; it += G) ret_passC_item(lds, it, P0b, args.in[I_RETL], SIN, RZ); }
    GRID_BAR();
    { pg8::Gemm g{Yb, Wglu, MT, 512, 512, 512, 512}; pg8::StaticOrder S; S.init(MT, 512, G, (int)blockIdx.x); EpiGlu E{Yb, args.in[I_S5BGLU], RZ + 512};
      pg8::gemm_phase<EpiGlu, pg8::StaticOrder, true, true>(lds + RING_OFF, g, S, E); }
    GRID_BAR();
    { pg8::Gemm g{RZ, Wout0, MT, 1024, 1024, 1024, 1024}; pg8::StaticOrder S; S.init(MT, 1024, G, (int)blockIdx.x); EpiResid E{args.in[I_X], args.in[I_CTX], OUT, HC, MOD + 2 * DM};
      pg8::gemm_phase<EpiResid, pg8::StaticOrder, true, true>(lds + RING_OFF, g, S, E); }
    GRID_BAR();
    norm_mod_rows(OUT, HC, MT, args.in[I_NMLP], MOD, 3 * DM, 4 * DM, XN, gw, NGW, lane);
    GRID_BAR();
    { pg8::Gemm g{XN, W1t0, MT, DFF, 1024, 1024, 1024}; pg8::StaticOrder S; S.init(MT, DFF, G, (int)blockIdx.x); EpiSqrelu E{Hb};
      pg8::gemm_phase<EpiSqrelu, pg8::StaticOrder, true, true>(lds + RING_OFF, g, S, E); }
    GRID_BAR();
    { pg8::Gemm g{Hb, W2t0, MT, 1024, DFF, DFF, DFF}; pg8::StaticOrder S; S.init(MT, 1024, G, (int)blockIdx.x); EpiResid E{OUT, HC, OUT, HC, MOD + 5 * DM};
      pg8::gemm_phase<EpiResid, pg8::StaticOrder, true, true>(lds + RING_OFF, g, S, E); }
    GRID_BAR();
    const float* MOD1 = MOD + (size_t)9 * NMOD;
    norm_mod_rows(OUT, HC, MT, args.in[I_NMIX] + DM, MOD1, 0, DM, XN, gw, NGW, lane);
    GRID_BAR();
    { pg8::Gemm g{XN, Whg, MT, 5120, 1024, 1024, 1024}; pg8::StaticOrder S; S.init(MT, 5120, G, (int)blockIdx.x); EpiProj1 E{P1b, LB};
      pg8::gemm_phase<EpiProj1, pg8::StaticOrder, true, true>(lds + RING_OFF, g, S, E); }
    GRID_BAR();
    for (int i = blockIdx.x; i < 256; i += G) hgrn_item(lds, i, P1b, OS, ws);
    GRID_BAR();
    merge1_rows(OS, ws, P1b, args.in[I_HGNORM], gw, NGW, lane);
    GRID_BAR();
    { pg8::Gemm g{OS, Whgo, ML, 1024, 1024, 1024, 1024}; pg8::StaticOrder S; S.init(ML, 1024, G, (int)blockIdx.x); EpiResid E{OUT, HC, OUT, HC, MOD1 + 2 * DM};
      pg8::gemm_phase<EpiResid, pg8::StaticOrder, true, true>(lds + RING_OFF, g, S, E); }
    GRID_BAR();
    norm_mod_rows(OUT, HC, ML, args.in[I_NMLP] + DM, MOD1, 3 * DM, 4 * DM, XN, gw, NGW, lane);
    GRID_BAR();
    { pg8::Gemm g{XN, W1t1, ML, DFF, 1024, 1024, 1024}; pg8::StaticOrder S; S.init(ML, DFF, G, (int)blockIdx.x); EpiSqrelu E{Hb};
      pg8::gemm_phase<EpiSqrelu, pg8::StaticOrder, true, true>(lds + RING_OFF, g, S, E); }
    GRID_BAR();
    { pg8::Gemm g{Hb, W2t1, ML, 1024, DFF, DFF, DFF}; pg8::StaticOrder S; S.init(ML, 1024, G, (int)blockIdx.x); EpiResid E{OUT, HC, OUT, HC, MOD1 + 5 * DM};
      pg8::gemm_phase<EpiResid, pg8::StaticOrder, true, true>(lds + RING_OFF, g, S, E); }
    GRID_BAR();
    final_norm_rows(OUT, args.in[I_NFIN], gw, NGW, lane);
}

extern "C" void kernel_launch(void* const* d_in, const int* in_sizes, int n_in, void* d_out, int out_size, void* d_ws, size_t ws_size, hipStream_t stream) {
    static int grid = 0;
    if (grid == 0) {
        if (n_in != 28 || in_sizes[0] != ML * DM || out_size != ML * DM || ws_size < WS_END) { fprintf(stderr, "kernel_launch: unexpected shapes (n_in %d, in0 %d, out %d, ws %zu)\n", n_in, n_in > 0 ? in_sizes[0] : -1, out_size, ws_size); grid = -1; return; }
        int dev = 0, cus = 0, per_cu = 0;
        if (hipGetDevice(&dev) != hipSuccess || hipDeviceGetAttribute(&cus, hipDeviceAttributeMultiprocessorCount, dev) != hipSuccess) { grid = -1; return; }
        if (hipFuncSetAttribute((const void*)mk_fwd, hipFuncAttributeMaxDynamicSharedMemorySize, LDS_BYTES) != hipSuccess) { fprintf(stderr, "kernel_launch: hipFuncSetAttribute failed\n"); grid = -1; return; }
        if (hipOccupancyMaxActiveBlocksPerMultiprocessor(&per_cu, (const void*)mk_fwd, NWAVES * 64, LDS_BYTES) != hipSuccess || per_cu < 1) { fprintf(stderr, "kernel_launch: occupancy query says %d blocks per CU\n", per_cu); }
        (void)hipGetLastError();
        grid = cus;
    }
    if (grid < 0) return;
    if (hipMemsetAsync((char*)d_ws + WS_CTL, 0, CTL_ZERO_BYTES, stream) != hipSuccess) return;
    Args a{};
    for (int i = 0; i < 28; ++i) a.in[i] = (const float*)d_in[i];
    a.out = (float*)d_out; a.ws = (unsigned char*)d_ws;
    hipLaunchKernelGGL(mk_fwd, dim3(grid), dim3(NWAVES * 64), LDS_BYTES, stream, a);
}
```

```cpp
#include <hip/hip_runtime.h>
#include <cstdio>
#include <cstdint>

namespace pg8 {
#define PG8_LAS __attribute__((address_space(3)))
typedef unsigned short bf16_t;
typedef short bf16x8 __attribute__((ext_vector_type(8)));
typedef float f32x4 __attribute__((ext_vector_type(4)));
typedef unsigned u32x4 __attribute__((ext_vector_type(4)));
constexpr int BM = 256, BK = 64, HALF = 128, HTB = HALF * BK * 2, STAGE_BYTES = 8 * HTB, NXCD = 8, WGM = 8;

__host__ __device__ __forceinline__ int lds_byte(int r, int c) { const int st = (r >> 4) * 2 + (c >> 5), rr = r & 15, cc = c & 31, ob = rr * 64 + cc * 2; return st * 1024 + (ob ^ (((ob >> 9) & 1) << 5)); }
__host__ __device__ __forceinline__ void stage_rc(int b, int& R, int& C) { const int st = b / 1024, sb = b % 1024, swz = sb ^ (((sb >> 9) & 1) << 5); R = (st >> 1) * 16 + swz / 64; C = (st & 1) * 32 + (swz % 64) / 2; }
__host__ __device__ __forceinline__ int perm32(int rho) { const int n = rho >> 4, i = rho & 15; return 8 * (i >> 2) + 4 * n + (i & 3); }

struct Unit { int pm, pn; };
struct Gemm { const bf16_t* A; const bf16_t* Bt; int M, N, K, lda, ldb; };

struct StaticOrder {
    int nM, nN, nwg, G, c;
    __host__ __device__ void init(int M, int N, int G_, int c_) { nM = M / BM; nN = N / BM; nwg = nM * nN; G = G_; c = c_; }
    __host__ __device__ bool next(int i, Unit& u) const {
        const long L = (long)i * G + c; if (L >= nwg) return false;
        int wgid = (int)L; { const int q = nwg / NXCD, r = nwg % NXCD, xcd = wgid % NXCD, off = wgid / NXCD; wgid = (xcd < r ? xcd * (q + 1) : r * (q + 1) + (xcd - r) * q) + off; }
        const int nig = WGM * nN, gid = wgid / nig, fm = gid * WGM, gsz = (nM - fm) < WGM ? (nM - fm) : WGM;
        u.pm = fm + ((wgid % nig) % gsz); u.pn = (wgid % nig) / gsz; return true;
    }
    __device__ __forceinline__ void a_ready(const Unit&) const {}
    __device__ __forceinline__ void done(const Unit&) const {}
};

struct BatchOrder {
    int nb, tm, tn, G, c;
    __host__ __device__ void init(int nb_, int tm_, int tn_, int G_, int c_) { nb = nb_; tm = tm_; tn = tn_; G = G_; c = c_; }
    __host__ __device__ bool next(int i, Unit& u) const {
        const long L = (long)i * G + c; if (c < 0 || L >= (long)nb * tm * tn) return false;
        const int per = tm * tn, g = (int)L / per, rem = (int)L % per;
        u.pm = g * tm + rem % tm; u.pn = g * tn + rem / tm; return true;
    }
    __device__ __forceinline__ void a_ready(const Unit&) const {}
    __device__ __forceinline__ void done(const Unit&) const {}
};

struct SingleUnit {
    int pm, pn; bool valid;
    __host__ __device__ bool next(int i, Unit& u) const { if (i != 0 || !valid) return false; u.pm = pm; u.pn = pn; return true; }
    __device__ __forceinline__ void a_ready(const Unit&) const {}
    __device__ __forceinline__ void done(const Unit&) const {}
};

__device__ __forceinline__ unsigned cvt_pk_bf16(float lo, float hi) { unsigned r; asm volatile("v_cvt_pk_bf16_f32 %0, %1, %2" : "=v"(r) : "v"(lo), "v"(hi)); return r; }

template <class Epi, class Sched, bool ALIGN_EPI = false, bool SP2 = false>
__device__ __forceinline__ void gemm_phase(PG8_LAS unsigned char* lds, const Gemm g, const Sched& S, const Epi& E) {
    int tid_ = threadIdx.x; asm volatile("" : "+v"(tid_));
    const int tid = tid_, wid = __builtin_amdgcn_readfirstlane(tid >> 6), lane = tid & 63, wr = wid >> 2, wc = wid & 3, fr = lane & 15, fq = lane >> 4;
    const int K = g.K, nt = K / BK;
    unsigned voffA[2], voffB[2];
#pragma unroll
    for (int i = 0; i < 2; ++i) { int R, C; stage_rc(tid * 16 + i * 8192, R, C); const int Rb = Epi::PERM ? ((R & ~31) + perm32(R & 31)) : R;
        voffA[i] = (unsigned)(R * g.lda + C) * 2u; voffB[i] = (unsigned)(Rb * g.ldb + C) * 2u; }
    const size_t kstep = (size_t)(BK * 2);
    const size_t hstepA = (size_t)HALF * g.lda * 2, hstepB = (size_t)HALF * g.ldb * 2;
    const size_t tstepA = 2 * hstepA, tstepB = 2 * hstepB;
    const unsigned ldsw = (unsigned)wid * 1024u;
    const int aoff = lds_byte(wr * 64 + fr, fq * 8), boff = lds_byte(wc * 32 + fr, fq * 8);
#define PG8_SA(b, h) (((b) * 2 + (h)) * HTB)
#define PG8_SB(b, h) ((4 + (b) * 2 + (h)) * HTB)
#define PG8_STAGE(bufoff, gbase, voff) do { _Pragma("unroll") for (int _i = 0; _i < 2; ++_i) \
        __builtin_amdgcn_global_load_lds((const unsigned*)((const char*)(gbase) + (voff)[_i]), (PG8_LAS unsigned*)(lds + (bufoff) + ldsw + _i * 8192), 16, 0, 0); } while (0)
#define PG8_LDA(dst, b, h) do { _Pragma("unroll") for (int m = 0; m < 4; ++m) _Pragma("unroll") for (int k = 0; k < 2; ++k) dst[m][k] = *(const PG8_LAS bf16x8*)(lds + PG8_SA(b, h) + aoff + m * 2048 + k * 1024); } while (0)
#define PG8_LDB(dst, b, h) do { _Pragma("unroll") for (int n = 0; n < 2; ++n) _Pragma("unroll") for (int k = 0; k < 2; ++k) dst[n][k] = *(const PG8_LAS bf16x8*)(lds + PG8_SB(b, h) + boff + n * 2048 + k * 1024); } while (0)
#define PG8_MMA(ai, bj, At, Bt) do { __builtin_amdgcn_s_setprio(1); _Pragma("unroll") for (int m = 0; m < 4; ++m) _Pragma("unroll") for (int n = 0; n < 2; ++n) _Pragma("unroll") for (int k = 0; k < 2; ++k) \
        acc[ai][bj][m][n] = __builtin_amdgcn_mfma_f32_16x16x32_bf16(Bt[n][k], At[m][k], acc[ai][bj][m][n], 0, 0, 0); __builtin_amdgcn_s_setprio(0); } while (0)
#define PG8_WAIT_V(n) asm volatile("s_waitcnt vmcnt(" #n ")" ::: "memory")
#define PG8_WAIT_L(n) asm volatile("s_waitcnt lgkmcnt(" #n ")" ::: "memory")
#define PG8_BAR __builtin_amdgcn_s_barrier()
#define PG8_SCHED __builtin_amdgcn_sched_barrier(0)
    Unit cur, nxt; int ui = 0;
    if (!S.next(0, cur)) return;
    f32x4 acc[2][2][4][2];
#pragma unroll
    for (int a = 0; a < 2; ++a)
#pragma unroll
        for (int b = 0; b < 2; ++b)
#pragma unroll
            for (int m = 0; m < 4; ++m)
#pragma unroll
                for (int n = 0; n < 2; ++n) acc[a][b][m][n] = (f32x4){0.f, 0.f, 0.f, 0.f};
    bf16x8 At[4][2], B0[2][2], B1[2][2];
    const char* cA = (const char*)g.A + (size_t)cur.pm * tstepA; const char* cB = (const char*)g.Bt + (size_t)cur.pn * tstepB;
    S.a_ready(cur);
    if constexpr (SP2) {
        PG8_STAGE(PG8_SB(0, 0), cB, voffB); PG8_STAGE(PG8_SB(0, 1), cB + hstepB, voffB); PG8_STAGE(PG8_SA(0, 0), cA, voffA); PG8_STAGE(PG8_SA(0, 1), cA + hstepA, voffA);
        if (wr == 1) PG8_BAR;
        PG8_WAIT_V(2); PG8_BAR;
        PG8_STAGE(PG8_SB(1, 0), cB + kstep, voffB); PG8_STAGE(PG8_SA(1, 0), cA + kstep, voffA); PG8_STAGE(PG8_SB(1, 1), cB + hstepB + kstep, voffB);
        PG8_WAIT_V(6); PG8_BAR;
    } else {
        PG8_STAGE(PG8_SB(0, 0), cB, voffB); PG8_STAGE(PG8_SA(0, 0), cA, voffA); PG8_STAGE(PG8_SB(0, 1), cB + hstepB, voffB); PG8_STAGE(PG8_SA(0, 1), cA + hstepA, voffA);
        if (wr == 1) PG8_BAR;
        PG8_WAIT_V(4); PG8_BAR;
        PG8_STAGE(PG8_SB(1, 0), cB + kstep, voffB); PG8_STAGE(PG8_SA(1, 0), cA + kstep, voffA); PG8_STAGE(PG8_SB(1, 1), cB + hstepB + kstep, voffB);
        PG8_WAIT_V(6); PG8_BAR;
    }
    for (;;) {
        const bool has_next = S.next(ui + 1, nxt);
        const char* nA = has_next ? (const char*)g.A + (size_t)nxt.pm * tstepA : cA; const char* nB = has_next ? (const char*)g.Bt + (size_t)nxt.pn * tstepB : cB;
        for (int t = 0; t < nt; t += 2) {
            const bool last = (t == nt - 2);
            const char* a1 = cA + (size_t)(t + 1) * kstep;
            const char* a2 = last ? nA : cA + (size_t)(t + 2) * kstep; const char* b2 = last ? nB : cB + (size_t)(t + 2) * kstep;
            const char* a3 = a2 + kstep; const char* b3 = b2 + kstep;
            if (last && has_next) S.a_ready(nxt);
            if constexpr (SP2) {
            PG8_LDB(B0, 0, 0); PG8_LDB(B1, 0, 1); PG8_SCHED; PG8_LDA(At, 0, 0); PG8_STAGE(PG8_SA(1, 1), a1 + hstepA, voffA);
            PG8_WAIT_V(8); PG8_WAIT_L(0); PG8_BAR; PG8_MMA(0, 0, At, B0); PG8_MMA(0, 1, At, B1); PG8_BAR; PG8_SCHED;
            PG8_LDA(At, 0, 1); PG8_STAGE(PG8_SB(0, 0), b2, voffB); PG8_STAGE(PG8_SB(0, 1), b2 + hstepB, voffB); PG8_STAGE(PG8_SA(0, 0), a2, voffA);
            PG8_WAIT_V(8); PG8_WAIT_L(0); PG8_BAR; PG8_MMA(1, 0, At, B0); PG8_MMA(1, 1, At, B1); PG8_BAR; PG8_SCHED;
            PG8_LDB(B0, 1, 0); PG8_LDB(B1, 1, 1); PG8_SCHED; PG8_LDA(At, 1, 0); PG8_STAGE(PG8_SA(0, 1), a2 + hstepA, voffA);
            PG8_WAIT_V(8); PG8_WAIT_L(0); PG8_BAR; PG8_MMA(0, 0, At, B0); PG8_MMA(0, 1, At, B1); PG8_BAR; PG8_SCHED;
            PG8_LDA(At, 1, 1); PG8_STAGE(PG8_SB(1, 0), b3, voffB); PG8_STAGE(PG8_SB(1, 1), b3 + hstepB, voffB); PG8_STAGE(PG8_SA(1, 0), a3, voffA);
            PG8_WAIT_V(8); PG8_WAIT_L(0); PG8_BAR; PG8_MMA(1, 0, At, B0); PG8_MMA(1, 1, At, B1); PG8_BAR; PG8_SCHED;
            } else {
            PG8_LDB(B0, 0, 0); PG8_SCHED; PG8_LDA(At, 0, 0); PG8_STAGE(PG8_SA(1, 1), a1 + hstepA, voffA);
            PG8_WAIT_L(8); PG8_BAR; PG8_WAIT_L(0); PG8_MMA(0, 0, At, B0); PG8_BAR; PG8_SCHED;
            PG8_LDB(B1, 0, 1); PG8_STAGE(PG8_SB(0, 0), b2, voffB);
            PG8_BAR; PG8_WAIT_L(0); PG8_MMA(0, 1, At, B1); PG8_BAR;
            PG8_LDA(At, 0, 1); PG8_STAGE(PG8_SA(0, 0), a2, voffA);
            PG8_BAR; PG8_WAIT_L(0); PG8_MMA(1, 0, At, B0); PG8_BAR; PG8_SCHED;
            PG8_STAGE(PG8_SB(0, 1), b2 + hstepB, voffB);
            PG8_WAIT_V(6); PG8_BAR; PG8_MMA(1, 1, At, B1); PG8_BAR;
            PG8_LDB(B0, 1, 0); PG8_SCHED; PG8_LDA(At, 1, 0); PG8_STAGE(PG8_SA(0, 1), a2 + hstepA, voffA);
            PG8_WAIT_L(8); PG8_BAR; PG8_WAIT_L(0); PG8_MMA(0, 0, At, B0); PG8_BAR; PG8_SCHED;
            PG8_LDB(B1, 1, 1); PG8_STAGE(PG8_SB(1, 0), b3, voffB);
            PG8_BAR; PG8_WAIT_L(0); PG8_MMA(0, 1, At, B1); PG8_BAR;
            PG8_LDA(At, 1, 1); PG8_STAGE(PG8_SA(1, 0), a3, voffA);
            PG8_BAR; PG8_WAIT_L(0); PG8_MMA(1, 0, At, B0); PG8_BAR; PG8_SCHED;
            PG8_STAGE(PG8_SB(1, 1), b3 + hstepB, voffB);
            PG8_WAIT_V(6); PG8_BAR; PG8_MMA(1, 1, At, B1); PG8_BAR;
            }
        }
        if constexpr (ALIGN_EPI) { if (wr == 0) PG8_BAR; }
        if constexpr (!Epi::AFTER_DRAIN) { E(acc, cur, wr, wc, fr, fq); S.done(cur); }
        if (!has_next) break;
#pragma unroll
        for (int a = 0; a < 2; ++a)
#pragma unroll
            for (int b = 0; b < 2; ++b)
#pragma unroll
                for (int m = 0; m < 4; ++m)
#pragma unroll
                    for (int n = 0; n < 2; ++n) acc[a][b][m][n] = (f32x4){0.f, 0.f, 0.f, 0.f};
        cur = nxt; cA = nA; cB = nB; ++ui;
        if constexpr (ALIGN_EPI) { if (wr == 1) PG8_BAR; }
    }
    PG8_WAIT_V(0);
    if constexpr (!ALIGN_EPI) { if (wr == 0) PG8_BAR; }
    PG8_BAR;
#undef PG8_SA
#undef PG8_SB
#undef PG8_STAGE
#undef PG8_LDA
#undef PG8_LDB
#undef PG8_MMA
#undef PG8_WAIT_V
#undef PG8_WAIT_L
#undef PG8_BAR
#undef PG8_SCHED
}
}

#define GAS __attribute__((address_space(1)))
#define LAS __attribute__((address_space(3)))
typedef unsigned short bf16;
typedef unsigned v4u __attribute__((ext_vector_type(4)));
typedef unsigned v2u __attribute__((ext_vector_type(2)));
typedef float f32x4 __attribute__((ext_vector_type(4)));
typedef float f32x2 __attribute__((ext_vector_type(2)));

constexpr int NWAVES = 8;
constexpr int DM = 1024, NBATCH = 8, SEQL = 4096, CTXL = 256, DFF = 4096;
constexpr int ML = NBATCH * SEQL;
constexpr int MC = NBATCH * CTXL;
constexpr int MT = ML + MC;
constexpr int NMOD = 6 * DM;
constexpr float EPSN = 1e-6f;

constexpr size_t MiB = 1u << 20;
constexpr size_t WS_CTL = 0, CTL_ZERO_BYTES = 1 * MiB;
constexpr size_t WS_MOD = 1 * MiB;
constexpr size_t WS_CS = 2 * MiB;
constexpr size_t WS_S5T = 3 * MiB;
constexpr size_t WS_S5T_BB = WS_S5T + 32768, WS_LB = WS_S5T_BB + 524288;
constexpr size_t WS_HC = 4 * MiB;
constexpr size_t WS_WIN0 = 12 * MiB, WS_WOUT0 = 16 * MiB, WS_WGLU = 18 * MiB, WS_W1_0 = 19 * MiB, WS_W2_0 = 27 * MiB, WS_W1_1 = 35 * MiB, WS_W2_1 = 43 * MiB, WS_WHG = 51 * MiB, WS_WHGO = 61 * MiB;
__host__ __device__ __forceinline__ size_t ws_ob(int b) { return b < 5 ? 472 * MiB + (size_t)b * 8 * MiB : (b < 7 ? 12 * MiB + (size_t)(b - 5) * 8 * MiB : 4 * MiB); }
constexpr size_t WS_XN = 64 * MiB;
constexpr size_t WS_BIG = 132 * MiB;
constexpr int P0LD = 1536;
constexpr size_t WS_P0 = WS_BIG;
constexpr int S5R = 1088, S5RP = 1280, S5K = 768;
constexpr size_t WS_UA = WS_BIG + 102 * MiB;
constexpr size_t WS_BC = WS_BIG + 162 * MiB;
constexpr size_t WS_WS5 = WS_BIG + 186 * MiB;
constexpr size_t WS_ULOC = WS_BIG + 194 * MiB;
constexpr size_t WS_SIN = WS_BIG + 228 * MiB;
constexpr size_t WS_RZ = WS_BIG + 262 * MiB;
constexpr size_t WS_HLOC = WS_XN;
constexpr size_t WS_H = WS_BIG;
constexpr size_t WS_P1 = WS_BIG;
constexpr size_t WS_Y = 472 * MiB;
constexpr size_t WS_END = 512 * MiB;

constexpr int CW_BAR = 4096;

constexpr int RING_OFF = 0, RING_BYTES = 131072;
constexpr int LDSCTL_OFF = 143360, MISC_OFF = LDSCTL_OFF + 320;
constexpr int LDS_BYTES = 147456;

typedef GAS unsigned gu32;
#define LDS_WAIT() asm volatile("s_waitcnt lgkmcnt(0)" ::: "memory")
typedef __bf16 hwbf2 __attribute__((ext_vector_type(2)));
__device__ __forceinline__ unsigned pk2(float lo, float hi) { hwbf2 v; v.x = (__bf16)lo; v.y = (__bf16)hi; return __builtin_bit_cast(unsigned, v); }
__device__ __forceinline__ unsigned f2bf(float f) { return (unsigned)__builtin_bit_cast(unsigned short, (__bf16)f); }
__device__ __forceinline__ float bflo(unsigned w) { return __builtin_bit_cast(float, w << 16); }
__device__ __forceinline__ float bfhi(unsigned w) { return __builtin_bit_cast(float, w & 0xffff0000u); }
__device__ __forceinline__ float bf2f(bf16 h) { return __builtin_bit_cast(float, (unsigned)h << 16); }
typedef _Float16 h16x2 __attribute__((ext_vector_type(2)));
__device__ __forceinline__ unsigned pk_f16(float a, float b) { h16x2 v; v.x = (_Float16)a; v.y = (_Float16)b; return __builtin_bit_cast(unsigned, v); }
__device__ __forceinline__ float f16lo(unsigned w) { h16x2 v = __builtin_bit_cast(h16x2, w); return (float)v.x; }
__device__ __forceinline__ float f16hi(unsigned w) { h16x2 v = __builtin_bit_cast(h16x2, w); return (float)v.y; }
__device__ __forceinline__ float sigmoidf_(float x) { return 1.0f / (1.0f + __expf(-x)); }
__device__ __forceinline__ float siluf_(float x) { return x / (1.0f + __expf(-x)); }
__device__ __forceinline__ float gelu_tanh(float x) { const float u = 0.7978845608028654f * (x + 0.044715f * x * x * x); return 0.5f * x * (1.0f + tanhf(u)); }

#define XB_TMO      128
#define XB_XCNT(j)  (256  + 64 * (j))
#define XB_XSUB(j)  (1280 + 64 * (j))
#define XB_XGEN(j)  (2304 + 64 * (j))
#define XB_TOP      3328
#define XB_TOPGEN   3392
#define XCD_BAR_WORDS 3456
#define XB_SPIN_CAP (1u << 22)
__device__ __forceinline__ unsigned xb_ld(unsigned* p)              { return __hip_atomic_load(p, __ATOMIC_RELAXED, __HIP_MEMORY_SCOPE_AGENT); }
__device__ __forceinline__ unsigned xb_add(unsigned* p, unsigned v) { return __hip_atomic_fetch_add(p, v, __ATOMIC_RELAXED, __HIP_MEMORY_SCOPE_AGENT); }
__device__ __forceinline__ unsigned xb_xcc_id() { return (unsigned)__builtin_amdgcn_s_getreg((3 << 11) | 20) & 0xFu; }
#define XB_SPIN(cond, bar) do { unsigned _sp = 0; while (cond) { __builtin_amdgcn_s_sleep(1); \
    if ((++_sp & 255u) == 0u) { if (xb_ld(&(bar)[XB_TMO])) break; if (_sp > XB_SPIN_CAP) { atomicAdd(&(bar)[XB_TMO], 1u); break; } } } } while (0)
struct XcdBarrier { unsigned* bar; unsigned x; volatile LAS unsigned* st; };
__device__ __forceinline__ XcdBarrier xcd_barrier_post(unsigned* bar, volatile LAS unsigned* st) {
    XcdBarrier b; b.bar = bar; b.x = xb_xcc_id(); b.st = st;
    if (threadIdx.x == 0) (void)xb_add(&bar[XB_XCNT(b.x)], 1u);
    return b;
}
__device__ __forceinline__ void xcd_barrier_complete(unsigned* bar, unsigned x, unsigned& nloc, unsigned& nx) {
    const unsigned G = gridDim.x * gridDim.y * gridDim.z;
    unsigned sum, cnt, mine, sp = 0u;
    for (;;) {
        sum = 0u; cnt = 0u; mine = 0u;
#pragma unroll
        for (unsigned j = 0; j < 16; ++j) { const unsigned c = xb_ld(&bar[XB_XCNT(j)]); sum += c; cnt += (c > 0u) ? 1u : 0u; mine = (j == x) ? c : mine; }
        if (sum == G) break;
        __builtin_amdgcn_s_sleep(1);
        if ((++sp & 255u) == 0u) { if (xb_ld(&bar[XB_TMO])) break; if (sp > XB_SPIN_CAP) { atomicAdd(&bar[XB_TMO], 1u); break; } }
    }
    nloc = mine > 0u ? mine : 1u; nx = cnt > 0u ? cnt : 1u;
}
__device__ __forceinline__ void xcd_barrier(const XcdBarrier& b) {
    asm volatile("s_waitcnt vmcnt(0)" ::: "memory");
    __syncthreads();
    if (threadIdx.x == 0) {
        unsigned* bar = b.bar;
        __builtin_amdgcn_s_waitcnt(0);
        unsigned nloc = b.st[0], nx = b.st[1];
        if (nloc == 0u) { xcd_barrier_complete(bar, b.x, nloc, nx); b.st[0] = nloc; b.st[1] = nx; }
        const unsigned old = xb_add(&bar[XB_XSUB(b.x)], 1u);
        const unsigned gen = old / nloc;
        if (old + 1u == (gen + 1u) * nloc) {
            __builtin_amdgcn_fence(__ATOMIC_RELEASE, "agent");
            asm volatile("s_waitcnt vmcnt(0)" ::: "memory");
            const unsigned og = xb_add(&bar[XB_TOP], 1u);
            const unsigned tg = og / nx;
            if (og + 1u == (tg + 1u) * nx) xb_add(&bar[XB_TOPGEN], 1u);
            else XB_SPIN(xb_ld(&bar[XB_TOPGEN]) == tg, bar);
            __builtin_amdgcn_fence(__ATOMIC_ACQUIRE, "agent");
            xb_add(&bar[XB_XGEN(b.x)], 1u);
            asm volatile("s_waitcnt vmcnt(0)" ::: "memory");
        } else {
            XB_SPIN(xb_ld(&bar[XB_XGEN(b.x)]) == gen, bar);
            __builtin_amdgcn_fence(__ATOMIC_ACQUIRE, "agent");
            asm volatile("s_waitcnt vmcnt(0)" ::: "memory");
        }
    }
    __syncthreads();
}

__device__ __forceinline__ float wave_sum(float v) {
#pragma unroll
    for (int o = 1; o < 64; o <<= 1) v += __shfl_xor(v, o);
    return v;
}
__device__ __forceinline__ float sum16(float v) {
#pragma unroll
    for (int o = 1; o < 16; o <<= 1) v += __shfl_xor(v, o);
    return v;
}

__device__ __forceinline__ int rowof(int n, int b, int dir) {
    if (n < CTXL) { const int tc = dir ? (CTXL - 1 - n) : n; return ML + b * CTXL + tc; }
    const int tl = n - CTXL; const int t = dir ? (SEQL - 1 - tl) : tl; return b * SEQL + t;
}

__device__ __forceinline__ int permqk(int n) {
    const int d = n & 63, half = d >> 5, dd = d & 31, i = dd >> 2, j = dd & 3; return (n & ~63) + 8 * i + 4 * half + j;
}
template <bool PERMQK>
__device__ __forceinline__ void p0_transpose_item(const float* W, int K, int N, bf16* WT, LAS float* scr, int item, int lane) {
    const int nblk = N / 32, kb = item / nblk, nb = item % nblk, k0 = 64 * kb, n0 = 32 * nb;
#pragma unroll 8
    for (int i = 0; i < 32; ++i) { const int kk = 2 * i + (lane >> 5); scr[kk * 33 + (lane & 31)] = W[(size_t)(k0 + kk) * N + n0 + (lane & 31)]; }
    LDS_WAIT(); asm volatile("" ::: "memory");
    const int c = lane & 7;
#pragma unroll
    for (int j = 0; j < 4; ++j) { const int n = (lane >> 3) + 8 * j; const LAS float* s = scr + (8 * c) * 33 + n;
        v4u o; o.x = pk2(s[0 * 33], s[1 * 33]); o.y = pk2(s[2 * 33], s[3 * 33]); o.z = pk2(s[4 * 33], s[5 * 33]); o.w = pk2(s[6 * 33], s[7 * 33]);
        int nd = n0 + n; if (PERMQK && nd < 512) nd = permqk(nd);
        *(GAS v4u*)(WT + (size_t)nd * K + k0 + 8 * c) = o; }
    LDS_WAIT(); asm volatile("" ::: "memory");
}

__device__ __forceinline__ void norm_mod_rows(const float* hl, const float* hc, int nrows, const float* g, const float* mod, int shift_off, int scale_off, bf16* XN, int gw, int NGW, int lane,
                                              const float* slabs = nullptr, int nsl = 0, const float* cgate = nullptr, float* hcw = nullptr) {
    for (int row = gw; row < nrows; row += NGW) {
        const float* xr = row < ML ? hl + (size_t)row * DM : hc + (size_t)(row - ML) * DM;
        const int mr = row < ML ? (row >> 12) : 8;
        const f32x4* x4 = (const f32x4*)xr + lane;
        f32x4 v[4]; float s = 0.f;
#pragma unroll
        for (int j = 0; j < 4; ++j) v[j] = x4[64 * j];
        if (nsl > 0 && row >= ML) {
            const f32x4* p4 = (const f32x4*)(slabs + (size_t)(row - ML) * DM) + lane; const f32x4* g4c = (const f32x4*)cgate + lane;
            f32x4 a[4] = {(f32x4){0.f, 0.f, 0.f, 0.f}, (f32x4){0.f, 0.f, 0.f, 0.f}, (f32x4){0.f, 0.f, 0.f, 0.f}, (f32x4){0.f, 0.f, 0.f, 0.f}};
            for (int k = 0; k < nsl; ++k) {
#pragma unroll
                for (int j = 0; j < 4; ++j) a[j] += p4[(size_t)k * (MC * DM / 4) + 64 * j]; }
            f32x4* w4 = (f32x4*)(hcw + (size_t)(row - ML) * DM) + lane;
#pragma unroll
            for (int j = 0; j < 4; ++j) { v[j] = v[j] + g4c[64 * j] * a[j]; w4[64 * j] = v[j]; }
        }
#pragma unroll
        for (int j = 0; j < 4; ++j) s += (v[j].x * v[j].x + v[j].y * v[j].y) + (v[j].z * v[j].z + v[j].w * v[j].w);
        const float rstd = 1.0f / sqrtf(wave_sum(s) * (1.f / DM) + EPSN);
        const f32x4* g4 = (const f32x4*)g + lane; const f32x4* sc4 = (const f32x4*)(mod + (size_t)mr * NMOD + scale_off) + lane; const f32x4* sh4 = (const f32x4*)(mod + (size_t)mr * NMOD + shift_off) + lane;
        unsigned long long* o8 = (unsigned long long*)(XN + (size_t)row * DM) + lane;
#pragma unroll
        for (int j = 0; j < 4; ++j) { const f32x4 gg = g4[64 * j], sc = sc4[64 * j], sh = sh4[64 * j];
            const f32x4 y = (v[j] * rstd) * gg * (sc + 1.0f) + sh;
            o8[64 * j] = (unsigned long long)pk2(y.x, y.y) | ((unsigned long long)pk2(y.z, y.w) << 32); }
    }
}
__device__ __forceinline__ void final_norm_rows(float* h, const float* g, int gw, int NGW, int lane) {
    for (int row = gw; row < ML; row += NGW) {
        f32x4* x4 = (f32x4*)(h + (size_t)row * DM) + lane;
        f32x4 v[4]; float s = 0.f;
#pragma unroll
        for (int j = 0; j < 4; ++j) { v[j] = x4[64 * j]; s += (v[j].x * v[j].x + v[j].y * v[j].y) + (v[j].z * v[j].z + v[j].w * v[j].w); }
        const float rstd = 1.0f / sqrtf(wave_sum(s) * (1.f / DM) + EPSN);
        const f32x4* g4 = (const f32x4*)g + lane;
#pragma unroll
        for (int j = 0; j < 4; ++j) x4[64 * j] = (v[j] * rstd) * g4[64 * j];
    }
}
__device__ __forceinline__ void unpack8(const v4u w, float (&o)[8]) { o[0] = bflo(w.x); o[1] = bfhi(w.x); o[2] = bflo(w.y); o[3] = bfhi(w.y); o[4] = bflo(w.z); o[5] = bfhi(w.z); o[6] = bflo(w.w); o[7] = bfhi(w.w); }
__device__ __forceinline__ v4u pack8(const float (&o)[8]) { v4u w; w.x = pk2(o[0], o[1]); w.y = pk2(o[2], o[3]); w.z = pk2(o[4], o[5]); w.w = pk2(o[6], o[7]); return w; }

__device__ __forceinline__ void merge1_rows(bf16* OS, const unsigned char* ws, const bf16* P1, const float* hgn, int gw, int NGW, int lane) {
    for (int row = gw; row < ML; row += NGW) {
#pragma unroll
        for (int half = 0; half < 2; ++half) {
            const int c0 = half * 512 + lane * 8;
            const v4u ow = *(const v4u*)(OS + (size_t)row * 1024 + c0), gw4 = *(const v4u*)(P1 + (size_t)row * 5120 + 4096 + c0);
            const v4u ob = *(const v4u*)((const bf16*)(ws + ws_ob(row >> 12)) + (size_t)(row & (SEQL - 1)) * 1024 + c0);
            const f32x4 n0 = *(const f32x4*)(hgn + (c0 & 127)), n1 = *(const f32x4*)(hgn + (c0 & 127) + 4);
            float o[8], gg[8], o2[8]; unpack8(ow, o); unpack8(gw4, gg); unpack8(ob, o2);
            float ss = 0.f;
#pragma unroll
            for (int i = 0; i < 8; ++i) o[i] += o2[i];
#pragma unroll
            for (int i = 0; i < 8; ++i) ss += o[i] * o[i];
            const float rs = 1.0f / sqrtf(sum16(ss) * (1.f / 128.f) + EPSN);
            const float nn[8] = {n0.x, n0.y, n0.z, n0.w, n1.x, n1.y, n1.z, n1.w};
            float r[8];
#pragma unroll
            for (int i = 0; i < 8; ++i) r[i] = o[i] * rs * nn[i] * siluf_(gg[i]);
            *(v4u*)(OS + (size_t)row * 1024 + c0) = pack8(r);
        }
    }
}

using pg8::Unit; using pg8::HALF; using pg8::BM;
__device__ __forceinline__ v4u pack2x4(const f32x4 v0, const f32x4 v1) { v4u w; w.x = pg8::cvt_pk_bf16(v0[0], v0[1]); w.y = pg8::cvt_pk_bf16(v0[2], v0[3]); w.z = pg8::cvt_pk_bf16(v1[0], v1[1]); w.w = pg8::cvt_pk_bf16(v1[2], v1[3]); return w; }

struct EpiProj0 {
    static constexpr bool PERM = true, AFTER_DRAIN = false;
    bf16* O; const float* CS; bf16* UA;
    __device__ __forceinline__ void operator()(const f32x4 (&acc)[2][2][4][2], const Unit& u, int wr, int wc, int fr, int fq) const {
        const int row0 = u.pm * BM + wr * 64 + fr, col0 = u.pn * BM + wc * 32 + 8 * fq;
        const bool lat = u.pm < ML / BM;
        const bool rope = (u.pn < 2) && lat; const float sc = (u.pn == 1) ? 0.125f : 1.0f;
        const bool isu = (u.pn == 4) || (u.pn == 5);
        const int ocol0 = (u.pn >= 6) ? col0 - 512 : col0;
        const int i4 = 4 * (4 * (wc & 1) + fq);
#pragma unroll
        for (int ai = 0; ai < 2; ++ai)
#pragma unroll
            for (int m = 0; m < 4; ++m) { const int row = row0 + ai * HALF + m * 16;
                f32x4 ca = (f32x4){1.f, 0.f, 1.f, 0.f}, cb = ca;
                if (rope) { const float* p = CS + ((size_t)(row & (SEQL - 1)) * 32 + i4) * 2; ca = *(const f32x4*)p; cb = *(const f32x4*)(p + 4); }
                bf16* rowp = O + (size_t)row * P0LD + ocol0;
                int r5, i5;
                if (lat) { const int t = row & (SEQL - 1); r5 = (row >> 12) * 136 + 8 + (t >> 5); i5 = t & 31; }
                else { const int rc = row - ML, t = rc & (CTXL - 1); r5 = (rc >> 8) * 136 + (t >> 5); i5 = t & 31; }
#pragma unroll
                for (int bj = 0; bj < 2; ++bj) { f32x4 v0 = acc[ai][bj][m][0], v1 = acc[ai][bj][m][1];
                    if (rope) {
                        const f32x4 lo = (f32x4){v0[0] * ca[0] - v1[0] * ca[1], v0[1] * ca[2] - v1[1] * ca[3], v0[2] * cb[0] - v1[2] * cb[1], v0[3] * cb[2] - v1[3] * cb[3]};
                        const f32x4 hi = (f32x4){v0[0] * ca[1] + v1[0] * ca[0], v0[1] * ca[3] + v1[1] * ca[2], v0[2] * cb[1] + v1[2] * cb[0], v0[3] * cb[3] + v1[3] * cb[2]};
                        v0 = lo; v1 = hi; }
                    v0 = v0 * sc; v1 = v1 * sc;
                    const v4u w = pack2x4(v0, v1);
                    if (isu) { const int c = col0 + bj * HALF - 1024, g5 = c >> 4, m0 = c & 15;
                        *(v4u*)(UA + ((size_t)(g5 * S5RP + r5) * S5K + i5 * 16 + m0)) = w; }
                    else *(v4u*)(rowp + bj * HALF) = w; } }
    }
};
struct EpiGlu {
    static constexpr bool PERM = true, AFTER_DRAIN = false;
    const bf16* Y; const float* b; bf16* Z;
    __device__ __forceinline__ void operator()(const f32x4 (&acc)[2][2][4][2], const Unit& u, int wr, int wc, int fr, int fq) const {
        const int row0 = u.pm * BM + wr * 64 + fr, col0 = u.pn * BM + wc * 32 + 8 * fq;
        f32x4 bv[2][2];
#pragma unroll
        for (int bj = 0; bj < 2; ++bj)
#pragma unroll
            for (int n = 0; n < 2; ++n) bv[bj][n] = *(const f32x4*)(b + col0 + bj * HALF + 4 * n);
#pragma unroll
        for (int ai = 0; ai < 2; ++ai)
#pragma unroll
            for (int m = 0; m < 4; ++m) { const int row = row0 + ai * HALF + m * 16;
#pragma unroll
                for (int bj = 0; bj < 2; ++bj) { const int col = col0 + bj * HALF;
                    const v4u yw = *(const v4u*)(Y + (size_t)row * 512 + col); float yy[8]; unpack8(yw, yy);
                    const f32x4 a0 = acc[ai][bj][m][0] + bv[bj][0], a1 = acc[ai][bj][m][1] + bv[bj][1];
                    const f32x4 z0 = (f32x4){yy[0] * sigmoidf_(a0[0]), yy[1] * sigmoidf_(a0[1]), yy[2] * sigmoidf_(a0[2]), yy[3] * sigmoidf_(a0[3])};
                    const f32x4 z1 = (f32x4){yy[4] * sigmoidf_(a1[0]), yy[5] * sigmoidf_(a1[1]), yy[6] * sigmoidf_(a1[2]), yy[7] * sigmoidf_(a1[3])};
                    *(v4u*)(Z + (size_t)row * 1024 + col) = pack2x4(z0, z1); } }
    }
};
struct EpiResid {
    static constexpr bool PERM = false, AFTER_DRAIN = false;
    const float* baseL; const float* baseC; float* outL; float* outC; const float* gate;
    __device__ __forceinline__ void operator()(const f32x4 (&acc)[2][2][4][2], const Unit& u, int wr, int wc, int fr, int fq) const {
        const bool ctx = u.pm >= ML / BM; const int mr = ctx ? 8 : (u.pm >> 4);
        const int row0 = (ctx ? u.pm - ML / BM : u.pm) * BM + wr * 64 + fr, col0 = u.pn * BM + wc * 32 + 4 * fq;
        const float* B = ctx ? baseC : baseL; float* Oo = ctx ? outC : outL;
        f32x4 gv[2][2];
#pragma unroll
        for (int bj = 0; bj < 2; ++bj)
#pragma unroll
            for (int n = 0; n < 2; ++n) gv[bj][n] = *(const f32x4*)(gate + (size_t)mr * NMOD + col0 + bj * HALF + n * 16);
#pragma unroll
        for (int ai = 0; ai < 2; ++ai)
#pragma unroll
            for (int m = 0; m < 4; ++m) { const size_t off = (size_t)(row0 + ai * HALF + m * 16) * DM + col0;
#pragma unroll
                for (int bj = 0; bj < 2; ++bj)
#pragma unroll
                    for (int n = 0; n < 2; ++n) { const f32x4 bs = *(const f32x4*)(B + off + bj * HALF + n * 16);
                        *(f32x4*)(Oo + off + bj * HALF + n * 16) = bs + gv[bj][n] * acc[ai][bj][m][n]; } }
    }
};
struct EpiPart {
    static constexpr bool PERM = false, AFTER_DRAIN = false;
    float* C;
    __device__ __forceinline__ void operator()(const f32x4 (&acc)[2][2][4][2], const Unit& u, int wr, int wc, int fr, int fq) const {
        const int row0 = u.pm * BM + wr * 64 + fr, col0 = u.pn * BM + wc * 32 + 4 * fq;
#pragma unroll
        for (int ai = 0; ai < 2; ++ai)
#pragma unroll
            for (int m = 0; m < 4; ++m) { float* rowp = C + (size_t)(row0 + ai * HALF + m * 16) * DM + col0;
#pragma unroll
                for (int bj = 0; bj < 2; ++bj)
#pragma unroll
                    for (int n = 0; n < 2; ++n) *(f32x4*)(rowp + bj * HALF + n * 16) = acc[ai][bj][m][n]; }
    }
};
struct EpiSqrelu {
    static constexpr bool PERM = true, AFTER_DRAIN = false;
    bf16* O;
    __device__ __forceinline__ void operator()(const f32x4 (&acc)[2][2][4][2], const Unit& u, int wr, int wc, int fr, int fq) const {
        const int row0 = u.pm * BM + wr * 64 + fr, col0 = u.pn * BM + wc * 32 + 8 * fq;
#pragma unroll
        for (int ai = 0; ai < 2; ++ai)
#pragma unroll
            for (int m = 0; m < 4; ++m) { bf16* rowp = O + (size_t)(row0 + ai * HALF + m * 16) * DFF + col0;
#pragma unroll
                for (int bj = 0; bj < 2; ++bj) { f32x4 v0 = acc[ai][bj][m][0], v1 = acc[ai][bj][m][1];
                    v0 = __builtin_elementwise_max(v0, (f32x4){0.f, 0.f, 0.f, 0.f}); v1 = __builtin_elementwise_max(v1, (f32x4){0.f, 0.f, 0.f, 0.f});
                    *(v4u*)(rowp + bj * HALF) = pack2x4(v0 * v0, v1 * v1); } }
    }
};
struct EpiProj1 {
    static constexpr bool PERM = true, AFTER_DRAIN = false;
    bf16* O; const float* LB;
    __device__ __forceinline__ void operator()(const f32x4 (&acc)[2][2][4][2], const Unit& u, int wr, int wc, int fr, int fq) const {
        const int row0 = u.pm * BM + wr * 64 + fr, col0 = u.pn * BM + wc * 32 + 8 * fq;
        const int kind = u.pn >> 2;
        const bool gatek = (kind == 1) || (kind == 2);
        f32x4 lb[2][2];
#pragma unroll
        for (int bj = 0; bj < 2; ++bj)
#pragma unroll
            for (int n = 0; n < 2; ++n) lb[bj][n] = gatek ? *(const f32x4*)(LB + (size_t)(kind - 1) * 1024 + ((col0 + bj * HALF) & 1023) + 4 * n) : (f32x4){0.f, 0.f, 0.f, 0.f};
#pragma unroll
        for (int ai = 0; ai < 2; ++ai)
#pragma unroll
            for (int m = 0; m < 4; ++m) { bf16* rowp = O + (size_t)(row0 + ai * HALF + m * 16) * 5120 + col0;
#pragma unroll
                for (int bj = 0; bj < 2; ++bj) { const f32x4 v0 = acc[ai][bj][m][0], v1 = acc[ai][bj][m][1];
                    v4u w;
                    if (gatek) {
                        float l0[4], l1[4];
#pragma unroll
                        for (int i = 0; i < 4; ++i) { l0[i] = __logf(lb[bj][0][i] + (1.0f - lb[bj][0][i]) * sigmoidf_(v0[i])); l1[i] = __logf(lb[bj][1][i] + (1.0f - lb[bj][1][i]) * sigmoidf_(v1[i])); }
                        w.x = pk_f16(l0[0], l0[1]); w.y = pk_f16(l0[2], l0[3]); w.z = pk_f16(l1[0], l1[1]); w.w = pk_f16(l1[2], l1[3]);
                    } else w = pack2x4(v0, v1);
                    *(v4u*)(rowp + bj * HALF) = w; } }
    }
};

struct EpiHloc {
    static constexpr bool PERM = false, AFTER_DRAIN = false;
    float* C;
    __device__ __forceinline__ void operator()(const f32x4 (&acc)[2][2][4][2], const Unit& u, int wr, int wc, int fr, int fq) const {
        const int row0 = u.pm * BM + wr * 64 + fr, col0 = wc * 32 + 4 * fq;
#pragma unroll
        for (int ai = 0; ai < 2; ++ai)
#pragma unroll
            for (int m = 0; m < 4; ++m) { float* rowp = C + (size_t)(row0 + ai * HALF + m * 16) * 256 + col0;
#pragma unroll
                for (int bj = 0; bj < 2; ++bj)
#pragma unroll
                    for (int n = 0; n < 2; ++n) *(f32x4*)(rowp + bj * HALF + n * 16) = acc[ai][bj][m][n]; }
    }
};
struct EpiS5Out {
    static constexpr bool PERM = true, AFTER_DRAIN = false;
    const bf16* UA; const float* dskip; bf16* Y;
    __device__ __forceinline__ void operator()(const f32x4 (&acc)[2][2][4][2], const Unit& u, int wr, int wc, int fr, int fq) const {
        const int g5 = u.pm / 5, pml = u.pm - 5 * g5, pnl = u.pn - 2 * g5;
        const int r0 = pml * BM + wr * 64 + fr, col0 = pnl * BM + wc * 32 + 8 * fq;
#pragma unroll
        for (int ai = 0; ai < 2; ++ai)
#pragma unroll
            for (int m = 0; m < 4; ++m) { const int r = r0 + ai * HALF + m * 16;
                if (r < S5R) {
                    const int b = r / 136, ch = r - b * 136;
#pragma unroll
                    for (int bj = 0; bj < 2; ++bj) { const int col = col0 + bj * HALF, i5 = col >> 4, m0 = col & 15;
                        const int trow = ch < 8 ? ML + b * CTXL + ch * 32 + i5 : b * SEQL + (ch - 8) * 32 + i5;
                        const v4u uw = *(const v4u*)(UA + ((size_t)(g5 * S5RP + r) * S5K + col)); float uu[8]; unpack8(uw, uu);
                        const f32x4 d0 = *(const f32x4*)(dskip + g5 * 16 + m0), d1 = *(const f32x4*)(dskip + g5 * 16 + m0 + 4);
                        const f32x4 a0 = acc[ai][bj][m][0], a1 = acc[ai][bj][m][1];
                        const f32x4 y0 = (f32x4){gelu_tanh(a0[0] + d0[0] * uu[0]), gelu_tanh(a0[1] + d0[1] * uu[1]), gelu_tanh(a0[2] + d0[2] * uu[2]), gelu_tanh(a0[3] + d0[3] * uu[3])};
                        const f32x4 y1 = (f32x4){gelu_tanh(a1[0] + d1[0] * uu[4]), gelu_tanh(a1[1] + d1[1] * uu[5]), gelu_tanh(a1[2] + d1[2] * uu[6]), gelu_tanh(a1[3] + d1[3] * uu[7])};
                        *(v4u*)(Y + (size_t)trow * 512 + g5 * 16 + m0) = pack2x4(y0, y1); } } }
    }
};

__device__ __forceinline__ f32x2 cmul(f32x2 a, f32x2 b) { return (f32x2){a.x * b.x - a.y * b.y, a.x * b.y + a.y * b.x}; }
__device__ __forceinline__ void s5_tables_item(LAS unsigned char* lds, int g, const float* a_re, const float* a_im, const float* log_dt, const float* b_re, const float* b_im,
                                               const float* c_re, const float* c_im, bf16* Bc, bf16* Ws5) {
    const int tid = threadIdx.x;
    LAS f32x2* POW = (LAS f32x2*)lds;
    LAS f32x2* BBl = (LAS f32x2*)(lds + 33792);
    LAS f32x2* CCl = (LAS f32x2*)(lds + 50176);
    LAS float* KRN = (LAS float*)(lds + 66560);
    if (tid < 128) {
        const int d = tid >> 6, p = tid & 63, i = (d * 32 + g) * 64 + p;
        const float dt = expf(log_dt[d * 32 + g]); const float are = a_re[i], aim = a_im[i];
        const float mag = expf(are * dt), ang = aim * dt; const f32x2 ab = (f32x2){mag * cosf(ang), mag * sinf(ang)};
        const float nr = ab.x - 1.0f, ni = ab.y, den = are * are + aim * aim; const float fr = (nr * are + ni * aim) / den, fi = (ni * are - nr * aim) / den;
        f32x2 pw = (f32x2){1.f, 0.f};
        for (int e = 0; e <= 32; ++e) { POW[(d * 64 + p) * 33 + e] = pw; pw = cmul(pw, ab); }
        for (int n = 0; n < 16; ++n) { const float br = b_re[(size_t)i * 16 + n], bi = b_im[(size_t)i * 16 + n]; BBl[(d * 64 + p) * 16 + n] = (f32x2){fr * br - fi * bi, fr * bi + fi * br}; }
    }
    for (int o = tid; o < 2048; o += NWAVES * 64) { const int d = o >> 10, m = (o >> 6) & 15, p = o & 63; const size_t ci = ((size_t)(d * 32 + g) * 16 + m) * 64 + p; CCl[o] = (f32x2){c_re[ci], c_im[ci]}; }
    __syncthreads();
    for (int k = 0; k < 8; ++k) { const int o4 = tid + 512 * k, d = o4 >> 11, tau = (o4 >> 6) & 31, m = (o4 >> 2) & 15, nq = o4 & 3;
        float a0 = 0.f, a1 = 0.f, a2 = 0.f, a3 = 0.f;
        for (int p = 0; p < 64; ++p) { const f32x2 cp = cmul(CCl[(d * 16 + m) * 64 + p], POW[(d * 64 + p) * 33 + tau]); const LAS f32x2* bb = BBl + (d * 64 + p) * 16 + nq * 4;
            a0 += cp.x * bb[0].x - cp.y * bb[0].y; a1 += cp.x * bb[1].x - cp.y * bb[1].y; a2 += cp.x * bb[2].x - cp.y * bb[2].y; a3 += cp.x * bb[3].x - cp.y * bb[3].y; }
        *(LAS f32x4*)(KRN + ((d * 32 + tau) * 16 + m) * 16 + nq * 4) = (f32x4){a0, a1, a2, a3}; }
    __syncthreads();
    for (int k = 0; k < 96; ++k) { const int ch = tid + 512 * k, row = ch / 96, kc = ch - row * 96, k0 = kc * 8, i = row >> 4, m = row & 15;
        float v[8];
        if (k0 < 512) { const int j = k0 >> 4, n0 = k0 & 15;
            if (i > j) { const LAS float* s = KRN + ((0 * 32 + (i - j)) * 16 + m) * 16 + n0;
#pragma unroll
                for (int t = 0; t < 8; ++t) v[t] = s[t]; }
            else if (i < j) { const LAS float* s = KRN + ((1 * 32 + (j - i)) * 16 + m) * 16 + n0;
#pragma unroll
                for (int t = 0; t < 8; ++t) v[t] = s[t]; }
            else { const LAS float* s0 = KRN + ((0 * 32 + 0) * 16 + m) * 16 + n0; const LAS float* s1 = KRN + ((1 * 32 + 0) * 16 + m) * 16 + n0;
#pragma unroll
                for (int t = 0; t < 8; ++t) v[t] = s0[t] + s1[t]; }
        } else { const int q0 = k0 - 512, d = q0 >> 7, p0 = (q0 & 127) >> 1, e = d == 0 ? i + 1 : 32 - i;
#pragma unroll
            for (int t = 0; t < 4; ++t) { const f32x2 ca = cmul(CCl[(d * 16 + m) * 64 + p0 + t], POW[(d * 64 + p0 + t) * 33 + e]); v[2 * t] = ca.x; v[2 * t + 1] = -ca.y; } }
        *(v4u*)(Bc + ((size_t)(g * 512 + row) * S5K + k0)) = pack8(v); }
    for (int k = 0; k < 32; ++k) { const int ch = tid + 512 * k, q = ch >> 6, kc = ch & 63, k0 = kc * 8, j = k0 >> 4, n0 = k0 & 15;
        const int d = q >> 7, p = (q & 127) >> 1, ri = q & 1, ef = d == 0 ? 31 - j : j;
        const f32x2 pw = POW[(d * 64 + p) * 33 + ef]; float v[8];
#pragma unroll
        for (int t = 0; t < 8; ++t) { const f32x2 w = cmul(pw, BBl[(d * 64 + p) * 16 + n0 + t]); v[t] = ri ? w.y : w.x; }
        *(v4u*)(Ws5 + ((size_t)(g * 256 + q) * 512 + k0)) = pack8(v); }
    __syncthreads();
}
__device__ __forceinline__ void s5_scan(const float* HL, bf16* UA, const f32x2* AB, int gw, int NGW, int lane) {
    for (int w = gw; w < 512; w += NGW) {
        const int b = w >> 6, g = (w >> 1) & 31, d = w & 1;
        f32x2 a32 = AB[(d * 32 + g) * 64 + lane];
#pragma unroll
        for (int i = 0; i < 5; ++i) a32 = cmul(a32, a32);
        f32x2 h = (f32x2){0.f, 0.f};
        const size_t rbase = (size_t)g * S5RP + b * 136;
#pragma unroll 1
        for (int s0 = 0; s0 < 136; s0 += 34) {
            f32x2 hl[34];
#pragma unroll
            for (int k = 0; k < 34; ++k) { const int s = s0 + k, c = d == 0 ? s : (s < 8 ? 7 - s : 143 - s); hl[k] = *(const f32x2*)(HL + (rbase + c) * 256 + d * 128 + lane * 2); }
#pragma unroll
            for (int k = 0; k < 34; ++k) { const int s = s0 + k, c = d == 0 ? s : (s < 8 ? 7 - s : 143 - s);
                *(unsigned*)(UA + (rbase + c) * S5K + 512 + d * 128 + lane * 2) = pk2(h.x, h.y);
                h = cmul(a32, h) + hl[k]; }
        }
    }
}

typedef short bf16x8_t __attribute__((ext_vector_type(8)));
__device__ __forceinline__ bf16x8_t frag_rm(const LAS unsigned char* T, int RS, int r0, int k0, int lane) { return *(const LAS bf16x8_t*)(T + (r0 + (lane & 15)) * RS + (k0 + 8 * (lane >> 4)) * 2); }
#define MFMA16(a, b, c) __builtin_amdgcn_mfma_f32_16x16x32_bf16((a), (b), (c), 0, 0, 0)
typedef short v4i16_t __attribute__((ext_vector_type(4)));
__device__ __forceinline__ bf16x8_t frag_tr(const LAS unsigned char* T, int RS, int k0, int n0, int lane) {
    const int g = lane >> 4, q = (lane & 15) >> 2, p = lane & 3;
    const LAS unsigned char* a = T + (k0 + 8 * g + q) * RS + (n0 + 4 * p) * 2;
    const v4i16_t lo = __builtin_amdgcn_ds_read_tr16_b64_v4i16((LAS v4i16_t*)a);
    const v4i16_t hi = __builtin_amdgcn_ds_read_tr16_b64_v4i16((LAS v4i16_t*)(a + 4 * RS));
    return (bf16x8_t){lo[0], lo[1], lo[2], lo[3], hi[0], hi[1], hi[2], hi[3]};
}
__device__ __forceinline__ bf16x8_t scale_frag(bf16x8_t f, float sc) {
    const v4u w = __builtin_bit_cast(v4u, f); float t[8]; unpack8(w, t);
    v4u o; o.x = pk2(t[0] * sc, t[1] * sc); o.y = pk2(t[2] * sc, t[3] * sc); o.z = pk2(t[4] * sc, t[5] * sc); o.w = pk2(t[6] * sc, t[7] * sc);
    return __builtin_bit_cast(bf16x8_t, o);
}
constexpr int RCH = 34;
__device__ __forceinline__ int ret_row0(int b, int s) { return s < 2 ? ML + b * CTXL + s * 128 : b * SEQL + (s - 2) * 128; }
__device__ __forceinline__ void stage_v(LAS unsigned char* Vs, const bf16* P0, int row0, int h, int tid) {
#pragma unroll
    for (int k = 0; k < 4; ++k) { const int c = tid + 512 * k, j = c >> 4, ch = c & 15;
        *(LAS v4u*)(Vs + j * 272 + ch * 16) = *(const v4u*)(P0 + (size_t)(row0 + j) * P0LD + 512 + h * 128 + ch * 8); }
}
__device__ __forceinline__ void ret_passA_item(LAS unsigned char* lds, int it, const bf16* P0, const float* ret_logit, bf16* ULOC) {
    int tid_ = threadIdx.x; asm volatile("" : "+v"(tid_)); const int tid = tid_, lane = tid & 63, w = tid >> 6, g4 = lane >> 4;
    const int bh = it / RCH, s = it - bh * RCH, b = bh >> 2, h = bh & 3, row0 = ret_row0(b, s);
    const float lgf = log2f(1.0f / (1.0f + expf(-ret_logit[h]))), lgb = log2f(1.0f / (1.0f + expf(-ret_logit[4 + h])));
    LAS unsigned char* Kf = lds; LAS unsigned char* Kb = lds + 18432; LAS unsigned char* Vs = lds + 36864;
#pragma unroll
    for (int k = 0; k < 2; ++k) { const int c = tid + 512 * k, j = c >> 3, ch = c & 7;
        const v4u wv = *(const v4u*)(P0 + (size_t)(row0 + j) * P0LD + 256 + h * 64 + ch * 8); float t[8]; unpack8(wv, t);
        const float sf = exp2f((float)(127 - j) * lgf), sb = exp2f((float)j * lgb);
        v4u of, ob; of.x = pk2(t[0] * sf, t[1] * sf); of.y = pk2(t[2] * sf, t[3] * sf); of.z = pk2(t[4] * sf, t[5] * sf); of.w = pk2(t[6] * sf, t[7] * sf);
        ob.x = pk2(t[0] * sb, t[1] * sb); ob.y = pk2(t[2] * sb, t[3] * sb); ob.z = pk2(t[4] * sb, t[5] * sb); ob.w = pk2(t[6] * sb, t[7] * sb);
        *(LAS v4u*)(Kf + j * 144 + ch * 16) = of; *(LAS v4u*)(Kb + j * 144 + ch * 16) = ob; }
    stage_v(Vs, P0, row0, h, tid);
    __syncthreads();
    f32x4 acc[2][4];
#pragma unroll
    for (int d = 0; d < 2; ++d)
#pragma unroll
        for (int dt = 0; dt < 4; ++dt) acc[d][dt] = (f32x4){0.f, 0.f, 0.f, 0.f};
#pragma unroll
    for (int ks = 0; ks < 4; ++ks) { const bf16x8_t vb = frag_tr(Vs, 272, 32 * ks, 16 * w, lane);
#pragma unroll
        for (int dt = 0; dt < 4; ++dt) { acc[0][dt] = MFMA16(frag_tr(Kf, 144, 32 * ks, 16 * dt, lane), vb, acc[0][dt]); acc[1][dt] = MFMA16(frag_tr(Kb, 144, 32 * ks, 16 * dt, lane), vb, acc[1][dt]); } }
    const int e = 16 * w + (lane & 15);
#pragma unroll
    for (int d = 0; d < 2; ++d)
#pragma unroll
        for (int dt = 0; dt < 4; ++dt) { v2u o; o.x = pk2(acc[d][dt][0], acc[d][dt][1]); o.y = pk2(acc[d][dt][2], acc[d][dt][3]);
            *(v2u*)(ULOC + ((size_t)((bh * 2 + d) * RCH + s) * 128 + e) * 64 + 16 * dt + 4 * g4) = o; }
    __syncthreads();
}
__device__ __forceinline__ void ret_scan(const bf16* ULOC, bf16* SIN, const float* ret_logit, int gt, int NT) {
    for (int idx = gt; idx < 64 * 2048; idx += NT) {
        const int bhd = idx >> 11, off = (idx & 2047) * 4, dir = bhd & 1, h = (bhd >> 1) & 3;
        const float g128 = exp2f(128.0f * log2f(1.0f / (1.0f + expf(-ret_logit[dir * 4 + h]))));
        const size_t base = (size_t)bhd * RCH * 8192 + off;
        v2u u[RCH];
#pragma unroll
        for (int k = 0; k < RCH; ++k) { const int s = dir == 0 ? k : (k < 2 ? 1 - k : 35 - k); u[k] = *(const v2u*)(ULOC + base + (size_t)s * 8192); }
        float st[4] = {0.f, 0.f, 0.f, 0.f};
#pragma unroll
        for (int k = 0; k < RCH; ++k) { const int s = dir == 0 ? k : (k < 2 ? 1 - k : 35 - k);
            v2u o; o.x = pg8::cvt_pk_bf16(st[0], st[1]); o.y = pg8::cvt_pk_bf16(st[2], st[3]); *(v2u*)(SIN + base + (size_t)s * 8192) = o;
            st[0] = g128 * st[0] + bflo(u[k].x); st[1] = g128 * st[1] + bfhi(u[k].x); st[2] = g128 * st[2] + bflo(u[k].y); st[3] = g128 * st[3] + bfhi(u[k].y); }
    }
}
__device__ __forceinline__ void ret_passC_item(LAS unsigned char* lds, int it, const bf16* P0, const float* ret_logit, const bf16* SIN, bf16* RZ) {
    int tid_ = threadIdx.x; asm volatile("" : "+v"(tid_)); const int tid = tid_, lane = tid & 63, w = tid >> 6, g4 = lane >> 4, l15 = lane & 15;
    const int bh = it / RCH, s = it - bh * RCH, b = bh >> 2, h = bh & 3, row0 = ret_row0(b, s);
    const float lgf = log2f(1.0f / (1.0f + expf(-ret_logit[h]))), lgb = log2f(1.0f / (1.0f + expf(-ret_logit[4 + h])));
    LAS unsigned char* Qs = lds; LAS unsigned char* Ks = lds + 18432; LAS unsigned char* SfT = lds + 36864; LAS unsigned char* SbT = lds + 55296; LAS unsigned char* Vs = lds + 73728;
    LAS unsigned char* Pm = lds + 108544;
#pragma unroll
    for (int k = 0; k < 2; ++k) { const int c = tid + 512 * k, j = c >> 3, ch = c & 7;
        *(LAS v4u*)(Qs + j * 144 + ch * 16) = *(const v4u*)(P0 + (size_t)(row0 + j) * P0LD + h * 64 + ch * 8);
        *(LAS v4u*)(Ks + j * 144 + ch * 16) = *(const v4u*)(P0 + (size_t)(row0 + j) * P0LD + 256 + h * 64 + ch * 8);
        *(LAS v4u*)(SfT + j * 144 + ch * 16) = *(const v4u*)(SIN + ((size_t)((bh * 2 + 0) * RCH + s) * 128 + j) * 64 + ch * 8);
        *(LAS v4u*)(SbT + j * 144 + ch * 16) = *(const v4u*)(SIN + ((size_t)((bh * 2 + 1) * RCH + s) * 128 + j) * 64 + ch * 8); }
    stage_v(Vs, P0, row0, h, tid);
    const int il = 16 * w + l15;
    const size_t row = (size_t)(row0 + il);
    v2u gatew[8];
#pragma unroll
    for (int t = 0; t < 8; ++t) gatew[t] = *(const v2u*)(P0 + row * P0LD + 1024 + h * 128 + 16 * t + 4 * g4);
    __syncthreads();
    f32x4 accO[8], accA[8];
#pragma unroll
    for (int t = 0; t < 8; ++t) { accO[t] = (f32x4){0.f, 0.f, 0.f, 0.f}; accA[t] = (f32x4){0.f, 0.f, 0.f, 0.f}; }
    { const float af = exp2f((float)(il + 1) * lgf), ab = exp2f((float)(128 - il) * lgb);
#pragma unroll
      for (int ks = 0; ks < 2; ++ks) { const bf16x8_t q = frag_rm(Qs, 144, 16 * w, 32 * ks, lane); const bf16x8_t qf = scale_frag(q, af), qb = scale_frag(q, ab);
#pragma unroll
          for (int t = 0; t < 8; ++t) { accA[t] = MFMA16(frag_rm(Ks, 144, 16 * t, 32 * ks, lane), q, accA[t]);
              accO[t] = MFMA16(frag_rm(SfT, 144, 16 * t, 32 * ks, lane), qf, accO[t]); accO[t] = MFMA16(frag_rm(SbT, 144, 16 * t, 32 * ks, lane), qb, accO[t]); } } }
#pragma unroll
    for (int t = 0; t < 8; ++t) { float pv[4];
#pragma unroll
        for (int r = 0; r < 4; ++r) { const int j = 16 * t + 4 * g4 + r;
            const float dm = il > j ? exp2f((float)(il - j) * lgf) : (il < j ? exp2f((float)(j - il) * lgb) : 2.0f); pv[r] = accA[t][r] * dm; }
        v2u pw; pw.x = pk2(pv[0], pv[1]); pw.y = pk2(pv[2], pv[3]); *(LAS v2u*)(Pm + il * 272 + (16 * t + 4 * g4) * 2) = pw; }
    __syncthreads();
#pragma unroll
    for (int ks = 0; ks < 4; ++ks) { const bf16x8_t p = frag_rm(Pm, 272, 16 * w, 32 * ks, lane);
#pragma unroll
        for (int t = 0; t < 8; ++t) accO[t] = MFMA16(frag_tr(Vs, 272, 32 * ks, 16 * t, lane), p, accO[t]); }
    float ss = 0.f;
#pragma unroll
    for (int t = 0; t < 8; ++t) ss += (accO[t][0] * accO[t][0] + accO[t][1] * accO[t][1]) + (accO[t][2] * accO[t][2] + accO[t][3] * accO[t][3]);
    ss += __shfl_xor(ss, 16); ss += __shfl_xor(ss, 32);
    const float rs = 1.0f / sqrtf(ss * (1.f / 128.f) + EPSN);
#pragma unroll
    for (int t = 0; t < 8; ++t) { const float g0 = bflo(gatew[t].x), g1 = bfhi(gatew[t].x), g2 = bflo(gatew[t].y), g3 = bfhi(gatew[t].y);
        v2u o; o.x = pk2(accO[t][0] * rs * siluf_(g0), accO[t][1] * rs * siluf_(g1)); o.y = pk2(accO[t][2] * rs * siluf_(g2), accO[t][3] * rs * siluf_(g3));
        *(v2u*)(RZ + row * 1024 + h * 128 + 16 * t + 4 * g4) = o; }
    __syncthreads();
}
__device__ __forceinline__ int hg_row0(int b, int dir, int st) {
    if (st < 8) { const int c = dir ? 7 - st : st; return ML + b * CTXL + c * 32; }
    const int c = dir ? 135 - st : st - 8; return b * SEQL + c * 32;
}
struct HgRaw { v4u q0, q1, l0, l1, v; };
#define HG_ISSUE(R_, st_) do { const int r0_ = hg_row0(b, dir, (st_)); \
        const bf16* qp_ = P1 + (size_t)(r0_ + rtok) * 5120 + h * 128 + rseg; \
        (R_).q0 = *(const v4u*)qp_; (R_).q1 = *(const v4u*)(qp_ + (size_t)16 * 5120); (R_).l0 = *(const v4u*)(qp_ + 1024 + dir * 1024); (R_).l1 = *(const v4u*)(qp_ + (size_t)16 * 5120 + 1024 + dir * 1024); \
        (R_).v = *(const v4u*)(P1 + (size_t)(r0_ + tv) * 5120 + 3072 + h * 128 + eh * 64 + eseg); } while (0)
__device__ __forceinline__ float f16bits(unsigned short hbits) { return (float)__builtin_bit_cast(_Float16, hbits); }
__device__ __forceinline__ void hgrn_item(LAS unsigned char* lds, int it, const bf16* P1, bf16* OS, unsigned char* ws) {
    int tid_ = threadIdx.x; asm volatile("" : "+v"(tid_)); const int tid = tid_;
    const int lane = tid & 63, w = tid >> 6, g4 = lane >> 4, l15 = lane & 15;
    const bool fe = w >= 4;
    const int dir = it & 1, et = w & 3, td = tid & 255, tv = td >> 3, eseg = (td & 7) * 8;
    const int rtok = td >> 4, rseg = (td & 15) * 8;
    const int b = it >> 5, h = (it >> 2) & 7, eh = (it >> 1) & 1;
    LAS unsigned char* LR = lds + 71680;
#define HG_QI(p) (lds + (p) * 35840)
#define HG_KT(p) (lds + (p) * 35840 + 8704)
#define HG_VT(p) (lds + (p) * 35840 + 18944)
#define HG_PM(p) (lds + (p) * 35840 + 24064)
#define HG_KI(p) (lds + (p) * 35840 + 27136)
#define HG_DEC(p) ((LAS float*)(lds + (p) * 35840 + 26624))
    f32x4 S[8];
#pragma unroll
    for (int t = 0; t < 8; ++t) S[t] = (f32x4){0.f, 0.f, 0.f, 0.f};
    HgRaw R[4];
    v2u pend[2] = {(v2u){0u, 0u}, (v2u){0u, 0u}};
    if (fe) { HG_ISSUE(R[0], 0); HG_ISSUE(R[1], 1); HG_ISSUE(R[2], 2); }
#pragma unroll 1
    for (int s4 = 0; s4 < 140; s4 += 4) {
#pragma unroll
    for (int u = 0; u < 4; ++u) {
        const int sl = s4 + u;
        const int pf = sl & 1, pb = pf ^ 1;
        const bool fe_on = fe && sl < 136, be_on = !fe && sl >= 1 && sl <= 136;
        if (fe_on) {
            LAS unsigned char* QI = HG_QI(pf); LAS unsigned char* VT = HG_VT(pf);
            *(LAS v4u*)(QI + rtok * 272 + rseg * 2) = R[u].q0; *(LAS v4u*)(QI + (rtok + 16) * 272 + rseg * 2) = R[u].q1;
            *(LAS v4u*)(LR + rtok * 272 + rseg * 2) = R[u].l0; *(LAS v4u*)(LR + (rtok + 16) * 272 + rseg * 2) = R[u].l1;
            const v4u vr = R[u].v;
            LAS unsigned short* vp = (LAS unsigned short*)(VT + eseg * 80 + tv * 2);
            vp[0 * 40] = (unsigned short)(vr.x & 0xffffu); vp[1 * 40] = (unsigned short)(vr.x >> 16); vp[2 * 40] = (unsigned short)(vr.y & 0xffffu); vp[3 * 40] = (unsigned short)(vr.y >> 16);
            vp[4 * 40] = (unsigned short)(vr.z & 0xffffu); vp[5 * 40] = (unsigned short)(vr.z >> 16); vp[6 * 40] = (unsigned short)(vr.w & 0xffffu); vp[7 * 40] = (unsigned short)(vr.w >> 16);
            if (sl + 3 < 136) HG_ISSUE(R[(u + 3) & 3], sl + 3);
        }
        if (be_on) {
            if (sl >= 10) { const int prow = hg_row0(b, dir, sl - 2);
                bf16* obase = dir == 0 ? OS + (size_t)prow * 1024 : (bf16*)(ws + ws_ob(b)) + (size_t)(prow - b * SEQL) * 1024;
#pragma unroll
                for (int t2 = 0; t2 < 2; ++t2) *(v2u*)(obase + (size_t)(16 * t2 + l15) * 1024 + h * 128 + eh * 64 + 16 * et + 4 * g4) = pend[t2]; }
            LAS unsigned char* QI = HG_QI(pb); LAS unsigned char* KI = HG_KI(pb); LAS unsigned char* PM = HG_PM(pb);
            const int it1 = et >> 1, jt1 = et & 1;
            f32x4 ap = (f32x4){0.f, 0.f, 0.f, 0.f};
#pragma unroll
            for (int ks = 0; ks < 4; ++ks) ap = MFMA16(frag_rm(QI, 272, 16 * it1, 32 * ks, lane), frag_rm(KI, 272, 16 * jt1, 32 * ks, lane), ap);
#pragma unroll
            for (int r = 0; r < 4; ++r) { const int i = 16 * it1 + 4 * g4 + r, j = 16 * jt1 + l15; const bool keep = dir == 0 ? (j <= i) : (j >= i);
                *(LAS unsigned short*)(PM + i * 80 + j * 2) = keep ? (unsigned short)f2bf(ap[r]) : (unsigned short)0; }
        }
        __syncthreads();
        if (fe_on) {
            LAS unsigned char* QI = HG_QI(pf); LAS unsigned char* KT = HG_KT(pf); LAS float* DEC = HG_DEC(pf); LAS unsigned char* KI = HG_KI(pf);
            const int dpl = lane & 15, tq8 = lane >> 4, d0 = 2 * ((w & 3) * 16 + dpl), t0 = tq8 * 8;
            float la[8], lb[8], Ta = 0.f, Tb = 0.f;
#pragma unroll
            for (int i = 0; i < 8; ++i) { const unsigned wv = *(const LAS unsigned*)(LR + (t0 + i) * 272 + d0 * 2); la[i] = f16lo(wv); lb[i] = f16hi(wv); Ta += la[i]; Tb += lb[i]; }
            const float A0 = __shfl(Ta, dpl), A1 = __shfl(Ta, 16 + dpl), A2 = __shfl(Ta, 32 + dpl), A3 = __shfl(Ta, 48 + dpl);
            const float B0 = __shfl(Tb, dpl), B1 = __shfl(Tb, 16 + dpl), B2 = __shfl(Tb, 32 + dpl), B3 = __shfl(Tb, 48 + dpl);
            const float tota = (A0 + A1) + (A2 + A3), totb = (B0 + B1) + (B2 + B3);
            float basea, baseb;
            if (dir == 0) { basea = (tq8 > 0 ? A0 : 0.f) + (tq8 > 1 ? A1 : 0.f) + (tq8 > 2 ? A2 : 0.f); baseb = (tq8 > 0 ? B0 : 0.f) + (tq8 > 1 ? B1 : 0.f) + (tq8 > 2 ? B2 : 0.f); }
            else          { basea = (tq8 < 3 ? A3 : 0.f) + (tq8 < 2 ? A2 : 0.f) + (tq8 < 1 ? A1 : 0.f); baseb = (tq8 < 3 ? B3 : 0.f) + (tq8 < 2 ? B2 : 0.f) + (tq8 < 1 ? B1 : 0.f); }
            float ea = __expf(basea), eb = __expf(baseb); const float eta = __expf(tota), etb = __expf(totb);
            float koa[8], kob[8];
#pragma unroll
            for (int ii = 0; ii < 8; ++ii) { const int i = dir == 0 ? ii : 7 - ii;
                const float fa = __expf(la[i]), fb = __expf(lb[i]); ea *= fa; eb *= fb;
                LAS unsigned* qp = (LAS unsigned*)(QI + (t0 + i) * 272 + d0 * 2); const unsigned qw = *qp;
                const float kia = (1.0f - fa) * __builtin_amdgcn_rcpf(ea), kib = (1.0f - fb) * __builtin_amdgcn_rcpf(eb);
                *qp = pk2(bflo(qw) * ea, bfhi(qw) * eb);
                *(LAS unsigned*)(KI + (t0 + i) * 272 + d0 * 2) = pk2(kia, kib);
                koa[i] = kia * eta; kob[i] = kib * etb; }
            v4u k0, k1;
            k0.x = pk2(koa[0], koa[1]); k0.y = pk2(koa[2], koa[3]); k0.z = pk2(koa[4], koa[5]); k0.w = pk2(koa[6], koa[7]);
            k1.x = pk2(kob[0], kob[1]); k1.y = pk2(kob[2], kob[3]); k1.z = pk2(kob[4], kob[5]); k1.w = pk2(kob[6], kob[7]);
            *(LAS v4u*)(KT + d0 * 80 + t0 * 2) = k0; *(LAS v4u*)(KT + (d0 + 1) * 80 + t0 * 2) = k1;
            if (tq8 == 0) { DEC[d0] = eta; DEC[d0 + 1] = etb; }
        }
        if (be_on) {
            LAS unsigned char* QI = HG_QI(pb); LAS unsigned char* VT = HG_VT(pb); LAS unsigned char* PM = HG_PM(pb);
            LAS unsigned char* KT = HG_KT(pb); LAS float* DEC = HG_DEC(pb);
            bf16x8_t sb[4];
#pragma unroll
            for (int ks = 0; ks < 4; ++ks) { v4u t; t.x = pk2(S[2 * ks][0], S[2 * ks][1]); t.y = pk2(S[2 * ks][2], S[2 * ks][3]); t.z = pk2(S[2 * ks + 1][0], S[2 * ks + 1][1]); t.w = pk2(S[2 * ks + 1][2], S[2 * ks + 1][3]);
                sb[ks] = __builtin_bit_cast(bf16x8_t, t); }
            const bf16x8_t vfrag = frag_rm(VT, 80, 16 * et, 0, lane);
            f32x4 o[2];
#pragma unroll
            for (int t2 = 0; t2 < 2; ++t2) {
                o[t2] = MFMA16(vfrag, frag_rm(PM, 80, 16 * t2, 0, lane), ((f32x4){0.f, 0.f, 0.f, 0.f}));
#pragma unroll
                for (int ks = 0; ks < 4; ++ks) { const LAS unsigned char* qrow = QI + (16 * t2 + l15) * 272 + (32 * ks + 4 * g4) * 2;
                    const v2u qa = *(const LAS v2u*)qrow, qb = *(const LAS v2u*)(qrow + 32);
                    v4u qq; qq.x = qa.x; qq.y = qa.y; qq.z = qb.x; qq.w = qb.y;
                    o[t2] = MFMA16(sb[ks], __builtin_bit_cast(bf16x8_t, qq), o[t2]); }
            }
#pragma unroll
            for (int dt = 0; dt < 8; ++dt) { const f32x4 dv = *(const LAS f32x4*)(DEC + 16 * dt + 4 * g4);
                S[dt] = MFMA16(frag_rm(KT, 80, 16 * dt, 0, lane), vfrag, S[dt] * dv); }
#pragma unroll
            for (int t2 = 0; t2 < 2; ++t2) { pend[t2].x = pk2(o[t2][0], o[t2][1]); pend[t2].y = pk2(o[t2][2], o[t2][3]); }
        }
        __syncthreads();
    }
    }
    if (!fe) { const int prow = hg_row0(b, dir, 135);
      bf16* obase = dir == 0 ? OS + (size_t)prow * 1024 : (bf16*)(ws + ws_ob(b)) + (size_t)(prow - b * SEQL) * 1024;
#pragma unroll
      for (int t2 = 0; t2 < 2; ++t2) *(v2u*)(obase + (size_t)(16 * t2 + l15) * 1024 + h * 128 + eh * 64 + 16 * et + 4 * g4) = pend[t2]; }
    __syncthreads();
#undef HG_QI
#undef HG_KT
#undef HG_VT
#undef HG_PM
#undef HG_DEC
#undef HG_KI
}

struct Args { const float* in[28]; float* out; unsigned char* ws; };
enum { I_X = 0, I_C, I_CTX, I_CCTX, I_WMOD, I_BMOD, I_NMIX, I_NMLP, I_W1, I_W2, I_ABWIN, I_ABWOUT, I_RETL, I_S5ARE, I_S5AIM, I_S5DT, I_S5BRE, I_S5BIM, I_S5CRE, I_S5CIM, I_S5D, I_S5WGLU, I_S5BGLU, I_HGWIN, I_HGWOUT, I_HGLB, I_HGNORM, I_NFIN };

__global__ void __launch_bounds__(NWAVES * 64, 2) mk_fwd(Args args) {
    extern __shared__ __attribute__((aligned(16))) unsigned char lds_raw[];
    LAS unsigned char* lds = (LAS unsigned char*)lds_raw;
    volatile LAS unsigned* MISC = (volatile LAS unsigned*)(lds + MISC_OFF);
    const int tid = threadIdx.x, lane = tid & 63, wave = __builtin_amdgcn_readfirstlane(tid >> 6);
    const int G = gridDim.x;
    const int vcu = (G % 8 == 0) ? ((int)blockIdx.x % 8) * (G / 8) + (int)blockIdx.x / 8 : (int)blockIdx.x;
    const int gw = vcu * NWAVES + wave, NGW = G * NWAVES;
    unsigned char* ws = args.ws;
    gu32* ctl = (gu32*)(ws + WS_CTL);
    for (int u = tid; u < (LDS_BYTES - LDSCTL_OFF) / 4; u += NWAVES * 64) ((LAS unsigned*)(lds + LDSCTL_OFF))[u] = 0u;
    __syncthreads();
    XcdBarrier bar = xcd_barrier_post((unsigned*)(ctl + CW_BAR), MISC + 8);
#define GRID_BAR() xcd_barrier(bar)

    float* MOD = (float*)(ws + WS_MOD); float* CS = (float*)(ws + WS_CS);
    f32x2* AB = (f32x2*)(ws + WS_S5T); float* LB = (float*)(ws + WS_LB);
    float* HC = (float*)(ws + WS_HC);
    bf16* Win0 = (bf16*)(ws + WS_WIN0); bf16* Wout0 = (bf16*)(ws + WS_WOUT0); bf16* Wglu = (bf16*)(ws + WS_WGLU);
    bf16* W1t0 = (bf16*)(ws + WS_W1_0); bf16* W2t0 = (bf16*)(ws + WS_W2_0); bf16* W1t1 = (bf16*)(ws + WS_W1_1); bf16* W2t1 = (bf16*)(ws + WS_W2_1); bf16* Whg = (bf16*)(ws + WS_WHG); bf16* Whgo = (bf16*)(ws + WS_WHGO);
    bf16* XN = (bf16*)(ws + WS_XN); bf16* P0b = (bf16*)(ws + WS_P0); bf16* P1b = (bf16*)(ws + WS_P1); bf16* Hb = (bf16*)(ws + WS_H);
    bf16* ULOC = (bf16*)(ws + WS_ULOC); bf16* SIN = (bf16*)(ws + WS_SIN);
    bf16* UA = (bf16*)(ws + WS_UA); bf16* Bc = (bf16*)(ws + WS_BC); bf16* Ws5 = (bf16*)(ws + WS_WS5); float* HLOC = (float*)(ws + WS_HLOC);
    bf16* RZ = (bf16*)(ws + WS_RZ); bf16* Yb = (bf16*)(ws + WS_Y); bf16* OS = (bf16*)(ws + WS_XN);
    float* OUT = args.out;

    {
        LAS float* scr = (LAS float*)(lds + RING_OFF + wave * 16384);
        constexpr int I_A = 16 * 64, I_B = 16 * 32, I_G = 8 * 16, I_1 = 16 * 128, I_2 = 64 * 32, I_H = 16 * 160, I_O = 16 * 32;
        constexpr int NITEMS = I_A + I_B + I_G + 2 * I_1 + 2 * I_2 + I_H + I_O;
        for (int it = gw; it < NITEMS; it += NGW) {
            int r = it;
            if (r < I_A) { p0_transpose_item<true>(args.in[I_ABWIN], 1024, 2048, Win0, scr, r, lane); continue; } r -= I_A;
            if (r < I_B) { p0_transpose_item<false>(args.in[I_ABWOUT], 1024, 1024, Wout0, scr, r, lane); continue; } r -= I_B;
            if (r < I_G) { p0_transpose_item<false>(args.in[I_S5WGLU], 512, 512, Wglu, scr, r, lane); continue; } r -= I_G;
            if (r < 2 * I_1) { const int l = r / I_1; p0_transpose_item<false>(args.in[I_W1] + (size_t)l * 1024 * 4096, 1024, 4096, l ? W1t1 : W1t0, scr, r % I_1, lane); continue; } r -= 2 * I_1;
            if (r < 2 * I_2) { const int l = r / I_2; p0_transpose_item<false>(args.in[I_W2] + (size_t)l * 1024 * 4096, 4096, 1024, l ? W2t1 : W2t0, scr, r % I_2, lane); continue; } r -= 2 * I_2;
            if (r < I_H) { p0_transpose_item<false>(args.in[I_HGWIN], 1024, 5120, Whg, scr, r, lane); continue; } r -= I_H;
            p0_transpose_item<false>(args.in[I_HGWOUT], 1024, 1024, Whgo, scr, r, lane);
        }
        __syncthreads();
        if ((int)blockIdx.x < 96) {
            LAS float* Ssil = (LAS float*)lds; LAS float* red = (LAS float*)(lds + 36864);
            for (int i = tid; i < 9 * 1024; i += NWAVES * 64) { const int r = i >> 10, k = i & 1023; const float v = r < 8 ? args.in[I_C][r * 1024 + k] : args.in[I_CCTX][k]; Ssil[i] = v / (1.0f + expf(-v)); }
            __syncthreads();
            for (int it = blockIdx.x; it < 96; it += G) {
                const int l = it / 48, col0 = (it % 48) * 128, cgp = tid & 31, ksl = tid >> 5;
                const float* W = args.in[I_WMOD] + (size_t)l * 1024 * NMOD + col0 + 4 * cgp;
                f32x4 a[9];
#pragma unroll
                for (int r = 0; r < 9; ++r) a[r] = (f32x4){0.f, 0.f, 0.f, 0.f};
                for (int kk = 0; kk < 64; ++kk) { const int k = ksl * 64 + kk; const f32x4 w = *(const f32x4*)(W + (size_t)k * NMOD);
#pragma unroll
                    for (int r = 0; r < 9; ++r) a[r] += w * Ssil[r * 1024 + k]; }
#pragma unroll
                for (int r = 0; r < 9; ++r) *(LAS f32x4*)(red + (ksl * 9 + r) * 128 + 4 * cgp) = a[r];
                __syncthreads();
                for (int o = tid; o < 9 * 128; o += NWAVES * 64) { const int r = o >> 7, cc = o & 127; float s = args.in[I_BMOD][l * NMOD + col0 + cc];
                    for (int q = 0; q < 16; ++q) s += red[(q * 9 + r) * 128 + cc];
                    MOD[(size_t)(l * 9 + r) * NMOD + col0 + cc] = s; }
                __syncthreads();
            }
        }
        { const int first = G >= 128 ? 96 : 0, nb_ = G >= 128 ? 32 : G;
          if ((int)blockIdx.x >= first && (int)blockIdx.x < first + nb_) { __syncthreads();
            for (int g5 = (int)blockIdx.x - first; g5 < 32; g5 += nb_)
                s5_tables_item(lds, g5, args.in[I_S5ARE], args.in[I_S5AIM], args.in[I_S5DT], args.in[I_S5BRE], args.in[I_S5BIM], args.in[I_S5CRE], args.in[I_S5CIM], Bc, Ws5); } }
        const int gt = gw * 64 + lane, NT = NGW * 64;
        for (int i = gt; i < SEQL * 32; i += NT) { const int t = i >> 5, dd = i & 31; const float inv = powf(10000.0f, -(float)(dd & 15) / 16.0f);
            const float a = (dd < 16 ? (float)(t >> 6) : (float)(t & 63)) * inv; CS[2 * i] = cosf(a); CS[2 * i + 1] = sinf(a); }
        for (int i = gt; i < 2 * 32 * 64; i += NT) {
            const float dt = expf(args.in[I_S5DT][i >> 6]); const float are = args.in[I_S5ARE][i], aim = args.in[I_S5AIM][i];
            const float mag = expf(are * dt), ang = aim * dt; const float abr = mag * cosf(ang), abi = mag * sinf(ang);
            const float nr = abr - 1.0f, ni = abi, den = are * are + aim * aim; const float fr = (nr * are + ni * aim) / den, fi = (ni * are - nr * aim) / den;
            AB[i] = (f32x2){abr, abi}; (void)fr; (void)fi;
        }
        for (int i = gt; i < 2 * 1024; i += NT) { const int d = i >> 10, j = i & 1023; const float x0 = args.in[I_HGLB][(d * 2 + 0) * 1024 + j], x1 = args.in[I_HGLB][(d * 2 + 1) * 1024 + j];
            const float mx = fmaxf(x0, x1), e0 = expf(x0 - mx), e1 = expf(x1 - mx); const float g0 = e0 / (e0 + e1), g1 = e1 / (e0 + e1); LB[i] = (g0 + g1) - g0; }
    }
    GRID_BAR();
    norm_mod_rows(args.in[I_X], args.in[I_CTX], MT, args.in[I_NMIX], MOD, 0, DM, XN, gw, NGW, lane);
    GRID_BAR();
    { pg8::Gemm g{XN, Win0, MT, 2048, 1024, 1024, 1024}; pg8::StaticOrder S; S.init(MT, 2048, G, (int)blockIdx.x); EpiProj0 E{P0b, CS, UA};
      pg8::gemm_phase<EpiProj0, pg8::StaticOrder, true, true>(lds + RING_OFF, g, S, E); }
    GRID_BAR();
    { pg8::Gemm g{UA, Ws5, 32 * S5RP, 32 * 256, 512, S5K, 512}; pg8::BatchOrder S; S.init(32, 5, 1, G, (int)blockIdx.x); EpiHloc E{HLOC};
      pg8::gemm_phase<EpiHloc, pg8::BatchOrder, true, true>(lds + RING_OFF, g, S, E);
      __syncthreads();
      for (;;) {
          if (tid == 0) MISC[16] = __hip_atomic_fetch_add((unsigned*)ctl + 1024, 1u, __ATOMIC_RELAXED, __HIP_MEMORY_SCOPE_AGENT);
          __syncthreads(); const int it = (int)MISC[16]; if (it >= 32 * RCH) break;
          ret_passA_item(lds, it, P0b, args.in[I_RETL], ULOC); } }
    GRID_BAR();
    s5_scan(HLOC, UA, AB, gw, NGW, lane);
    ret_scan(ULOC, SIN, args.in[I_RETL], gw * 64 + lane, NGW * 64);
    GRID_BAR();
    { pg8::Gemm g{UA, Bc, 32 * S5RP, 32 * 512, S5K, S5K, S5K}; pg8::BatchOrder S; S.init(32, 5, 2, G, (int)blockIdx.x); EpiS5Out E{UA, args.in[I_S5D], Yb};
      pg8::gemm_phase<EpiS5Out, pg8::BatchOrder, true, true>(lds + RING_OFF, g, S, E);
      __syncthreads();
      for (;;) {
          if (tid == 0) MISC[16] = __hip_atomic_fetch_add((unsigned*)ctl + 1088, 1u, __ATOMIC_RELAXED, __HIP_MEMORY_SCOPE_AGENT);
          __syncthreads(); const int it = (int)MISC[16]; if (it >= 32 * RCH) break;
          ret_passC_item(lds, it, P0b, args.in[I_RETL], SIN, RZ); } }
    GRID_BAR();
    { pg8::Gemm g{Yb, Wglu, MT, 512, 512, 512, 512}; pg8::StaticOrder S; S.init(MT, 512, G, (int)blockIdx.x); EpiGlu E{Yb, args.in[I_S5BGLU], RZ + 512};
      pg8::gemm_phase<EpiGlu, pg8::StaticOrder, true, true>(lds + RING_OFF, g, S, E); }
    GRID_BAR();
    float* SLAB0 = (float*)(ws + WS_BIG);
    float* SLAB1 = (float*)(ws + WS_BIG + 272 * MiB);
    { pg8::Gemm g{RZ, Wout0, ML, 1024, 1024, 1024, 1024}; pg8::StaticOrder S; S.init(ML, 1024, G, (int)blockIdx.x); EpiResid E{args.in[I_X], args.in[I_CTX], OUT, HC, MOD + 2 * DM};
      pg8::gemm_phase<EpiResid, pg8::StaticOrder, true, true>(lds + RING_OFF, g, S, E);
      const int p = (int)blockIdx.x, sk = p & 3, tile = p >> 2;
      pg8::Gemm gp{RZ + (size_t)ML * 1024 + sk * 256, Wout0 + sk * 256, MC, 1024, 256, 1024, 1024}; pg8::SingleUnit SU{tile & 7, tile >> 3, p < 128}; EpiPart EP{SLAB0 + (size_t)sk * MC * DM};
      pg8::gemm_phase<EpiPart, pg8::SingleUnit, true, true>(lds + RING_OFF, gp, SU, EP); }
    GRID_BAR();
    norm_mod_rows(OUT, args.in[I_CTX], MT, args.in[I_NMLP], MOD, 3 * DM, 4 * DM, XN, gw, NGW, lane, SLAB0, 4, MOD + (size_t)8 * NMOD + 2 * DM, HC);
    GRID_BAR();
    { pg8::Gemm g{XN, W1t0, MT, DFF, 1024, 1024, 1024}; pg8::StaticOrder S; S.init(MT, DFF, G, (int)blockIdx.x); EpiSqrelu E{Hb};
      pg8::gemm_phase<EpiSqrelu, pg8::StaticOrder, true, true>(lds + RING_OFF, g, S, E); }
    GRID_BAR();
    { pg8::Gemm g{Hb, W2t0, ML, 1024, DFF, DFF, DFF}; pg8::StaticOrder S; S.init(ML, 1024, G, (int)blockIdx.x); EpiResid E{OUT, HC, OUT, HC, MOD + 5 * DM};
      pg8::gemm_phase<EpiResid, pg8::StaticOrder, true, true>(lds + RING_OFF, g, S, E);
      const int p = (int)blockIdx.x, sk = p & 7, tile = p >> 3;
      pg8::Gemm gp{Hb + (size_t)ML * DFF + sk * 512, W2t0 + sk * 512, MC, 1024, 512, DFF, DFF}; pg8::SingleUnit SU{tile & 7, tile >> 3, p < 256}; EpiPart EP{SLAB1 + (size_t)sk * MC * DM};
      pg8::gemm_phase<EpiPart, pg8::SingleUnit, true, true>(lds + RING_OFF, gp, SU, EP); }
    GRID_BAR();
    const float* MOD1 = MOD + (size_t)9 * NMOD;
    norm_mod_rows(OUT, HC, MT, args.in[I_NMIX] + DM, MOD1, 0, DM, XN, gw, NGW, lane, SLAB1, 8, MOD + (size_t)8 * NMOD + 5 * DM, HC);
    GRID_BAR();
    { pg8::Gemm g{XN, Whg, MT, 5120, 1024, 1024, 1024}; pg8::StaticOrder S; S.init(MT, 5120, G, (int)blockIdx.x); EpiProj1 E{P1b, LB};
      pg8::gemm_phase<EpiProj1, pg8::StaticOrder, true, true>(lds + RING_OFF, g, S, E); }
    GRID_BAR();
    for (int i = blockIdx.x; i < 256; i += G) hgrn_item(lds, i, P1b, OS, ws);
    GRID_BAR();
    merge1_rows(OS, ws, P1b, args.in[I_HGNORM], gw, NGW, lane);
    GRID_BAR();
    { pg8::Gemm g{OS, Whgo, ML, 1024, 1024, 1024, 1024}; pg8::StaticOrder S; S.init(ML, 1024, G, (int)blockIdx.x); EpiResid E{OUT, HC, OUT, HC, MOD1 + 2 * DM};
      pg8::gemm_phase<EpiResid, pg8::StaticOrder, true, true>(lds + RING_OFF, g, S, E); }
    GRID_BAR();
    norm_mod_rows(OUT, HC, ML, args.in[I_NMLP] + DM, MOD1, 3 * DM, 4 * DM, XN, gw, NGW, lane);
    GRID_BAR();
    { pg8::Gemm g{XN, W1t1, ML, DFF, 1024, 1024, 1024}; pg8::StaticOrder S; S.init(ML, DFF, G, (int)blockIdx.x); EpiSqrelu E{Hb};
      pg8::gemm_phase<EpiSqrelu, pg8::StaticOrder, true, true>(lds + RING_OFF, g, S, E); }
    GRID_BAR();
    { pg8::Gemm g{Hb, W2t1, ML, 1024, DFF, DFF, DFF}; pg8::StaticOrder S; S.init(ML, 1024, G, (int)blockIdx.x); EpiResid E{OUT, HC, OUT, HC, MOD1 + 5 * DM};
      pg8::gemm_phase<EpiResid, pg8::StaticOrder, true, true>(lds + RING_OFF, g, S, E); }
    GRID_BAR();
    final_norm_rows(OUT, args.in[I_NFIN], gw, NGW, lane);
}

extern "C" void kernel_launch(void* const* d_in, const int* in_sizes, int n_in, void* d_out, int out_size, void* d_ws, size_t ws_size, hipStream_t stream) {
    static int grid = 0;
    if (grid == 0) {
        if (n_in != 28 || in_sizes[0] != ML * DM || out_size != ML * DM || ws_size < WS_END) { fprintf(stderr, "kernel_launch: unexpected shapes (n_in %d, in0 %d, out %d, ws %zu)\n", n_in, n_in > 0 ? in_sizes[0] : -1, out_size, ws_size); grid = -1; return; }
        int dev = 0, cus = 0, per_cu = 0;
        if (hipGetDevice(&dev) != hipSuccess || hipDeviceGetAttribute(&cus, hipDeviceAttributeMultiprocessorCount, dev) != hipSuccess) { grid = -1; return; }
        if (hipFuncSetAttribute((const void*)mk_fwd, hipFuncAttributeMaxDynamicSharedMemorySize, LDS_BYTES) != hipSuccess) { fprintf(stderr, "kernel_launch: hipFuncSetAttribute failed\n"); grid = -1; return; }
        if (hipOccupancyMaxActiveBlocksPerMultiprocessor(&per_cu, (const void*)mk_fwd, NWAVES * 64, LDS_BYTES) != hipSuccess || per_cu < 1) { fprintf(stderr, "kernel_launch: occupancy query says %d blocks per CU\n", per_cu); }
        (void)hipGetLastError();
        grid = cus;
    }
    if (grid < 0) return;
    if (hipMemsetAsync((char*)d_ws + WS_CTL, 0, CTL_ZERO_BYTES, stream) != hipSuccess) return;
    Args a{};
    for (int i = 0; i < 28; ++i) a.in[i] = (const float*)d_in[i];
    a.out = (float*)d_out; a.ws = (unsigned char*)d_ws;
    hipLaunchKernelGGL(mk_fwd, dim3(grid), dim3(NWAVES * 64), LDS_BYTES, stream, a);
}
```

```cpp
#include <hip/hip_runtime.h>
#include <cstdio>
#include <cstdint>

namespace pg8 {
#define PG8_LAS __attribute__((address_space(3)))
typedef unsigned short bf16_t;
typedef short bf16x8 __attribute__((ext_vector_type(8)));
typedef float f32x4 __attribute__((ext_vector_type(4)));
typedef unsigned u32x4 __attribute__((ext_vector_type(4)));
constexpr int BM = 256, BK = 64, HALF = 128, HTB = HALF * BK * 2, STAGE_BYTES = 8 * HTB, NXCD = 8, WGM = 8;

__host__ __device__ __forceinline__ int lds_byte(int r, int c) { const int st = (r >> 4) * 2 + (c >> 5), rr = r & 15, cc = c & 31, ob = rr * 64 + cc * 2; return st * 1024 + (ob ^ (((ob >> 9) & 1) << 5)); }
__host__ __device__ __forceinline__ void stage_rc(int b, int& R, int& C) { const int st = b / 1024, sb = b % 1024, swz = sb ^ (((sb >> 9) & 1) << 5); R = (st >> 1) * 16 + swz / 64; C = (st & 1) * 32 + (swz % 64) / 2; }
__host__ __device__ __forceinline__ int perm32(int rho) { const int n = rho >> 4, i = rho & 15; return 8 * (i >> 2) + 4 * n + (i & 3); }

struct Unit { int pm, pn; };
struct Gemm { const bf16_t* A; const bf16_t* Bt; int M, N, K, lda, ldb; };

struct StaticOrder {
    int nM, nN, nwg, G, c;
    __host__ __device__ void init(int M, int N, int G_, int c_) { nM = M / BM; nN = N / BM; nwg = nM * nN; G = G_; c = c_; }
    __host__ __device__ bool next(int i, Unit& u) const {
        const long L = (long)i * G + c; if (L >= nwg) return false;
        int wgid = (int)L; { const int q = nwg / NXCD, r = nwg % NXCD, xcd = wgid % NXCD, off = wgid / NXCD; wgid = (xcd < r ? xcd * (q + 1) : r * (q + 1) + (xcd - r) * q) + off; }
        const int nig = WGM * nN, gid = wgid / nig, fm = gid * WGM, gsz = (nM - fm) < WGM ? (nM - fm) : WGM;
        u.pm = fm + ((wgid % nig) % gsz); u.pn = (wgid % nig) / gsz; return true;
    }
    __device__ __forceinline__ void a_ready(const Unit&) const {}
    __device__ __forceinline__ void done(const Unit&) const {}
};

struct BatchOrder {
    int nb, tm, tn, G, c;
    __host__ __device__ void init(int nb_, int tm_, int tn_, int G_, int c_) { nb = nb_; tm = tm_; tn = tn_; G = G_; c = c_; }
    __host__ __device__ bool next(int i, Unit& u) const {
        const long L = (long)i * G + c; if (c < 0 || L >= (long)nb * tm * tn) return false;
        const int per = tm * tn, g = (int)L / per, rem = (int)L % per;
        u.pm = g * tm + rem % tm; u.pn = g * tn + rem / tm; return true;
    }
    __device__ __forceinline__ void a_ready(const Unit&) const {}
    __device__ __forceinline__ void done(const Unit&) const {}
};

struct SingleUnit {
    int pm, pn; bool valid;
    __host__ __device__ bool next(int i, Unit& u) const { if (i != 0 || !valid) return false; u.pm = pm; u.pn = pn; return true; }
    __device__ __forceinline__ void a_ready(const Unit&) const {}
    __device__ __forceinline__ void done(const Unit&) const {}
};

__device__ __forceinline__ unsigned cvt_pk_bf16(float lo, float hi) { unsigned r; asm volatile("v_cvt_pk_bf16_f32 %0, %1, %2" : "=v"(r) : "v"(lo), "v"(hi)); return r; }

template <class Epi, class Sched, bool ALIGN_EPI = false, bool SP2 = false>
__device__ __forceinline__ void gemm_phase(PG8_LAS unsigned char* lds, const Gemm g, const Sched& S, const Epi& E) {
    int tid_ = threadIdx.x; asm volatile("" : "+v"(tid_));
    const int tid = tid_, wid = __builtin_amdgcn_readfirstlane(tid >> 6), lane = tid & 63, wr = wid >> 2, wc = wid & 3, fr = lane & 15, fq = lane >> 4;
    const int K = g.K, nt = K / BK;
    unsigned voffA[2], voffB[2];
#pragma unroll
    for (int i = 0; i < 2; ++i) { int R, C; stage_rc(tid * 16 + i * 8192, R, C); const int Rb = Epi::PERM ? ((R & ~31) + perm32(R & 31)) : R;
        voffA[i] = (unsigned)(R * g.lda + C) * 2u; voffB[i] = (unsigned)(Rb * g.ldb + C) * 2u; }
    const size_t kstep = (size_t)(BK * 2);
    const size_t hstepA = (size_t)HALF * g.lda * 2, hstepB = (size_t)HALF * g.ldb * 2;
    const size_t tstepA = 2 * hstepA, tstepB = 2 * hstepB;
    const unsigned ldsw = (unsigned)wid * 1024u;
    const int aoff = lds_byte(wr * 64 + fr, fq * 8), boff = lds_byte(wc * 32 + fr, fq * 8);
#define PG8_SA(b, h) (((b) * 2 + (h)) * HTB)
#define PG8_SB(b, h) ((4 + (b) * 2 + (h)) * HTB)
#define PG8_STAGE(bufoff, gbase, voff) do { _Pragma("unroll") for (int _i = 0; _i < 2; ++_i) \
        __builtin_amdgcn_global_load_lds((const unsigned*)((const char*)(gbase) + (voff)[_i]), (PG8_LAS unsigned*)(lds + (bufoff) + ldsw + _i * 8192), 16, 0, 0); } while (0)
#define PG8_LDA(dst, b, h) do { _Pragma("unroll") for (int m = 0; m < 4; ++m) _Pragma("unroll") for (int k = 0; k < 2; ++k) dst[m][k] = *(const PG8_LAS bf16x8*)(lds + PG8_SA(b, h) + aoff + m * 2048 + k * 1024); } while (0)
#define PG8_LDB(dst, b, h) do { _Pragma("unroll") for (int n = 0; n < 2; ++n) _Pragma("unroll") for (int k = 0; k < 2; ++k) dst[n][k] = *(const PG8_LAS bf16x8*)(lds + PG8_SB(b, h) + boff + n * 2048 + k * 1024); } while (0)
#define PG8_MMA(ai, bj, At, Bt) do { __builtin_amdgcn_s_setprio(1); _Pragma("unroll") for (int m = 0; m < 4; ++m) _Pragma("unroll") for (int n = 0; n < 2; ++n) _Pragma("unroll") for (int k = 0; k < 2; ++k) \
        acc[ai][bj][m][n] = __builtin_amdgcn_mfma_f32_16x16x32_bf16(Bt[n][k], At[m][k], acc[ai][bj][m][n], 0, 0, 0); __builtin_amdgcn_s_setprio(0); } while (0)
#define PG8_WAIT_V(n) asm volatile("s_waitcnt vmcnt(" #n ")" ::: "memory")
#define PG8_WAIT_L(n) asm volatile("s_waitcnt lgkmcnt(" #n ")" ::: "memory")
#define PG8_BAR __builtin_amdgcn_s_barrier()
#define PG8_SCHED __builtin_amdgcn_sched_barrier(0)
    Unit cur, nxt; int ui = 0;
    if (!S.next(0, cur)) return;
    f32x4 acc[2][2][4][2];
#pragma unroll
    for (int a = 0; a < 2; ++a)
#pragma unroll
        for (int b = 0; b < 2; ++b)
#pragma unroll
            for (int m = 0; m < 4; ++m)
#pragma unroll
                for (int n = 0; n < 2; ++n) acc[a][b][m][n] = (f32x4){0.f, 0.f, 0.f, 0.f};
    bf16x8 At[4][2], B0[2][2], B1[2][2];
    const char* cA = (const char*)g.A + (size_t)cur.pm * tstepA; const char* cB = (const char*)g.Bt + (size_t)cur.pn * tstepB;
    S.a_ready(cur);
    if constexpr (SP2) {
        PG8_STAGE(PG8_SB(0, 0), cB, voffB); PG8_STAGE(PG8_SB(0, 1), cB + hstepB, voffB); PG8_STAGE(PG8_SA(0, 0), cA, voffA); PG8_STAGE(PG8_SA(0, 1), cA + hstepA, voffA);
        if (wr == 1) PG8_BAR;
        PG8_WAIT_V(2); PG8_BAR;
        PG8_STAGE(PG8_SB(1, 0), cB + kstep, voffB); PG8_STAGE(PG8_SA(1, 0), cA + kstep, voffA); PG8_STAGE(PG8_SB(1, 1), cB + hstepB + kstep, voffB);
        PG8_WAIT_V(6); PG8_BAR;
    } else {
        PG8_STAGE(PG8_SB(0, 0), cB, voffB); PG8_STAGE(PG8_SA(0, 0), cA, voffA); PG8_STAGE(PG8_SB(0, 1), cB + hstepB, voffB); PG8_STAGE(PG8_SA(0, 1), cA + hstepA, voffA);
        if (wr == 1) PG8_BAR;
        PG8_WAIT_V(4); PG8_BAR;
        PG8_STAGE(PG8_SB(1, 0), cB + kstep, voffB); PG8_STAGE(PG8_SA(1, 0), cA + kstep, voffA); PG8_STAGE(PG8_SB(1, 1), cB + hstepB + kstep, voffB);
        PG8_WAIT_V(6); PG8_BAR;
    }
    for (;;) {
        const bool has_next = S.next(ui + 1, nxt);
        const char* nA = has_next ? (const char*)g.A + (size_t)nxt.pm * tstepA : cA; const char* nB = has_next ? (const char*)g.Bt + (size_t)nxt.pn * tstepB : cB;
        for (int t = 0; t < nt; t += 2) {
            const bool last = (t == nt - 2);
            const char* a1 = cA + (size_t)(t + 1) * kstep;
            const char* a2 = last ? nA : cA + (size_t)(t + 2) * kstep; const char* b2 = last ? nB : cB + (size_t)(t + 2) * kstep;
            const char* a3 = a2 + kstep; const char* b3 = b2 + kstep;
            if (last && has_next) S.a_ready(nxt);
            if constexpr (SP2) {
            PG8_LDB(B0, 0, 0); PG8_LDB(B1, 0, 1); PG8_SCHED; PG8_LDA(At, 0, 0); PG8_STAGE(PG8_SA(1, 1), a1 + hstepA, voffA);
            PG8_WAIT_V(8); PG8_WAIT_L(0); PG8_BAR; PG8_MMA(0, 0, At, B0); PG8_MMA(0, 1, At, B1); PG8_BAR; PG8_SCHED;
            PG8_LDA(At, 0, 1); PG8_STAGE(PG8_SB(0, 0), b2, voffB); PG8_STAGE(PG8_SB(0, 1), b2 + hstepB, voffB); PG8_STAGE(PG8_SA(0, 0), a2, voffA);
            PG8_WAIT_V(8); PG8_WAIT_L(0); PG8_BAR; PG8_MMA(1, 0, At, B0); PG8_MMA(1, 1, At, B1); PG8_BAR; PG8_SCHED;
            PG8_LDB(B0, 1, 0); PG8_LDB(B1, 1, 1); PG8_SCHED; PG8_LDA(At, 1, 0); PG8_STAGE(PG8_SA(0, 1), a2 + hstepA, voffA);
            PG8_WAIT_V(8); PG8_WAIT_L(0); PG8_BAR; PG8_MMA(0, 0, At, B0); PG8_MMA(0, 1, At, B1); PG8_BAR; PG8_SCHED;
            PG8_LDA(At, 1, 1); PG8_STAGE(PG8_SB(1, 0), b3, voffB); PG8_STAGE(PG8_SB(1, 1), b3 + hstepB, voffB); PG8_STAGE(PG8_SA(1, 0), a3, voffA);
            PG8_WAIT_V(8); PG8_WAIT_L(0); PG8_BAR; PG8_MMA(1, 0, At, B0); PG8_MMA(1, 1, At, B1); PG8_BAR; PG8_SCHED;
            } else {
            PG8_LDB(B0, 0, 0); PG8_SCHED; PG8_LDA(At, 0, 0); PG8_STAGE(PG8_SA(1, 1), a1 + hstepA, voffA);
            PG8_WAIT_L(8); PG8_BAR; PG8_WAIT_L(0); PG8_MMA(0, 0, At, B0); PG8_BAR; PG8_SCHED;
            PG8_LDB(B1, 0, 1); PG8_STAGE(PG8_SB(0, 0), b2, voffB);
            PG8_BAR; PG8_WAIT_L(0); PG8_MMA(0, 1, At, B1); PG8_BAR;
            PG8_LDA(At, 0, 1); PG8_STAGE(PG8_SA(0, 0), a2, voffA);
            PG8_BAR; PG8_WAIT_L(0); PG8_MMA(1, 0, At, B0); PG8_BAR; PG8_SCHED;
            PG8_STAGE(PG8_SB(0, 1), b2 + hstepB, voffB);
            PG8_WAIT_V(6); PG8_BAR; PG8_MMA(1, 1, At, B1); PG8_BAR;
            PG8_LDB(B0, 1, 0); PG8_SCHED; PG8_LDA(At, 1, 0); PG8_STAGE(PG8_SA(0, 1), a2 + hstepA, voffA);
            PG8_WAIT_L(8); PG8_BAR; PG8_WAIT_L(0); PG8_MMA(0, 0, At, B0); PG8_BAR; PG8_SCHED;
            PG8_LDB(B1, 1, 1); PG8_STAGE(PG8_SB(1, 0), b3, voffB);
            PG8_BAR; PG8_WAIT_L(0); PG8_MMA(0, 1, At, B1); PG8_BAR;
            PG8_LDA(At, 1, 1); PG8_STAGE(PG8_SA(1, 0), a3, voffA);
            PG8_BAR; PG8_WAIT_L(0); PG8_MMA(1, 0, At, B0); PG8_BAR; PG8_SCHED;
            PG8_STAGE(PG8_SB(1, 1), b3 + hstepB, voffB);
            PG8_WAIT_V(6); PG8_BAR; PG8_MMA(1, 1, At, B1); PG8_BAR;
            }
        }
        if constexpr (ALIGN_EPI) { if (wr == 0) PG8_BAR; }
        if constexpr (!Epi::AFTER_DRAIN) { E(acc, cur, wr, wc, fr, fq); S.done(cur); }
        if (!has_next) break;
#pragma unroll
        for (int a = 0; a < 2; ++a)
#pragma unroll
            for (int b = 0; b < 2; ++b)
#pragma unroll
                for (int m = 0; m < 4; ++m)
#pragma unroll
                    for (int n = 0; n < 2; ++n) acc[a][b][m][n] = (f32x4){0.f, 0.f, 0.f, 0.f};
        cur = nxt; cA = nA; cB = nB; ++ui;
        if constexpr (ALIGN_EPI) { if (wr == 1) PG8_BAR; }
    }
    PG8_WAIT_V(0);
    if constexpr (!ALIGN_EPI) { if (wr == 0) PG8_BAR; }
    PG8_BAR;
#undef PG8_SA
#undef PG8_SB
#undef PG8_STAGE
#undef PG8_LDA
#undef PG8_LDB
#undef PG8_MMA
#undef PG8_WAIT_V
#undef PG8_WAIT_L
#undef PG8_BAR
#undef PG8_SCHED
}
}

#define GAS __attribute__((address_space(1)))
#define LAS __attribute__((address_space(3)))
typedef unsigned short bf16;
typedef unsigned v4u __attribute__((ext_vector_type(4)));
typedef unsigned v2u __attribute__((ext_vector_type(2)));
typedef float f32x4 __attribute__((ext_vector_type(4)));
typedef float f32x2 __attribute__((ext_vector_type(2)));

constexpr int NWAVES = 8;
constexpr int DM = 1024, NBATCH = 8, SEQL = 4096, CTXL = 256, DFF = 4096;
constexpr int ML = NBATCH * SEQL;
constexpr int MC = NBATCH * CTXL;
constexpr int MT = ML + MC;
constexpr int NMOD = 6 * DM;
constexpr float EPSN = 1e-6f;

constexpr size_t MiB = 1u << 20;
constexpr size_t WS_CTL = 0, CTL_ZERO_BYTES = 1 * MiB;
constexpr size_t WS_MOD = 1 * MiB;
constexpr size_t WS_CS = 2 * MiB;
constexpr size_t WS_S5T = 3 * MiB;
constexpr size_t WS_S5T_BB = WS_S5T + 32768, WS_LB = WS_S5T_BB + 524288;
constexpr size_t WS_HC = 4 * MiB;
constexpr size_t WS_WIN0 = 12 * MiB, WS_WOUT0 = 16 * MiB, WS_WGLU = 18 * MiB, WS_W1_0 = 19 * MiB, WS_W2_0 = 27 * MiB, WS_W1_1 = 35 * MiB, WS_W2_1 = 43 * MiB, WS_WHG = 51 * MiB, WS_WHGO = 61 * MiB;
__host__ __device__ __forceinline__ size_t ws_ob(int b) { return b < 5 ? 472 * MiB + (size_t)b * 8 * MiB : (b < 7 ? 12 * MiB + (size_t)(b - 5) * 8 * MiB : 4 * MiB); }
constexpr size_t WS_XN = 64 * MiB;
constexpr size_t WS_BIG = 132 * MiB;
constexpr int P0LD = 1536;
constexpr size_t WS_P0 = WS_BIG;
constexpr int S5R = 1088, S5RP = 1280, S5K = 768;
constexpr size_t WS_UA = WS_BIG + 102 * MiB;
constexpr size_t WS_BC = WS_BIG + 162 * MiB;
constexpr size_t WS_WS5 = WS_BIG + 186 * MiB;
constexpr size_t WS_ULOC = WS_BIG + 194 * MiB;
constexpr size_t WS_SIN = WS_BIG + 228 * MiB;
constexpr size_t WS_RZ = WS_BIG + 262 * MiB;
constexpr size_t WS_HLOC = WS_XN;
constexpr size_t WS_H = WS_BIG;
constexpr size_t WS_P1 = WS_BIG;
constexpr size_t WS_Y = 472 * MiB;
constexpr size_t WS_END = 512 * MiB;

constexpr int CW_BAR = 4096;

constexpr int RING_OFF = 0, RING_BYTES = 131072;
constexpr int LDSCTL_OFF = 143360, MISC_OFF = LDSCTL_OFF + 320;
constexpr int LDS_BYTES = 147456;

typedef GAS unsigned gu32;
#define LDS_WAIT() asm volatile("s_waitcnt lgkmcnt(0)" ::: "memory")
typedef __bf16 hwbf2 __attribute__((ext_vector_type(2)));
__device__ __forceinline__ unsigned pk2(float lo, float hi) { hwbf2 v; v.x = (__bf16)lo; v.y = (__bf16)hi; return __builtin_bit_cast(unsigned, v); }
__device__ __forceinline__ unsigned f2bf(float f) { return (unsigned)__builtin_bit_cast(unsigned short, (__bf16)f); }
__device__ __forceinline__ float bflo(unsigned w) { return __builtin_bit_cast(float, w << 16); }
__device__ __forceinline__ float bfhi(unsigned w) { return __builtin_bit_cast(float, w & 0xffff0000u); }
__device__ __forceinline__ float bf2f(bf16 h) { return __builtin_bit_cast(float, (unsigned)h << 16); }
typedef _Float16 h16x2 __attribute__((ext_vector_type(2)));
__device__ __forceinline__ unsigned pk_f16(float a, float b) { h16x2 v; v.x = (_Float16)a; v.y = (_Float16)b; return __builtin_bit_cast(unsigned, v); }
__device__ __forceinline__ float f16lo(unsigned w) { h16x2 v = __builtin_bit_cast(h16x2, w); return (float)v.x; }
__device__ __forceinline__ float f16hi(unsigned w) { h16x2 v = __builtin_bit_cast(h16x2, w); return (float)v.y; }
__device__ __forceinline__ float sigmoidf_(float x) { return 1.0f / (1.0f + __expf(-x)); }
__device__ __forceinline__ float siluf_(float x) { return x / (1.0f + __expf(-x)); }
__device__ __forceinline__ float gelu_tanh(float x) { const float u = 0.7978845608028654f * (x + 0.044715f * x * x * x); return 0.5f * x * (1.0f + tanhf(u)); }

#define XB_TMO      128
#define XB_XCNT(j)  (256  + 64 * (j))
#define XB_XSUB(j)  (1280 + 64 * (j))
#define XB_XGEN(j)  (2304 + 64 * (j))
#define XB_TOP      3328
#define XB_TOPGEN   3392
#define XCD_BAR_WORDS 3456
#define XB_SPIN_CAP (1u << 22)
__device__ __forceinline__ unsigned xb_ld(unsigned* p)              { return __hip_atomic_load(p, __ATOMIC_RELAXED, __HIP_MEMORY_SCOPE_AGENT); }
__device__ __forceinline__ unsigned xb_add(unsigned* p, unsigned v) { return __hip_atomic_fetch_add(p, v, __ATOMIC_RELAXED, __HIP_MEMORY_SCOPE_AGENT); }
__device__ __forceinline__ unsigned xb_xcc_id() { return (unsigned)__builtin_amdgcn_s_getreg((3 << 11) | 20) & 0xFu; }
#define XB_SPIN(cond, bar) do { unsigned _sp = 0; while (cond) { __builtin_amdgcn_s_sleep(1); \
    if ((++_sp & 255u) == 0u) { if (xb_ld(&(bar)[XB_TMO])) break; if (_sp > XB_SPIN_CAP) { atomicAdd(&(bar)[XB_TMO], 1u); break; } } } } while (0)
struct XcdBarrier { unsigned* bar; unsigned x; volatile LAS unsigned* st; };
__device__ __forceinline__ XcdBarrier xcd_barrier_post(unsigned* bar, volatile LAS unsigned* st) {
    XcdBarrier b; b.bar = bar; b.x = xb_xcc_id(); b.st = st;
    if (threadIdx.x == 0) (void)xb_add(&bar[XB_XCNT(b.x)], 1u);
    return b;
}
__device__ __forceinline__ void xcd_barrier_complete(unsigned* bar, unsigned x, unsigned& nloc, unsigned& nx) {
    const unsigned G = gridDim.x * gridDim.y * gridDim.z;
    unsigned sum, cnt, mine, sp = 0u;
    for (;;) {
        sum = 0u; cnt = 0u; mine = 0u;
#pragma unroll
        for (unsigned j = 0; j < 16; ++j) { const unsigned c = xb_ld(&bar[XB_XCNT(j)]); sum += c; cnt += (c > 0u) ? 1u : 0u; mine = (j == x) ? c : mine; }
        if (sum == G) break;
        __builtin_amdgcn_s_sleep(1);
        if ((++sp & 255u) == 0u) { if (xb_ld(&bar[XB_TMO])) break; if (sp > XB_SPIN_CAP) { atomicAdd(&bar[XB_TMO], 1u); break; } }
    }
    nloc = mine > 0u ? mine : 1u; nx = cnt > 0u ? cnt : 1u;
}
__device__ __forceinline__ void xcd_barrier(const XcdBarrier& b) {
    asm volatile("s_waitcnt vmcnt(0)" ::: "memory");
    __syncthreads();
    if (threadIdx.x == 0) {
        unsigned* bar = b.bar;
        __builtin_amdgcn_s_waitcnt(0);
        unsigned nloc = b.st[0], nx = b.st[1];
        if (nloc == 0u) { xcd_barrier_complete(bar, b.x, nloc, nx); b.st[0] = nloc; b.st[1] = nx; }
        const unsigned old = xb_add(&bar[XB_XSUB(b.x)], 1u);
        const unsigned gen = old / nloc;
        if (old + 1u == (gen + 1u) * nloc) {
            __builtin_amdgcn_fence(__ATOMIC_RELEASE, "agent");
            asm volatile("s_waitcnt vmcnt(0)" ::: "memory");
            const unsigned og = xb_add(&bar[XB_TOP], 1u);
            const unsigned tg = og / nx;
            if (og + 1u == (tg + 1u) * nx) xb_add(&bar[XB_TOPGEN], 1u);
            else XB_SPIN(xb_ld(&bar[XB_TOPGEN]) == tg, bar);
            __builtin_amdgcn_fence(__ATOMIC_ACQUIRE, "agent");
            xb_add(&bar[XB_XGEN(b.x)], 1u);
            asm volatile("s_waitcnt vmcnt(0)" ::: "memory");
        } else {
            XB_SPIN(xb_ld(&bar[XB_XGEN(b.x)]) == gen, bar);
            __builtin_amdgcn_fence(__ATOMIC_ACQUIRE, "agent");
            asm volatile("s_waitcnt vmcnt(0)" ::: "memory");
        }
    }
    __syncthreads();
}

__device__ __forceinline__ float wave_sum(float v) {
#pragma unroll
    for (int o = 1; o < 64; o <<= 1) v += __shfl_xor(v, o);
    return v;
}
__device__ __forceinline__ float sum16(float v) {
#pragma unroll
    for (int o = 1; o < 16; o <<= 1) v += __shfl_xor(v, o);
    return v;
}

__device__ __forceinline__ int rowof(int n, int b, int dir) {
    if (n < CTXL) { const int tc = dir ? (CTXL - 1 - n) : n; return ML + b * CTXL + tc; }
    const int tl = n - CTXL; const int t = dir ? (SEQL - 1 - tl) : tl; return b * SEQL + t;
}

__device__ __forceinline__ int permqk(int n) {
    const int d = n & 63, half = d >> 5, dd = d & 31, i = dd >> 2, j = dd & 3; return (n & ~63) + 8 * i + 4 * half + j;
}
template <bool PERMQK>
__device__ __forceinline__ void p0_transpose_item(const float* W, int K, int N, bf16* WT, LAS float* scr, int item, int lane) {
    const int nblk = N / 32, kb = item / nblk, nb = item % nblk, k0 = 64 * kb, n0 = 32 * nb;
#pragma unroll 8
    for (int i = 0; i < 32; ++i) { const int kk = 2 * i + (lane >> 5); scr[kk * 33 + (lane & 31)] = W[(size_t)(k0 + kk) * N + n0 + (lane & 31)]; }
    LDS_WAIT(); asm volatile("" ::: "memory");
    const int c = lane & 7;
#pragma unroll
    for (int j = 0; j < 4; ++j) { const int n = (lane >> 3) + 8 * j; const LAS float* s = scr + (8 * c) * 33 + n;
        v4u o; o.x = pk2(s[0 * 33], s[1 * 33]); o.y = pk2(s[2 * 33], s[3 * 33]); o.z = pk2(s[4 * 33], s[5 * 33]); o.w = pk2(s[6 * 33], s[7 * 33]);
        int nd = n0 + n; if (PERMQK && nd < 512) nd = permqk(nd);
        *(GAS v4u*)(WT + (size_t)nd * K + k0 + 8 * c) = o; }
    LDS_WAIT(); asm volatile("" ::: "memory");
}

__device__ __forceinline__ void norm_mod_rows(const float* hl, const float* hc, int nrows, const float* g, const float* mod, int shift_off, int scale_off, bf16* XN, int gw, int NGW, int lane,
                                              const float* slabs = nullptr, int nsl = 0, const float* cgate = nullptr, float* hcw = nullptr) {
    for (int row = gw; row < nrows; row += NGW) {
        const float* xr = row < ML ? hl + (size_t)row * DM : hc + (size_t)(row - ML) * DM;
        const int mr = row < ML ? (row >> 12) : 8;
        const f32x4* x4 = (const f32x4*)xr + lane;
        f32x4 v[4]; float s = 0.f;
#pragma unroll
        for (int j = 0; j < 4; ++j) v[j] = x4[64 * j];
        if (nsl > 0 && row >= ML) {
            const f32x4* p4 = (const f32x4*)(slabs + (size_t)(row - ML) * DM) + lane; const f32x4* g4c = (const f32x4*)cgate + lane;
            f32x4 a[4] = {(f32x4){0.f, 0.f, 0.f, 0.f}, (f32x4){0.f, 0.f, 0.f, 0.f}, (f32x4){0.f, 0.f, 0.f, 0.f}, (f32x4){0.f, 0.f, 0.f, 0.f}};
            for (int k = 0; k < nsl; ++k) {
#pragma unroll
                for (int j = 0; j < 4; ++j) a[j] += p4[(size_t)k * (MC * DM / 4) + 64 * j]; }
            f32x4* w4 = (f32x4*)(hcw + (size_t)(row - ML) * DM) + lane;
#pragma unroll
            for (int j = 0; j < 4; ++j) { v[j] = v[j] + g4c[64 * j] * a[j]; w4[64 * j] = v[j]; }
        }
#pragma unroll
        for (int j = 0; j < 4; ++j) s += (v[j].x * v[j].x + v[j].y * v[j].y) + (v[j].z * v[j].z + v[j].w * v[j].w);
        const float rstd = 1.0f / sqrtf(wave_sum(s) * (1.f / DM) + EPSN);
        const f32x4* g4 = (const f32x4*)g + lane; const f32x4* sc4 = (const f32x4*)(mod + (size_t)mr * NMOD + scale_off) + lane; const f32x4* sh4 = (const f32x4*)(mod + (size_t)mr * NMOD + shift_off) + lane;
        unsigned long long* o8 = (unsigned long long*)(XN + (size_t)row * DM) + lane;
#pragma unroll
        for (int j = 0; j < 4; ++j) { const f32x4 gg = g4[64 * j], sc = sc4[64 * j], sh = sh4[64 * j];
            const f32x4 y = (v[j] * rstd) * gg * (sc + 1.0f) + sh;
            o8[64 * j] = (unsigned long long)pk2(y.x, y.y) | ((unsigned long long)pk2(y.z, y.w) << 32); }
    }
}
__device__ __forceinline__ void final_norm_rows(float* h, const float* g, int gw, int NGW, int lane) {
    for (int row = gw; row < ML; row += NGW) {
        f32x4* x4 = (f32x4*)(h + (size_t)row * DM) + lane;
        f32x4 v[4]; float s = 0.f;
#pragma unroll
        for (int j = 0; j < 4; ++j) { v[j] = x4[64 * j]; s += (v[j].x * v[j].x + v[j].y * v[j].y) + (v[j].z * v[j].z + v[j].w * v[j].w); }
        const float rstd = 1.0f / sqrtf(wave_sum(s) * (1.f / DM) + EPSN);
        const f32x4* g4 = (const f32x4*)g + lane;
#pragma unroll
        for (int j = 0; j < 4; ++j) x4[64 * j] = (v[j] * rstd) * g4[64 * j];
    }
}
__device__ __forceinline__ void unpack8(const v4u w, float (&o)[8]) { o[0] = bflo(w.x); o[1] = bfhi(w.x); o[2] = bflo(w.y); o[3] = bfhi(w.y); o[4] = bflo(w.z); o[5] = bfhi(w.z); o[6] = bflo(w.w); o[7] = bfhi(w.w); }
__device__ __forceinline__ v4u pack8(const float (&o)[8]) { v4u w; w.x = pk2(o[0], o[1]); w.y = pk2(o[2], o[3]); w.z = pk2(o[4], o[5]); w.w = pk2(o[6], o[7]); return w; }

__device__ __forceinline__ void merge1_rows(bf16* OS, const unsigned char* ws, const bf16* P1, const float* hgn, int gw, int NGW, int lane) {
    for (int row = gw; row < ML; row += NGW) {
#pragma unroll
        for (int half = 0; half < 2; ++half) {
            const int c0 = half * 512 + lane * 8;
            const v4u ow = *(const v4u*)(OS + (size_t)row * 1024 + c0), gw4 = *(const v4u*)(P1 + (size_t)row * 5120 + 4096 + c0);
            const v4u ob = *(const v4u*)((const bf16*)(ws + ws_ob(row >> 12)) + (size_t)(row & (SEQL - 1)) * 1024 + c0);
            const f32x4 n0 = *(const f32x4*)(hgn + (c0 & 127)), n1 = *(const f32x4*)(hgn + (c0 & 127) + 4);
            float o[8], gg[8], o2[8]; unpack8(ow, o); unpack8(gw4, gg); unpack8(ob, o2);
            float ss = 0.f;
#pragma unroll
            for (int i = 0; i < 8; ++i) o[i] += o2[i];
#pragma unroll
            for (int i = 0; i < 8; ++i) ss += o[i] * o[i];
            const float rs = 1.0f / sqrtf(sum16(ss) * (1.f / 128.f) + EPSN);
            const float nn[8] = {n0.x, n0.y, n0.z, n0.w, n1.x, n1.y, n1.z, n1.w};
            float r[8];
#pragma unroll
            for (int i = 0; i < 8; ++i) r[i] = o[i] * rs * nn[i] * siluf_(gg[i]);
            *(v4u*)(OS + (size_t)row * 1024 + c0) = pack8(r);
        }
    }
}

using pg8::Unit; using pg8::HALF; using pg8::BM;
__device__ __forceinline__ v4u pack2x4(const f32x4 v0, const f32x4 v1) { v4u w; w.x = pg8::cvt_pk_bf16(v0[0], v0[1]); w.y = pg8::cvt_pk_bf16(v0[2], v0[3]); w.z = pg8::cvt_pk_bf16(v1[0], v1[1]); w.w = pg8::cvt_pk_bf16(v1[2], v1[3]); return w; }

struct EpiProj0 {
    static constexpr bool PERM = true, AFTER_DRAIN = false;
    bf16* O; const float* CS; bf16* UA;
    __device__ __forceinline__ void operator()(const f32x4 (&acc)[2][2][4][2], const Unit& u, int wr, int wc, int fr, int fq) const {
        const int row0 = u.pm * BM + wr * 64 + fr, col0 = u.pn * BM + wc * 32 + 8 * fq;
        const bool lat = u.pm < ML / BM;
        const bool rope = (u.pn < 2) && lat; const float sc = (u.pn == 1) ? 0.125f : 1.0f;
        const bool isu = (u.pn == 4) || (u.pn == 5);
        const int ocol0 = (u.pn >= 6) ? col0 - 512 : col0;
        const int i4 = 4 * (4 * (wc & 1) + fq);
#pragma unroll
        for (int ai = 0; ai < 2; ++ai)
#pragma unroll
            for (int m = 0; m < 4; ++m) { const int row = row0 + ai * HALF + m * 16;
                f32x4 ca = (f32x4){1.f, 0.f, 1.f, 0.f}, cb = ca;
                if (rope) { const float* p = CS + ((size_t)(row & (SEQL - 1)) * 32 + i4) * 2; ca = *(const f32x4*)p; cb = *(const f32x4*)(p + 4); }
                bf16* rowp = O + (size_t)row * P0LD + ocol0;
                int r5, i5;
                if (lat) { const int t = row & (SEQL - 1); r5 = (row >> 12) * 136 + 8 + (t >> 5); i5 = t & 31; }
                else { const int rc = row - ML, t = rc & (CTXL - 1); r5 = (rc >> 8) * 136 + (t >> 5); i5 = t & 31; }
#pragma unroll
                for (int bj = 0; bj < 2; ++bj) { f32x4 v0 = acc[ai][bj][m][0], v1 = acc[ai][bj][m][1];
                    if (rope) {
                        const f32x4 lo = (f32x4){v0[0] * ca[0] - v1[0] * ca[1], v0[1] * ca[2] - v1[1] * ca[3], v0[2] * cb[0] - v1[2] * cb[1], v0[3] * cb[2] - v1[3] * cb[3]};
                        const f32x4 hi = (f32x4){v0[0] * ca[1] + v1[0] * ca[0], v0[1] * ca[3] + v1[1] * ca[2], v0[2] * cb[1] + v1[2] * cb[0], v0[3] * cb[3] + v1[3] * cb[2]};
                        v0 = lo; v1 = hi; }
                    v0 = v0 * sc; v1 = v1 * sc;
                    const v4u w = pack2x4(v0, v1);
                    if (isu) { const int c = col0 + bj * HALF - 1024, g5 = c >> 4, m0 = c & 15;
                        *(v4u*)(UA + ((size_t)(g5 * S5RP + r5) * S5K + i5 * 16 + m0)) = w; }
                    else *(v4u*)(rowp + bj * HALF) = w; } }
    }
};
struct EpiGlu {
    static constexpr bool PERM = true, AFTER_DRAIN = false;
    const bf16* Y; const float* b; bf16* Z;
    __device__ __forceinline__ void operator()(const f32x4 (&acc)[2][2][4][2], const Unit& u, int wr, int wc, int fr, int fq) const {
        const int row0 = u.pm * BM + wr * 64 + fr, col0 = u.pn * BM + wc * 32 + 8 * fq;
        f32x4 bv[2][2];
#pragma unroll
        for (int bj = 0; bj < 2; ++bj)
#pragma unroll
            for (int n = 0; n < 2; ++n) bv[bj][n] = *(const f32x4*)(b + col0 + bj * HALF + 4 * n);
#pragma unroll
        for (int ai = 0; ai < 2; ++ai)
#pragma unroll
            for (int m = 0; m < 4; ++m) { const int row = row0 + ai * HALF + m * 16;
#pragma unroll
                for (int bj = 0; bj < 2; ++bj) { const int col = col0 + bj * HALF;
                    const v4u yw = *(const v4u*)(Y + (size_t)row * 512 + col); float yy[8]; unpack8(yw, yy);
                    const f32x4 a0 = acc[ai][bj][m][0] + bv[bj][0], a1 = acc[ai][bj][m][1] + bv[bj][1];
                    const f32x4 z0 = (f32x4){yy[0] * sigmoidf_(a0[0]), yy[1] * sigmoidf_(a0[1]), yy[2] * sigmoidf_(a0[2]), yy[3] * sigmoidf_(a0[3])};
                    const f32x4 z1 = (f32x4){yy[4] * sigmoidf_(a1[0]), yy[5] * sigmoidf_(a1[1]), yy[6] * sigmoidf_(a1[2]), yy[7] * sigmoidf_(a1[3])};
                    *(v4u*)(Z + (size_t)row * 1024 + col) = pack2x4(z0, z1); } }
    }
};
struct EpiResid {
    static constexpr bool PERM = false, AFTER_DRAIN = false;
    const float* baseL; const float* baseC; float* outL; float* outC; const float* gate;
    __device__ __forceinline__ void operator()(const f32x4 (&acc)[2][2][4][2], const Unit& u, int wr, int wc, int fr, int fq) const {
        const bool ctx = u.pm >= ML / BM; const int mr = ctx ? 8 : (u.pm >> 4);
        const int row0 = (ctx ? u.pm - ML / BM : u.pm) * BM + wr * 64 + fr, col0 = u.pn * BM + wc * 32 + 4 * fq;
        const float* B = ctx ? baseC : baseL; float* Oo = ctx ? outC : outL;
        f32x4 gv[2][2];
#pragma unroll
        for (int bj = 0; bj < 2; ++bj)
#pragma unroll
            for (int n = 0; n < 2; ++n) gv[bj][n] = *(const f32x4*)(gate + (size_t)mr * NMOD + col0 + bj * HALF + n * 16);
#pragma unroll
        for (int ai = 0; ai < 2; ++ai)
#pragma unroll
            for (int m = 0; m < 4; ++m) { const size_t off = (size_t)(row0 + ai * HALF + m * 16) * DM + col0;
#pragma unroll
                for (int bj = 0; bj < 2; ++bj)
#pragma unroll
                    for (int n = 0; n < 2; ++n) { const f32x4 bs = *(const f32x4*)(B + off + bj * HALF + n * 16);
                        *(f32x4*)(Oo + off + bj * HALF + n * 16) = bs + gv[bj][n] * acc[ai][bj][m][n]; } }
    }
};
struct EpiPart {
    static constexpr bool PERM = false, AFTER_DRAIN = false;
    float* C;
    __device__ __forceinline__ void operator()(const f32x4 (&acc)[2][2][4][2], const Unit& u, int wr, int wc, int fr, int fq) const {
        const int row0 = u.pm * BM + wr * 64 + fr, col0 = u.pn * BM + wc * 32 + 4 * fq;
#pragma unroll
        for (int ai = 0; ai < 2; ++ai)
#pragma unroll
            for (int m = 0; m < 4; ++m) { float* rowp = C + (size_t)(row0 + ai * HALF + m * 16) * DM + col0;
#pragma unroll
                for (int bj = 0; bj < 2; ++bj)
#pragma unroll
                    for (int n = 0; n < 2; ++n) *(f32x4*)(rowp + bj * HALF + n * 16) = acc[ai][bj][m][n]; }
    }
};
struct EpiSqrelu {
    static constexpr bool PERM = true, AFTER_DRAIN = false;
    bf16* O;
    __device__ __forceinline__ void operator()(const f32x4 (&acc)[2][2][4][2], const Unit& u, int wr, int wc, int fr, int fq) const {
        const int row0 = u.pm * BM + wr * 64 + fr, col0 = u.pn * BM + wc * 32 + 8 * fq;
#pragma unroll
        for (int ai = 0; ai < 2; ++ai)
#pragma unroll
            for (int m = 0; m < 4; ++m) { bf16* rowp = O + (size_t)(row0 + ai * HALF + m * 16) * DFF + col0;
#pragma unroll
                for (int bj = 0; bj < 2; ++bj) { f32x4 v0 = acc[ai][bj][m][0], v1 = acc[ai][bj][m][1];
                    v0 = __builtin_elementwise_max(v0, (f32x4){0.f, 0.f, 0.f, 0.f}); v1 = __builtin_elementwise_max(v1, (f32x4){0.f, 0.f, 0.f, 0.f});
                    *(v4u*)(rowp + bj * HALF) = pack2x4(v0 * v0, v1 * v1); } }
    }
};
struct EpiProj1 {
    static constexpr bool PERM = true, AFTER_DRAIN = false;
    bf16* O; const float* LB;
    __device__ __forceinline__ void operator()(const f32x4 (&acc)[2][2][4][2], const Unit& u, int wr, int wc, int fr, int fq) const {
        const int row0 = u.pm * BM + wr * 64 + fr, col0 = u.pn * BM + wc * 32 + 8 * fq;
        const int kind = u.pn >> 2;
        const bool gatek = (kind == 1) || (kind == 2);
        f32x4 lb[2][2];
#pragma unroll
        for (int bj = 0; bj < 2; ++bj)
#pragma unroll
            for (int n = 0; n < 2; ++n) lb[bj][n] = gatek ? *(const f32x4*)(LB + (size_t)(kind - 1) * 1024 + ((col0 + bj * HALF) & 1023) + 4 * n) : (f32x4){0.f, 0.f, 0.f, 0.f};
#pragma unroll
        for (int ai = 0; ai < 2; ++ai)
#pragma unroll
            for (int m = 0; m < 4; ++m) { bf16* rowp = O + (size_t)(row0 + ai * HALF + m * 16) * 5120 + col0;
#pragma unroll
                for (int bj = 0; bj < 2; ++bj) { const f32x4 v0 = acc[ai][bj][m][0], v1 = acc[ai][bj][m][1];
                    v4u w;
                    if (gatek) {
                        float l0[4], l1[4];
#pragma unroll
                        for (int i = 0; i < 4; ++i) { l0[i] = __logf(lb[bj][0][i] + (1.0f - lb[bj][0][i]) * sigmoidf_(v0[i])); l1[i] = __logf(lb[bj][1][i] + (1.0f - lb[bj][1][i]) * sigmoidf_(v1[i])); }
                        w.x = pk_f16(l0[0], l0[1]); w.y = pk_f16(l0[2], l0[3]); w.z = pk_f16(l1[0], l1[1]); w.w = pk_f16(l1[2], l1[3]);
                    } else w = pack2x4(v0, v1);
                    *(v4u*)(rowp + bj * HALF) = w; } }
    }
};

struct EpiHloc {
    static constexpr bool PERM = false, AFTER_DRAIN = false;
    float* C;
    __device__ __forceinline__ void operator()(const f32x4 (&acc)[2][2][4][2], const Unit& u, int wr, int wc, int fr, int fq) const {
        const int row0 = u.pm * BM + wr * 64 + fr, col0 = wc * 32 + 4 * fq;
#pragma unroll
        for (int ai = 0; ai < 2; ++ai)
#pragma unroll
            for (int m = 0; m < 4; ++m) { float* rowp = C + (size_t)(row0 + ai * HALF + m * 16) * 256 + col0;
#pragma unroll
                for (int bj = 0; bj < 2; ++bj)
#pragma unroll
                    for (int n = 0; n < 2; ++n) *(f32x4*)(rowp + bj * HALF + n * 16) = acc[ai][bj][m][n]; }
    }
};
struct EpiS5Out {
    static constexpr bool PERM = true, AFTER_DRAIN = false;
    const bf16* UA; const float* dskip; bf16* Y;
    __device__ __forceinline__ void operator()(const f32x4 (&acc)[2][2][4][2], const Unit& u, int wr, int wc, int fr, int fq) const {
        const int g5 = u.pm / 5, pml = u.pm - 5 * g5, pnl = u.pn - 2 * g5;
        const int r0 = pml * BM + wr * 64 + fr, col0 = pnl * BM + wc * 32 + 8 * fq;
#pragma unroll
        for (int ai = 0; ai < 2; ++ai)
#pragma unroll
            for (int m = 0; m < 4; ++m) { const int r = r0 + ai * HALF + m * 16;
                if (r < S5R) {
                    const int b = r / 136, ch = r - b * 136;
#pragma unroll
                    for (int bj = 0; bj < 2; ++bj) { const int col = col0 + bj * HALF, i5 = col >> 4, m0 = col & 15;
                        const int trow = ch < 8 ? ML + b * CTXL + ch * 32 + i5 : b * SEQL + (ch - 8) * 32 + i5;
                        const v4u uw = *(const v4u*)(UA + ((size_t)(g5 * S5RP + r) * S5K + col)); float uu[8]; unpack8(uw, uu);
                        const f32x4 d0 = *(const f32x4*)(dskip + g5 * 16 + m0), d1 = *(const f32x4*)(dskip + g5 * 16 + m0 + 4);
                        const f32x4 a0 = acc[ai][bj][m][0], a1 = acc[ai][bj][m][1];
                        const f32x4 y0 = (f32x4){gelu_tanh(a0[0] + d0[0] * uu[0]), gelu_tanh(a0[1] + d0[1] * uu[1]), gelu_tanh(a0[2] + d0[2] * uu[2]), gelu_tanh(a0[3] + d0[3] * uu[3])};
                        const f32x4 y1 = (f32x4){gelu_tanh(a1[0] + d1[0] * uu[4]), gelu_tanh(a1[1] + d1[1] * uu[5]), gelu_tanh(a1[2] + d1[2] * uu[6]), gelu_tanh(a1[3] + d1[3] * uu[7])};
                        *(v4u*)(Y + (size_t)trow * 512 + g5 * 16 + m0) = pack2x4(y0, y1); } } }
    }
};

__device__ __forceinline__ f32x2 cmul(f32x2 a, f32x2 b) { return (f32x2){a.x * b.x - a.y * b.y, a.x * b.y + a.y * b.x}; }
__device__ __forceinline__ void s5_tables_item(LAS unsigned char* lds, int g, const float* a_re, const float* a_im, const float* log_dt, const float* b_re, const float* b_im,
                                               const float* c_re, const float* c_im, bf16* Bc, bf16* Ws5) {
    const int tid = threadIdx.x;
    LAS f32x2* POW = (LAS f32x2*)lds;
    LAS f32x2* BBl = (LAS f32x2*)(lds + 33792);
    LAS f32x2* CCl = (LAS f32x2*)(lds + 50176);
    LAS float* KRN = (LAS float*)(lds + 66560);
    if (tid < 128) {
        const int d = tid >> 6, p = tid & 63, i = (d * 32 + g) * 64 + p;
        const float dt = expf(log_dt[d * 32 + g]); const float are = a_re[i], aim = a_im[i];
        const float mag = expf(are * dt), ang = aim * dt; const f32x2 ab = (f32x2){mag * cosf(ang), mag * sinf(ang)};
        const float nr = ab.x - 1.0f, ni = ab.y, den = are * are + aim * aim; const float fr = (nr * are + ni * aim) / den, fi = (ni * are - nr * aim) / den;
        f32x2 pw = (f32x2){1.f, 0.f};
        for (int e = 0; e <= 32; ++e) { POW[(d * 64 + p) * 33 + e] = pw; pw = cmul(pw, ab); }
        for (int n = 0; n < 16; ++n) { const float br = b_re[(size_t)i * 16 + n], bi = b_im[(size_t)i * 16 + n]; BBl[(d * 64 + p) * 16 + n] = (f32x2){fr * br - fi * bi, fr * bi + fi * br}; }
    }
    for (int o = tid; o < 2048; o += NWAVES * 64) { const int d = o >> 10, m = (o >> 6) & 15, p = o & 63; const size_t ci = ((size_t)(d * 32 + g) * 16 + m) * 64 + p; CCl[o] = (f32x2){c_re[ci], c_im[ci]}; }
    __syncthreads();
    for (int k = 0; k < 8; ++k) { const int o4 = tid + 512 * k, d = o4 >> 11, tau = (o4 >> 6) & 31, m = (o4 >> 2) & 15, nq = o4 & 3;
        float a0 = 0.f, a1 = 0.f, a2 = 0.f, a3 = 0.f;
        for (int p = 0; p < 64; ++p) { const f32x2 cp = cmul(CCl[(d * 16 + m) * 64 + p], POW[(d * 64 + p) * 33 + tau]); const LAS f32x2* bb = BBl + (d * 64 + p) * 16 + nq * 4;
            a0 += cp.x * bb[0].x - cp.y * bb[0].y; a1 += cp.x * bb[1].x - cp.y * bb[1].y; a2 += cp.x * bb[2].x - cp.y * bb[2].y; a3 += cp.x * bb[3].x - cp.y * bb[3].y; }
        *(LAS f32x4*)(KRN + ((d * 32 + tau) * 16 + m) * 16 + nq * 4) = (f32x4){a0, a1, a2, a3}; }
    __syncthreads();
    for (int k = 0; k < 96; ++k) { const int ch = tid + 512 * k, row = ch / 96, kc = ch - row * 96, k0 = kc * 8, i = row >> 4, m = row & 15;
        float v[8];
        if (k0 < 512) { const int j = k0 >> 4, n0 = k0 & 15;
            if (i > j) { const LAS float* s = KRN + ((0 * 32 + (i - j)) * 16 + m) * 16 + n0;
#pragma unroll
                for (int t = 0; t < 8; ++t) v[t] = s[t]; }
            else if (i < j) { const LAS float* s = KRN + ((1 * 32 + (j - i)) * 16 + m) * 16 + n0;
#pragma unroll
                for (int t = 0; t < 8; ++t) v[t] = s[t]; }
            else { const LAS float* s0 = KRN + ((0 * 32 + 0) * 16 + m) * 16 + n0; const LAS float* s1 = KRN + ((1 * 32 + 0) * 16 + m) * 16 + n0;
#pragma unroll
                for (int t = 0; t < 8; ++t) v[t] = s0[t] + s1[t]; }
        } else { const int q0 = k0 - 512, d = q0 >> 7, p0 = (q0 & 127) >> 1, e = d == 0 ? i + 1 : 32 - i;
#pragma unroll
            for (int t = 0; t < 4; ++t) { const f32x2 ca = cmul(CCl[(d * 16 + m) * 64 + p0 + t], POW[(d * 64 + p0 + t) * 33 + e]); v[2 * t] = ca.x; v[2 * t + 1] = -ca.y; } }
        *(v4u*)(Bc + ((size_t)(g * 512 + row) * S5K + k0)) = pack8(v); }
    for (int k = 0; k < 32; ++k) { const int ch = tid + 512 * k, q = ch >> 6, kc = ch & 63, k0 = kc * 8, j = k0 >> 4, n0 = k0 & 15;
        const int d = q >> 7, p = (q & 127) >> 1, ri = q & 1, ef = d == 0 ? 31 - j : j;
        const f32x2 pw = POW[(d * 64 + p) * 33 + ef]; float v[8];
#pragma unroll
        for (int t = 0; t < 8; ++t) { const f32x2 w = cmul(pw, BBl[(d * 64 + p) * 16 + n0 + t]); v[t] = ri ? w.y : w.x; }
        *(v4u*)(Ws5 + ((size_t)(g * 256 + q) * 512 + k0)) = pack8(v); }
    __syncthreads();
}
__device__ __forceinline__ void s5_scan(const float* HL, bf16* UA, const f32x2* AB, int gw, int NGW, int lane) {
    for (int w = gw; w < 512; w += NGW) {
        const int b = w >> 6, g = (w >> 1) & 31, d = w & 1;
        f32x2 a32 = AB[(d * 32 + g) * 64 + lane];
#pragma unroll
        for (int i = 0; i < 5; ++i) a32 = cmul(a32, a32);
        f32x2 h = (f32x2){0.f, 0.f};
        const size_t rbase = (size_t)g * S5RP + b * 136;
#pragma unroll 1
        for (int s0 = 0; s0 < 136; s0 += 34) {
            f32x2 hl[34];
#pragma unroll
            for (int k = 0; k < 34; ++k) { const int s = s0 + k, c = d == 0 ? s : (s < 8 ? 7 - s : 143 - s); hl[k] = *(const f32x2*)(HL + (rbase + c) * 256 + d * 128 + lane * 2); }
#pragma unroll
            for (int k = 0; k < 34; ++k) { const int s = s0 + k, c = d == 0 ? s : (s < 8 ? 7 - s : 143 - s);
                *(unsigned*)(UA + (rbase + c) * S5K + 512 + d * 128 + lane * 2) = pk2(h.x, h.y);
                h = cmul(a32, h) + hl[k]; }
        }
    }
}

typedef short bf16x8_t __attribute__((ext_vector_type(8)));
__device__ __forceinline__ bf16x8_t frag_rm(const LAS unsigned char* T, int RS, int r0, int k0, int lane) { return *(const LAS bf16x8_t*)(T + (r0 + (lane & 15)) * RS + (k0 + 8 * (lane >> 4)) * 2); }
#define MFMA16(a, b, c) __builtin_amdgcn_mfma_f32_16x16x32_bf16((a), (b), (c), 0, 0, 0)
typedef short v4i16_t __attribute__((ext_vector_type(4)));
__device__ __forceinline__ bf16x8_t frag_tr(const LAS unsigned char* T, int RS, int k0, int n0, int lane) {
    const int g = lane >> 4, q = (lane & 15) >> 2, p = lane & 3;
    const LAS unsigned char* a = T + (k0 + 8 * g + q) * RS + (n0 + 4 * p) * 2;
    const v4i16_t lo = __builtin_amdgcn_ds_read_tr16_b64_v4i16((LAS v4i16_t*)a);
    const v4i16_t hi = __builtin_amdgcn_ds_read_tr16_b64_v4i16((LAS v4i16_t*)(a + 4 * RS));
    return (bf16x8_t){lo[0], lo[1], lo[2], lo[3], hi[0], hi[1], hi[2], hi[3]};
}
__device__ __forceinline__ bf16x8_t scale_frag(bf16x8_t f, float sc) {
    const v4u w = __builtin_bit_cast(v4u, f); float t[8]; unpack8(w, t);
    v4u o; o.x = pk2(t[0] * sc, t[1] * sc); o.y = pk2(t[2] * sc, t[3] * sc); o.z = pk2(t[4] * sc, t[5] * sc); o.w = pk2(t[6] * sc, t[7] * sc);
    return __builtin_bit_cast(bf16x8_t, o);
}
constexpr int RCH = 34;
__device__ __forceinline__ int ret_row0(int b, int s) { return s < 2 ? ML + b * CTXL + s * 128 : b * SEQL + (s - 2) * 128; }
__device__ __forceinline__ void stage_v(LAS unsigned char* Vs, const bf16* P0, int row0, int h, int tid) {
#pragma unroll
    for (int k = 0; k < 4; ++k) { const int c = tid + 512 * k, j = c >> 4, ch = c & 15;
        *(LAS v4u*)(Vs + j * 272 + ch * 16) = *(const v4u*)(P0 + (size_t)(row0 + j) * P0LD + 512 + h * 128 + ch * 8); }
}
__device__ __forceinline__ void ret_passA_item(LAS unsigned char* lds, int it, const bf16* P0, const float* ret_logit, bf16* ULOC) {
    int tid_ = threadIdx.x; asm volatile("" : "+v"(tid_)); const int tid = tid_, lane = tid & 63, w = tid >> 6, g4 = lane >> 4;
    const int bh = it / RCH, s = it - bh * RCH, b = bh >> 2, h = bh & 3, row0 = ret_row0(b, s);
    const float lgf = log2f(1.0f / (1.0f + expf(-ret_logit[h]))), lgb = log2f(1.0f / (1.0f + expf(-ret_logit[4 + h])));
    LAS unsigned char* Kf = lds; LAS unsigned char* Kb = lds + 18432; LAS unsigned char* Vs = lds + 36864;
#pragma unroll
    for (int k = 0; k < 2; ++k) { const int c = tid + 512 * k, j = c >> 3, ch = c & 7;
        const v4u wv = *(const v4u*)(P0 + (size_t)(row0 + j) * P0LD + 256 + h * 64 + ch * 8); float t[8]; unpack8(wv, t);
        const float sf = exp2f((float)(127 - j) * lgf), sb = exp2f((float)j * lgb);
        v4u of, ob; of.x = pk2(t[0] * sf, t[1] * sf); of.y = pk2(t[2] * sf, t[3] * sf); of.z = pk2(t[4] * sf, t[5] * sf); of.w = pk2(t[6] * sf, t[7] * sf);
        ob.x = pk2(t[0] * sb, t[1] * sb); ob.y = pk2(t[2] * sb, t[3] * sb); ob.z = pk2(t[4] * sb, t[5] * sb); ob.w = pk2(t[6] * sb, t[7] * sb);
        *(LAS v4u*)(Kf + j * 144 + ch * 16) = of; *(LAS v4u*)(Kb + j * 144 + ch * 16) = ob; }
    stage_v(Vs, P0, row0, h, tid);
    __syncthreads();
    f32x4 acc[2][4];
#pragma unroll
    for (int d = 0; d < 2; ++d)
#pragma unroll
        for (int dt = 0; dt < 4; ++dt) acc[d][dt] = (f32x4){0.f, 0.f, 0.f, 0.f};
#pragma unroll
    for (int ks = 0; ks < 4; ++ks) { const bf16x8_t vb = frag_tr(Vs, 272, 32 * ks, 16 * w, lane);
#pragma unroll
        for (int dt = 0; dt < 4; ++dt) { acc[0][dt] = MFMA16(frag_tr(Kf, 144, 32 * ks, 16 * dt, lane), vb, acc[0][dt]); acc[1][dt] = MFMA16(frag_tr(Kb, 144, 32 * ks, 16 * dt, lane), vb, acc[1][dt]); } }
    const int e = 16 * w + (lane & 15);
#pragma unroll
    for (int d = 0; d < 2; ++d)
#pragma unroll
        for (int dt = 0; dt < 4; ++dt) { v2u o; o.x = pk2(acc[d][dt][0], acc[d][dt][1]); o.y = pk2(acc[d][dt][2], acc[d][dt][3]);
            *(v2u*)(ULOC + ((size_t)((bh * 2 + d) * RCH + s) * 128 + e) * 64 + 16 * dt + 4 * g4) = o; }
    __syncthreads();
}
__device__ __forceinline__ void ret_scan(const bf16* ULOC, bf16* SIN, const float* ret_logit, int gt, int NT) {
    for (int idx = gt; idx < 64 * 2048; idx += NT) {
        const int bhd = idx >> 11, off = (idx & 2047) * 4, dir = bhd & 1, h = (bhd >> 1) & 3;
        const float g128 = exp2f(128.0f * log2f(1.0f / (1.0f + expf(-ret_logit[dir * 4 + h]))));
        const size_t base = (size_t)bhd * RCH * 8192 + off;
        v2u u[RCH];
#pragma unroll
        for (int k = 0; k < RCH; ++k) { const int s = dir == 0 ? k : (k < 2 ? 1 - k : 35 - k); u[k] = *(const v2u*)(ULOC + base + (size_t)s * 8192); }
        float st[4] = {0.f, 0.f, 0.f, 0.f};
#pragma unroll
        for (int k = 0; k < RCH; ++k) { const int s = dir == 0 ? k : (k < 2 ? 1 - k : 35 - k);
            v2u o; o.x = pg8::cvt_pk_bf16(st[0], st[1]); o.y = pg8::cvt_pk_bf16(st[2], st[3]); *(v2u*)(SIN + base + (size_t)s * 8192) = o;
            st[0] = g128 * st[0] + bflo(u[k].x); st[1] = g128 * st[1] + bfhi(u[k].x); st[2] = g128 * st[2] + bflo(u[k].y); st[3] = g128 * st[3] + bfhi(u[k].y); }
    }
}
__device__ __forceinline__ void ret_passC_item(LAS unsigned char* lds, int it, const bf16* P0, const float* ret_logit, const bf16* SIN, bf16* RZ) {
    int tid_ = threadIdx.x; asm volatile("" : "+v"(tid_)); const int tid = tid_, lane = tid & 63, w = tid >> 6, g4 = lane >> 4, l15 = lane & 15;
    const int bh = it / RCH, s = it - bh * RCH, b = bh >> 2, h = bh & 3, row0 = ret_row0(b, s);
    const float lgf = log2f(1.0f / (1.0f + expf(-ret_logit[h]))), lgb = log2f(1.0f / (1.0f + expf(-ret_logit[4 + h])));
    LAS unsigned char* Qs = lds; LAS unsigned char* Ks = lds + 18432; LAS unsigned char* SfT = lds + 36864; LAS unsigned char* SbT = lds + 55296; LAS unsigned char* Vs = lds + 73728;
    LAS unsigned char* Pm = lds + 108544;
#pragma unroll
    for (int k = 0; k < 2; ++k) { const int c = tid + 512 * k, j = c >> 3, ch = c & 7;
        *(LAS v4u*)(Qs + j * 144 + ch * 16) = *(const v4u*)(P0 + (size_t)(row0 + j) * P0LD + h * 64 + ch * 8);
        *(LAS v4u*)(Ks + j * 144 + ch * 16) = *(const v4u*)(P0 + (size_t)(row0 + j) * P0LD + 256 + h * 64 + ch * 8);
        *(LAS v4u*)(SfT + j * 144 + ch * 16) = *(const v4u*)(SIN + ((size_t)((bh * 2 + 0) * RCH + s) * 128 + j) * 64 + ch * 8);
        *(LAS v4u*)(SbT + j * 144 + ch * 16) = *(const v4u*)(SIN + ((size_t)((bh * 2 + 1) * RCH + s) * 128 + j) * 64 + ch * 8); }
    stage_v(Vs, P0, row0, h, tid);
    const int il = 16 * w + l15;
    const size_t row = (size_t)(row0 + il);
    v2u gatew[8];
#pragma unroll
    for (int t = 0; t < 8; ++t) gatew[t] = *(const v2u*)(P0 + row * P0LD + 1024 + h * 128 + 16 * t + 4 * g4);
    __syncthreads();
    f32x4 accO[8], accA[8];
#pragma unroll
    for (int t = 0; t < 8; ++t) { accO[t] = (f32x4){0.f, 0.f, 0.f, 0.f}; accA[t] = (f32x4){0.f, 0.f, 0.f, 0.f}; }
    { const float af = exp2f((float)(il + 1) * lgf), ab = exp2f((float)(128 - il) * lgb);
#pragma unroll
      for (int ks = 0; ks < 2; ++ks) { const bf16x8_t q = frag_rm(Qs, 144, 16 * w, 32 * ks, lane); const bf16x8_t qf = scale_frag(q, af), qb = scale_frag(q, ab);
#pragma unroll
          for (int t = 0; t < 8; ++t) { accA[t] = MFMA16(frag_rm(Ks, 144, 16 * t, 32 * ks, lane), q, accA[t]);
              accO[t] = MFMA16(frag_rm(SfT, 144, 16 * t, 32 * ks, lane), qf, accO[t]); accO[t] = MFMA16(frag_rm(SbT, 144, 16 * t, 32 * ks, lane), qb, accO[t]); } } }
#pragma unroll
    for (int t = 0; t < 8; ++t) { float pv[4];
#pragma unroll
        for (int r = 0; r < 4; ++r) { const int j = 16 * t + 4 * g4 + r;
            const float dm = il > j ? exp2f((float)(il - j) * lgf) : (il < j ? exp2f((float)(j - il) * lgb) : 2.0f); pv[r] = accA[t][r] * dm; }
        v2u pw; pw.x = pk2(pv[0], pv[1]); pw.y = pk2(pv[2], pv[3]); *(LAS v2u*)(Pm + il * 272 + (16 * t + 4 * g4) * 2) = pw; }
    __syncthreads();
#pragma unroll
    for (int ks = 0; ks < 4; ++ks) { const bf16x8_t p = frag_rm(Pm, 272, 16 * w, 32 * ks, lane);
#pragma unroll
        for (int t = 0; t < 8; ++t) accO[t] = MFMA16(frag_tr(Vs, 272, 32 * ks, 16 * t, lane), p, accO[t]); }
    float ss = 0.f;
#pragma unroll
    for (int t = 0; t < 8; ++t) ss += (accO[t][0] * accO[t][0] + accO[t][1] * accO[t][1]) + (accO[t][2] * accO[t][2] + accO[t][3] * accO[t][3]);
    ss += __shfl_xor(ss, 16); ss += __shfl_xor(ss, 32);
    const float rs = 1.0f / sqrtf(ss * (1.f / 128.f) + EPSN);
#pragma unroll
    for (int t = 0; t < 8; ++t) { const float g0 = bflo(gatew[t].x), g1 = bfhi(gatew[t].x), g2 = bflo(gatew[t].y), g3 = bfhi(gatew[t].y);
        v2u o; o.x = pk2(accO[t][0] * rs * siluf_(g0), accO[t][1] * rs * siluf_(g1)); o.y = pk2(accO[t][2] * rs * siluf_(g2), accO[t][3] * rs * siluf_(g3));
        *(v2u*)(RZ + row * 1024 + h * 128 + 16 * t + 4 * g4) = o; }
    __syncthreads();
}
__device__ __forceinline__ int hg_row0(int b, int dir, int st) {
    if (st < 8) { const int c = dir ? 7 - st : st; return ML + b * CTXL + c * 32; }
    const int c = dir ? 135 - st : st - 8; return b * SEQL + c * 32;
}
struct HgRaw { v4u q0, q1, l0, l1, v; };
#define HG_ISSUE(R_, st_) do { const int r0_ = hg_row0(b, dir, (st_)); \
        const bf16* qp_ = P1 + (size_t)(r0_ + rtok) * 5120 + h * 128 + rseg; \
        (R_).q0 = *(const v4u*)qp_; (R_).q1 = *(const v4u*)(qp_ + (size_t)16 * 5120); (R_).l0 = *(const v4u*)(qp_ + 1024 + dir * 1024); (R_).l1 = *(const v4u*)(qp_ + (size_t)16 * 5120 + 1024 + dir * 1024); \
        (R_).v = *(const v4u*)(P1 + (size_t)(r0_ + tv) * 5120 + 3072 + h * 128 + eh * 64 + eseg); } while (0)
__device__ __forceinline__ float f16bits(unsigned short hbits) { return (float)__builtin_bit_cast(_Float16, hbits); }
__device__ __forceinline__ void hgrn_item(LAS unsigned char* lds, int it, const bf16* P1, bf16* OS, unsigned char* ws) {
    int tid_ = threadIdx.x; asm volatile("" : "+v"(tid_)); const int tid = tid_;
    const int lane = tid & 63, w = tid >> 6, g4 = lane >> 4, l15 = lane & 15;
    const bool fe = w >= 4;
    const int dir = it & 1, et = w & 3, td = tid & 255, tv = td >> 3, eseg = (td & 7) * 8;
    const int rtok = td >> 4, rseg = (td & 15) * 8;
    const int b = it >> 5, h = (it >> 2) & 7, eh = (it >> 1) & 1;
    LAS unsigned char* LR = lds + 71680;
#define HG_QI(p) (lds + (p) * 35840)
#define HG_KT(p) (lds + (p) * 35840 + 8704)
#define HG_VT(p) (lds + (p) * 35840 + 18944)
#define HG_PM(p) (lds + (p) * 35840 + 24064)
#define HG_KI(p) (lds + (p) * 35840 + 27136)
#define HG_DEC(p) ((LAS float*)(lds + (p) * 35840 + 26624))
    f32x4 S[8];
#pragma unroll
    for (int t = 0; t < 8; ++t) S[t] = (f32x4){0.f, 0.f, 0.f, 0.f};
    HgRaw R[4];
    v2u pend[2] = {(v2u){0u, 0u}, (v2u){0u, 0u}};
    if (fe) { HG_ISSUE(R[0], 0); HG_ISSUE(R[1], 1); HG_ISSUE(R[2], 2); }
#pragma unroll 1
    for (int s4 = 0; s4 < 140; s4 += 4) {
#pragma unroll
    for (int u = 0; u < 4; ++u) {
        const int sl = s4 + u;
        const int pf = sl & 1, pb = pf ^ 1;
        const bool fe_on = fe && sl < 136, be_on = !fe && sl >= 1 && sl <= 136;
        if (fe_on) {
            LAS unsigned char* QI = HG_QI(pf); LAS unsigned char* VT = HG_VT(pf);
            *(LAS v4u*)(QI + rtok * 272 + rseg * 2) = R[u].q0; *(LAS v4u*)(QI + (rtok + 16) * 272 + rseg * 2) = R[u].q1;
            *(LAS v4u*)(LR + rtok * 272 + rseg * 2) = R[u].l0; *(LAS v4u*)(LR + (rtok + 16) * 272 + rseg * 2) = R[u].l1;
            const v4u vr = R[u].v;
            LAS unsigned short* vp = (LAS unsigned short*)(VT + eseg * 80 + tv * 2);
            vp[0 * 40] = (unsigned short)(vr.x & 0xffffu); vp[1 * 40] = (unsigned short)(vr.x >> 16); vp[2 * 40] = (unsigned short)(vr.y & 0xffffu); vp[3 * 40] = (unsigned short)(vr.y >> 16);
            vp[4 * 40] = (unsigned short)(vr.z & 0xffffu); vp[5 * 40] = (unsigned short)(vr.z >> 16); vp[6 * 40] = (unsigned short)(vr.w & 0xffffu); vp[7 * 40] = (unsigned short)(vr.w >> 16);
            if (sl + 3 < 136) HG_ISSUE(R[(u + 3) & 3], sl + 3);
        }
        if (be_on) {
            if (sl >= 10) { const int prow = hg_row0(b, dir, sl - 2);
                bf16* obase = dir == 0 ? OS + (size_t)prow * 1024 : (bf16*)(ws + ws_ob(b)) + (size_t)(prow - b * SEQL) * 1024;
#pragma unroll
                for (int t2 = 0; t2 < 2; ++t2) *(v2u*)(obase + (size_t)(16 * t2 + l15) * 1024 + h * 128 + eh * 64 + 16 * et + 4 * g4) = pend[t2]; }
            LAS unsigned char* QI = HG_QI(pb); LAS unsigned char* KI = HG_KI(pb); LAS unsigned char* PM = HG_PM(pb);
            const int it1 = et >> 1, jt1 = et & 1;
            f32x4 ap = (f32x4){0.f, 0.f, 0.f, 0.f};
#pragma unroll
            for (int ks = 0; ks < 4; ++ks) ap = MFMA16(frag_rm(QI, 272, 16 * it1, 32 * ks, lane), frag_rm(KI, 272, 16 * jt1, 32 * ks, lane), ap);
#pragma unroll
            for (int r = 0; r < 4; ++r) { const int i = 16 * it1 + 4 * g4 + r, j = 16 * jt1 + l15; const bool keep = dir == 0 ? (j <= i) : (j >= i);
                *(LAS unsigned short*)(PM + i * 80 + j * 2) = keep ? (unsigned short)f2bf(ap[r]) : (unsigned short)0; }
        }
        __syncthreads();
        if (fe_on) {
            LAS unsigned char* QI = HG_QI(pf); LAS unsigned char* KT = HG_KT(pf); LAS float* DEC = HG_DEC(pf); LAS unsigned char* KI = HG_KI(pf);
            const int dpl = lane & 15, tq8 = lane >> 4, d0 = 2 * ((w & 3) * 16 + dpl), t0 = tq8 * 8;
            float la[8], lb[8], Ta = 0.f, Tb = 0.f;
#pragma unroll
            for (int i = 0; i < 8; ++i) { const unsigned wv = *(const LAS unsigned*)(LR + (t0 + i) * 272 + d0 * 2); la[i] = f16lo(wv); lb[i] = f16hi(wv); Ta += la[i]; Tb += lb[i]; }
            const float A0 = __shfl(Ta, dpl), A1 = __shfl(Ta, 16 + dpl), A2 = __shfl(Ta, 32 + dpl), A3 = __shfl(Ta, 48 + dpl);
            const float B0 = __shfl(Tb, dpl), B1 = __shfl(Tb, 16 + dpl), B2 = __shfl(Tb, 32 + dpl), B3 = __shfl(Tb, 48 + dpl);
            const float tota = (A0 + A1) + (A2 + A3), totb = (B0 + B1) + (B2 + B3);
            float basea, baseb;
            if (dir == 0) { basea = (tq8 > 0 ? A0 : 0.f) + (tq8 > 1 ? A1 : 0.f) + (tq8 > 2 ? A2 : 0.f); baseb = (tq8 > 0 ? B0 : 0.f) + (tq8 > 1 ? B1 : 0.f) + (tq8 > 2 ? B2 : 0.f); }
            else          { basea = (tq8 < 3 ? A3 : 0.f) + (tq8 < 2 ? A2 : 0.f) + (tq8 < 1 ? A1 : 0.f); baseb = (tq8 < 3 ? B3 : 0.f) + (tq8 < 2 ? B2 : 0.f) + (tq8 < 1 ? B1 : 0.f); }
            float ea = __expf(basea), eb = __expf(baseb); const float eta = __expf(tota), etb = __expf(totb);
            float koa[8], kob[8];
#pragma unroll
            for (int ii = 0; ii < 8; ++ii) { const int i = dir == 0 ? ii : 7 - ii;
                const float fa = __expf(la[i]), fb = __expf(lb[i]); ea *= fa; eb *= fb;
                LAS unsigned* qp = (LAS unsigned*)(QI + (t0 + i) * 272 + d0 * 2); const unsigned qw = *qp;
                const float kia = (1.0f - fa) * __builtin_amdgcn_rcpf(ea), kib = (1.0f - fb) * __builtin_amdgcn_rcpf(eb);
                *qp = pk2(bflo(qw) * ea, bfhi(qw) * eb);
                *(LAS unsigned*)(KI + (t0 + i) * 272 + d0 * 2) = pk2(kia, kib);
                koa[i] = kia * eta; kob[i] = kib * etb; }
            v4u k0, k1;
            k0.x = pk2(koa[0], koa[1]); k0.y = pk2(koa[2], koa[3]); k0.z = pk2(koa[4], koa[5]); k0.w = pk2(koa[6], koa[7]);
            k1.x = pk2(kob[0], kob[1]); k1.y = pk2(kob[2], kob[3]); k1.z = pk2(kob[4], kob[5]); k1.w = pk2(kob[6], kob[7]);
            *(LAS v4u*)(KT + d0 * 80 + t0 * 2) = k0; *(LAS v4u*)(KT + (d0 + 1) * 80 + t0 * 2) = k1;
            if (tq8 == 0) { DEC[d0] = eta; DEC[d0 + 1] = etb; }
        }
        if (be_on) {
            LAS unsigned char* QI = HG_QI(pb); LAS unsigned char* VT = HG_VT(pb); LAS unsigned char* PM = HG_PM(pb);
            LAS unsigned char* KT = HG_KT(pb); LAS float* DEC = HG_DEC(pb);
            bf16x8_t sb[4];
#pragma unroll
            for (int ks = 0; ks < 4; ++ks) { v4u t; t.x = pk2(S[2 * ks][0], S[2 * ks][1]); t.y = pk2(S[2 * ks][2], S[2 * ks][3]); t.z = pk2(S[2 * ks + 1][0], S[2 * ks + 1][1]); t.w = pk2(S[2 * ks + 1][2], S[2 * ks + 1][3]);
                sb[ks] = __builtin_bit_cast(bf16x8_t, t); }
            const bf16x8_t vfrag = frag_rm(VT, 80, 16 * et, 0, lane);
            f32x4 o[2];
#pragma unroll
            for (int t2 = 0; t2 < 2; ++t2) {
                o[t2] = MFMA16(vfrag, frag_rm(PM, 80, 16 * t2, 0, lane), ((f32x4){0.f, 0.f, 0.f, 0.f}));
#pragma unroll
                for (int ks = 0; ks < 4; ++ks) { const LAS unsigned char* qrow = QI + (16 * t2 + l15) * 272 + (32 * ks + 4 * g4) * 2;
                    const v2u qa = *(const LAS v2u*)qrow, qb = *(const LAS v2u*)(qrow + 32);
                    v4u qq; qq.x = qa.x; qq.y = qa.y; qq.z = qb.x; qq.w = qb.y;
                    o[t2] = MFMA16(sb[ks], __builtin_bit_cast(bf16x8_t, qq), o[t2]); }
            }
#pragma unroll
            for (int dt = 0; dt < 8; ++dt) { const f32x4 dv = *(const LAS f32x4*)(DEC + 16 * dt + 4 * g4);
                S[dt] = MFMA16(frag_rm(KT, 80, 16 * dt, 0, lane), vfrag, S[dt] * dv); }
#pragma unroll
            for (int t2 = 0; t2 < 2; ++t2) { pend[t2].x = pk2(o[t2][0], o[t2][1]); pend[t2].y = pk2(o[t2][2], o[t2][3]); }
        }
        __syncthreads();
    }
    }
    if (!fe) { const int prow = hg_row0(b, dir, 135);
      bf16* obase = dir == 0 ? OS + (size_t)prow * 1024 : (bf16*)(ws + ws_ob(b)) + (size_t)(prow - b * SEQL) * 1024;
#pragma unroll
      for (int t2 = 0; t2 < 2; ++t2) *(v2u*)(obase + (size_t)(16 * t2 + l15) * 1024 + h * 128 + eh * 64 + 16 * et + 4 * g4) = pend[t2]; }
    __syncthreads();
#undef HG_QI
#undef HG_KT
#undef HG_VT
#undef HG_PM
#undef HG_DEC
#undef HG_KI
}

struct Args { const float* in[28]; float* out; unsigned char* ws; };
enum { I_X = 0, I_C, I_CTX, I_CCTX, I_WMOD, I_BMOD, I_NMIX, I_NMLP, I_W1, I_W2, I_ABWIN, I_ABWOUT, I_RETL, I_S5ARE, I_S5AIM, I_S5DT, I_S5BRE, I_S5BIM, I_S5CRE, I_S5CIM, I_S5D, I_S5WGLU, I_S5BGLU, I_HGWIN, I_HGWOUT, I_HGLB, I_HGNORM, I_NFIN };

__global__ void __launch_bounds__(NWAVES * 64, 2) mk_fwd(Args args) {
    extern __shared__ __attribute__((aligned(16))) unsigned char lds_raw[];
    LAS unsigned char* lds = (LAS unsigned char*)lds_raw;
    volatile LAS unsigned* MISC = (volatile LAS unsigned*)(lds + MISC_OFF);
    const int tid = threadIdx.x, lane = tid & 63, wave = __builtin_amdgcn_readfirstlane(tid >> 6);
    const int G = gridDim.x;
    const int vcu = (G % 8 == 0) ? ((int)blockIdx.x % 8) * (G / 8) + (int)blockIdx.x / 8 : (int)blockIdx.x;
    const int gw = vcu * NWAVES + wave, NGW = G * NWAVES;
    unsigned char* ws = args.ws;
    gu32* ctl = (gu32*)(ws + WS_CTL);
    for (int u = tid; u < (LDS_BYTES - LDSCTL_OFF) / 4; u += NWAVES * 64) ((LAS unsigned*)(lds + LDSCTL_OFF))[u] = 0u;
    __syncthreads();
    XcdBarrier bar = xcd_barrier_post((unsigned*)(ctl + CW_BAR), MISC + 8);
#define GRID_BAR() xcd_barrier(bar)

    float* MOD = (float*)(ws + WS_MOD); float* CS = (float*)(ws + WS_CS);
    f32x2* AB = (f32x2*)(ws + WS_S5T); float* LB = (float*)(ws + WS_LB);
    float* HC = (float*)(ws + WS_HC);
    bf16* Win0 = (bf16*)(ws + WS_WIN0); bf16* Wout0 = (bf16*)(ws + WS_WOUT0); bf16* Wglu = (bf16*)(ws + WS_WGLU);
    bf16* W1t0 = (bf16*)(ws + WS_W1_0); bf16* W2t0 = (bf16*)(ws + WS_W2_0); bf16* W1t1 = (bf16*)(ws + WS_W1_1); bf16* W2t1 = (bf16*)(ws + WS_W2_1); bf16* Whg = (bf16*)(ws + WS_WHG); bf16* Whgo = (bf16*)(ws + WS_WHGO);
    bf16* XN = (bf16*)(ws + WS_XN); bf16* P0b = (bf16*)(ws + WS_P0); bf16* P1b = (bf16*)(ws + WS_P1); bf16* Hb = (bf16*)(ws + WS_H);
    bf16* ULOC = (bf16*)(ws + WS_ULOC); bf16* SIN = (bf16*)(ws + WS_SIN);
    bf16* UA = (bf16*)(ws + WS_UA); bf16* Bc = (bf16*)(ws + WS_BC); bf16* Ws5 = (bf16*)(ws + WS_WS5); float* HLOC = (float*)(ws + WS_HLOC);
    bf16* RZ = (bf16*)(ws + WS_RZ); bf16* Yb = (bf16*)(ws + WS_Y); bf16* OS = (bf16*)(ws + WS_XN);
    float* OUT = args.out;

    {
        if ((int)blockIdx.x < 96) {
            LAS float* Ssil = (LAS float*)lds; LAS float* red = (LAS float*)(lds + 36864);
            for (int i = tid; i < 9 * 1024; i += NWAVES * 64) { const int r = i >> 10, k = i & 1023; const float v = r < 8 ? args.in[I_C][r * 1024 + k] : args.in[I_CCTX][k]; Ssil[i] = v / (1.0f + expf(-v)); }
            __syncthreads();
            for (int it = blockIdx.x; it < 96; it += G) {
                const int l = it / 48, col0 = (it % 48) * 128, cgp = tid & 31, ksl = tid >> 5;
                const float* W = args.in[I_WMOD] + (size_t)l * 1024 * NMOD + col0 + 4 * cgp;
                f32x4 a[9];
#pragma unroll
                for (int r = 0; r < 9; ++r) a[r] = (f32x4){0.f, 0.f, 0.f, 0.f};
                for (int kk = 0; kk < 64; ++kk) { const int k = ksl * 64 + kk; const f32x4 w = *(const f32x4*)(W + (size_t)k * NMOD);
#pragma unroll
                    for (int r = 0; r < 9; ++r) a[r] += w * Ssil[r * 1024 + k]; }
#pragma unroll
                for (int r = 0; r < 9; ++r) *(LAS f32x4*)(red + (ksl * 9 + r) * 128 + 4 * cgp) = a[r];
                __syncthreads();
                for (int o = tid; o < 9 * 128; o += NWAVES * 64) { const int r = o >> 7, cc = o & 127; float s = args.in[I_BMOD][l * NMOD + col0 + cc];
                    for (int q = 0; q < 16; ++q) s += red[(q * 9 + r) * 128 + cc];
                    MOD[(size_t)(l * 9 + r) * NMOD + col0 + cc] = s; }
                __syncthreads();
            }
        }
        { const int first = G >= 128 ? 96 : 0, nb_ = G >= 128 ? 32 : G;
          if ((int)blockIdx.x >= first && (int)blockIdx.x < first + nb_) { __syncthreads();
            for (int g5 = (int)blockIdx.x - first; g5 < 32; g5 += nb_)
                s5_tables_item(lds, g5, args.in[I_S5ARE], args.in[I_S5AIM], args.in[I_S5DT], args.in[I_S5BRE], args.in[I_S5BIM], args.in[I_S5CRE], args.in[I_S5CIM], Bc, Ws5); } }
        LAS float* scr = (LAS float*)(lds + RING_OFF + wave * 16384);
        constexpr int I_A = 16 * 64, I_B = 16 * 32, I_G = 8 * 16, I_1 = 16 * 128, I_2 = 64 * 32, I_H = 16 * 160, I_O = 16 * 32;
        constexpr int NITEMS = I_A + I_B + I_G + 2 * I_1 + 2 * I_2 + I_H + I_O;
        __syncthreads();
        for (;;) {
          int it0 = 0; if (lane == 0) it0 = (int)__hip_atomic_fetch_add((unsigned*)ctl + 1152, 4u, __ATOMIC_RELAXED, __HIP_MEMORY_SCOPE_AGENT);
          it0 = __builtin_amdgcn_readfirstlane(it0); if (it0 >= NITEMS) break;
          for (int it = it0; it < it0 + 4 && it < NITEMS; ++it) {
            int r = it;
            if (r < I_A) { p0_transpose_item<true>(args.in[I_ABWIN], 1024, 2048, Win0, scr, r, lane); continue; } r -= I_A;
            if (r < I_B) { p0_transpose_item<false>(args.in[I_ABWOUT], 1024, 1024, Wout0, scr, r, lane); continue; } r -= I_B;
            if (r < I_G) { p0_transpose_item<false>(args.in[I_S5WGLU], 512, 512, Wglu, scr, r, lane); continue; } r -= I_G;
            if (r < 2 * I_1) { const int l = r / I_1; p0_transpose_item<false>(args.in[I_W1] + (size_t)l * 1024 * 4096, 1024, 4096, l ? W1t1 : W1t0, scr, r % I_1, lane); continue; } r -= 2 * I_1;
            if (r < 2 * I_2) { const int l = r / I_2; p0_transpose_item<false>(args.in[I_W2] + (size_t)l * 1024 * 4096, 4096, 1024, l ? W2t1 : W2t0, scr, r % I_2, lane); continue; } r -= 2 * I_2;
            if (r < I_H) { p0_transpose_item<false>(args.in[I_HGWIN], 1024, 5120, Whg, scr, r, lane); continue; } r -= I_H;
            p0_transpose_item<false>(args.in[I_HGWOUT], 1024, 1024, Whgo, scr, r, lane);
          }
        }
        const int gt = gw * 64 + lane, NT = NGW * 64;
        for (int i = gt; i < SEQL * 32; i += NT) { const int t = i >> 5, dd = i & 31; const float inv = powf(10000.0f, -(float)(dd & 15) / 16.0f);
            const float a = (dd < 16 ? (float)(t >> 6) : (float)(t & 63)) * inv; CS[2 * i] = cosf(a); CS[2 * i + 1] = sinf(a); }
        for (int i = gt; i < 2 * 32 * 64; i += NT) {
            const float dt = expf(args.in[I_S5DT][i >> 6]); const float are = args.in[I_S5ARE][i], aim = args.in[I_S5AIM][i];
            const float mag = expf(are * dt), ang = aim * dt; const float abr = mag * cosf(ang), abi = mag * sinf(ang);
            const float nr = abr - 1.0f, ni = abi, den = are * are + aim * aim; const float fr = (nr * are + ni * aim) / den, fi = (ni * are - nr * aim) / den;
            AB[i] = (f32x2){abr, abi}; (void)fr; (void)fi;
        }
        for (int i = gt; i < 2 * 1024; i += NT) { const int d = i >> 10, j = i & 1023; const float x0 = args.in[I_HGLB][(d * 2 + 0) * 1024 + j], x1 = args.in[I_HGLB][(d * 2 + 1) * 1024 + j];
            const float mx = fmaxf(x0, x1), e0 = expf(x0 - mx), e1 = expf(x1 - mx); const float g0 = e0 / (e0 + e1), g1 = e1 / (e0 + e1); LB[i] = (g0 + g1) - g0; }
    }
    GRID_BAR();
    norm_mod_rows(args.in[I_X], args.in[I_CTX], MT, args.in[I_NMIX], MOD, 0, DM, XN, gw, NGW, lane);
    GRID_BAR();
    { pg8::Gemm g{XN, Win0, MT, 2048, 1024, 1024, 1024}; pg8::StaticOrder S; S.init(MT, 2048, G, (int)blockIdx.x); EpiProj0 E{P0b, CS, UA};
      pg8::gemm_phase<EpiProj0, pg8::StaticOrder, true, true>(lds + RING_OFF, g, S, E); }
    GRID_BAR();
    { pg8::Gemm g{UA, Ws5, 32 * S5RP, 32 * 256, 512, S5K, 512}; pg8::BatchOrder S; S.init(32, 5, 1, G, (int)blockIdx.x); EpiHloc E{HLOC};
      pg8::gemm_phase<EpiHloc, pg8::BatchOrder, true, true>(lds + RING_OFF, g, S, E);
      __syncthreads();
      for (;;) {
          if (tid == 0) MISC[16] = __hip_atomic_fetch_add((unsigned*)ctl + 1024, 1u, __ATOMIC_RELAXED, __HIP_MEMORY_SCOPE_AGENT);
          __syncthreads(); const int it = (int)MISC[16]; if (it >= 32 * RCH) break;
          ret_passA_item(lds, it, P0b, args.in[I_RETL], ULOC); } }
    GRID_BAR();
    s5_scan(HLOC, UA, AB, gw, NGW, lane);
    ret_scan(ULOC, SIN, args.in[I_RETL], gw * 64 + lane, NGW * 64);
    GRID_BAR();
    { pg8::Gemm g{UA, Bc, 32 * S5RP, 32 * 512, S5K, S5K, S5K}; pg8::BatchOrder S; S.init(32, 5, 2, G, (int)blockIdx.x); EpiS5Out E{UA, args.in[I_S5D], Yb};
      pg8::gemm_phase<EpiS5Out, pg8::BatchOrder, true, true>(lds + RING_OFF, g, S, E);
      __syncthreads();
      for (;;) {
          if (tid == 0) MISC[16] = __hip_atomic_fetch_add((unsigned*)ctl + 1088, 1u, __ATOMIC_RELAXED, __HIP_MEMORY_SCOPE_AGENT);
          __syncthreads(); const int it = (int)MISC[16]; if (it >= 32 * RCH) break;
          ret_passC_item(lds, it, P0b, args.in[I_RETL], SIN, RZ); } }
    GRID_BAR();
    { pg8::Gemm g{Yb, Wglu, MT, 512, 512, 512, 512}; pg8::StaticOrder S; S.init(MT, 512, G, (int)blockIdx.x); EpiGlu E{Yb, args.in[I_S5BGLU], RZ + 512};
      pg8::gemm_phase<EpiGlu, pg8::StaticOrder, true, true>(lds + RING_OFF, g, S, E); }
    GRID_BAR();
    float* SLAB0 = (float*)(ws + WS_BIG);
    float* SLAB1 = (float*)(ws + WS_BIG + 272 * MiB);
    { pg8::Gemm g{RZ, Wout0, ML, 1024, 1024, 1024, 1024}; pg8::StaticOrder S; S.init(ML, 1024, G, (int)blockIdx.x); EpiResid E{args.in[I_X], args.in[I_CTX], OUT, HC, MOD + 2 * DM};
      pg8::gemm_phase<EpiResid, pg8::StaticOrder, true, true>(lds + RING_OFF, g, S, E);
      const int p = (int)blockIdx.x, sk = p & 3, tile = p >> 2;
      pg8::Gemm gp{RZ + (size_t)ML * 1024 + sk * 256, Wout0 + sk * 256, MC, 1024, 256, 1024, 1024}; pg8::SingleUnit SU{tile & 7, tile >> 3, p < 128}; EpiPart EP{SLAB0 + (size_t)sk * MC * DM};
      pg8::gemm_phase<EpiPart, pg8::SingleUnit, true, true>(lds + RING_OFF, gp, SU, EP); }
    GRID_BAR();
    norm_mod_rows(OUT, args.in[I_CTX], MT, args.in[I_NMLP], MOD, 3 * DM, 4 * DM, XN, gw, NGW, lane, SLAB0, 4, MOD + (size_t)8 * NMOD + 2 * DM, HC);
    GRID_BAR();
    { pg8::Gemm g{XN, W1t0, MT, DFF, 1024, 1024, 1024}; pg8::StaticOrder S; S.init(MT, DFF, G, (int)blockIdx.x); EpiSqrelu E{Hb};
      pg8::gemm_phase<EpiSqrelu, pg8::StaticOrder, true, true>(lds + RING_OFF, g, S, E); }
    GRID_BAR();
    { pg8::Gemm g{Hb, W2t0, ML, 1024, DFF, DFF, DFF}; pg8::StaticOrder S; S.init(ML, 1024, G, (int)blockIdx.x); EpiResid E{OUT, HC, OUT, HC, MOD + 5 * DM};
      pg8::gemm_phase<EpiResid, pg8::StaticOrder, true, true>(lds + RING_OFF, g, S, E);
      const int p = (int)blockIdx.x, sk = p & 7, tile = p >> 3;
      pg8::Gemm gp{Hb + (size_t)ML * DFF + sk * 512, W2t0 + sk * 512, MC, 1024, 512, DFF, DFF}; pg8::SingleUnit SU{tile & 7, tile >> 3, p < 256}; EpiPart EP{SLAB1 + (size_t)sk * MC * DM};
      pg8::gemm_phase<EpiPart, pg8::SingleUnit, true, true>(lds + RING_OFF, gp, SU, EP); }
    GRID_BAR();
    const float* MOD1 = MOD + (size_t)9 * NMOD;
    norm_mod_rows(OUT, HC, MT, args.in[I_NMIX] + DM, MOD1, 0, DM, XN, gw, NGW, lane, SLAB1, 8, MOD + (size_t)8 * NMOD + 5 * DM, HC);
    GRID_BAR();
    { pg8::Gemm g{XN, Whg, MT, 5120, 1024, 1024, 1024}; pg8::StaticOrder S; S.init(MT, 5120, G, (int)blockIdx.x); EpiProj1 E{P1b, LB};
      pg8::gemm_phase<EpiProj1, pg8::StaticOrder, true, true>(lds + RING_OFF, g, S, E); }
    GRID_BAR();
    for (int i = blockIdx.x; i < 256; i += G) hgrn_item(lds, i, P1b, OS, ws);
    GRID_BAR();
    merge1_rows(OS, ws, P1b, args.in[I_HGNORM], gw, NGW, lane);
    GRID_BAR();
    { pg8::Gemm g{OS, Whgo, ML, 1024, 1024, 1024, 1024}; pg8::StaticOrder S; S.init(ML, 1024, G, (int)blockIdx.x); EpiResid E{OUT, HC, OUT, HC, MOD1 + 2 * DM};
      pg8::gemm_phase<EpiResid, pg8::StaticOrder, true, true>(lds + RING_OFF, g, S, E); }
    GRID_BAR();
    norm_mod_rows(OUT, HC, ML, args.in[I_NMLP] + DM, MOD1, 3 * DM, 4 * DM, XN, gw, NGW, lane);
    GRID_BAR();
    { pg8::Gemm g{XN, W1t1, ML, DFF, 1024, 1024, 1024}; pg8::StaticOrder S; S.init(ML, DFF, G, (int)blockIdx.x); EpiSqrelu E{Hb};
      pg8::gemm_phase<EpiSqrelu, pg8::StaticOrder, true, true>(lds + RING_OFF, g, S, E); }
    GRID_BAR();
    { pg8::Gemm g{Hb, W2t1, ML, 1024, DFF, DFF, DFF}; pg8::StaticOrder S; S.init(ML, 1024, G, (int)blockIdx.x); EpiResid E{OUT, HC, OUT, HC, MOD1 + 5 * DM};
      pg8::gemm_phase<EpiResid, pg8::StaticOrder, true, true>(lds + RING_OFF, g, S, E); }
    GRID_BAR();
    final_norm_rows(OUT, args.in[I_NFIN], gw, NGW, lane);
}

extern "C" void kernel_launch(void* const* d_in, const int* in_sizes, int n_in, void* d_out, int out_size, void* d_ws, size_t ws_size, hipStream_t stream) {
    static int grid = 0;
    if (grid == 0) {
        if (n_in != 28 || in_sizes[0] != ML * DM || out_size != ML * DM || ws_size < WS_END) { fprintf(stderr, "kernel_launch: unexpected shapes (n_in %d, in0 %d, out %d, ws %zu)\n", n_in, n_in > 0 ? in_sizes[0] : -1, out_size, ws_size); grid = -1; return; }
        int dev = 0, cus = 0, per_cu = 0;
        if (hipGetDevice(&dev) != hipSuccess || hipDeviceGetAttribute(&cus, hipDeviceAttributeMultiprocessorCount, dev) != hipSuccess) { grid = -1; return; }
        if (hipFuncSetAttribute((const void*)mk_fwd, hipFuncAttributeMaxDynamicSharedMemorySize, LDS_BYTES) != hipSuccess) { fprintf(stderr, "kernel_launch: hipFuncSetAttribute failed\n"); grid = -1; return; }
        if (hipOccupancyMaxActiveBlocksPerMultiprocessor(&per_cu, (const void*)mk_fwd, NWAVES * 64, LDS_BYTES) != hipSuccess || per_cu < 1) { fprintf(stderr, "kernel_launch: occupancy query says %d blocks per CU\n", per_cu); }
        (void)hipGetLastError();
        grid = cus;
    }
    if (grid < 0) return;
    if (hipMemsetAsync((char*)d_ws + WS_CTL, 0, CTL_ZERO_BYTES, stream) != hipSuccess) return;
    Args a{};
    for (int i = 0; i < 28; ++i) a.in[i] = (const float*)d_in[i];
    a.out = (float*)d_out; a.ws = (unsigned char*)d_ws;
    hipLaunchKernelGGL(mk_fwd, dim3(grid), dim3(NWAVES * 64), LDS_BYTES, stream, a);
}
```
